# Optimizing an MI355X kernel written in HIP

```python
import math
import jax, jax.numpy as jnp
from jax import lax
import numpy as np

D_MODEL = 2048
BATCH = 2
SEQ = 8192
DEPTH = 4

BLOCK = 128
RET_HEADS = 4
RET_QK_DIM = 256
RET_V_DIM = 512
SG_GROUPS = 4
SG_GROUP_DIM = 256
ATT_HEADS = 8
ATT_HEAD_DIM = 128
DILATION_CONFIGS = ((128, 1), (512, 4), (2048, 16))
REL_BUCKETS = 32
REL_MAX_DIST = 2048
D_FF = 5632
ROPE_BASE = 10000.0
EPS = 1e-6
NEG_INF = -1e30

RET_QK_W = RET_HEADS * RET_QK_DIM
RET_V_W = RET_HEADS * RET_V_DIM
SG_W = SG_GROUPS * SG_GROUP_DIM
ATT_W = ATT_HEADS * ATT_HEAD_DIM
N_BRANCH = 3
IN_SPLITS = (RET_QK_W, RET_QK_W, RET_V_W, RET_V_W, SG_W, SG_W, ATT_W, ATT_W, ATT_W, N_BRANCH * D_MODEL)
D_IN = sum(IN_SPLITS)

kernel_name = 'hybrid_retention_sgu_dilated_attn_macaron'

f32 = jnp.float32


def _rmsnorm(x, g):
    xf = x.astype(f32)
    y = xf * lax.rsqrt(jnp.mean(xf * xf, axis=-1, keepdims=True) + EPS) * g.astype(f32)
    return y.astype(x.dtype)


def _layernorm(x, g, b):
    xf = x.astype(f32)
    mu = jnp.mean(xf, axis=-1, keepdims=True)
    var = jnp.mean(jnp.square(xf - mu), axis=-1, keepdims=True)
    y = (xf - mu) * lax.rsqrt(var + EPS) * g.astype(f32) + b.astype(f32)
    return y.astype(x.dtype)


def _swiglu(h, w_gate, w_up, w_down):
    return (jax.nn.silu(h @ w_gate) * (h @ w_up)) @ w_down


def _rotary(t, positions):
    dh = t.shape[-1]
    inv = ROPE_BASE ** (-jnp.arange(0, dh, 2, dtype=f32) / dh)
    ang = positions.astype(f32)[:, None] * inv[None, :]
    cos, sin = jnp.cos(ang), jnp.sin(ang)
    t1, t2 = t[..., : dh // 2], t[..., dh // 2:]
    return jnp.concatenate([t1 * cos - t2 * sin, t1 * sin + t2 * cos], axis=-1)


def _retention(q, k, v):
    B, H, S, dk = q.shape
    dv = v.shape[-1]
    C = BLOCK
    nc = S // C
    log_g = jnp.log1p(-(2.0 ** (-5.0 - jnp.arange(H, dtype=f32))))
    idx = jnp.arange(C, dtype=f32)
    rel = idx[:, None] - idx[None, :]
    inner = jnp.where(rel[None] >= 0, jnp.exp(jnp.maximum(rel, 0.0)[None] * log_g[:, None, None]), 0.0)
    xi = jnp.exp((idx + 1.0)[None, :] * log_g[:, None])
    zeta = jnp.exp((C - 1.0 - idx)[None, :] * log_g[:, None])
    g_chunk = jnp.exp(C * log_g)
    k = k * (dk ** -0.5)

    def chunks(t):
        return jnp.moveaxis(t.reshape(B, H, nc, C, t.shape[-1]), 2, 0)

    def step(R, qkv):
        qc, kc, vc = qkv
        a = jnp.einsum('bhid,bhjd->bhij', qc, kc) * inner
        o = jnp.einsum('bhij,bhje->bhie', a, vc) + jnp.einsum('bhid,bhde->bhie', qc, R) * xi[..., None]
        R = R * g_chunk[:, None, None] + jnp.einsum('bhjd,bhje->bhde', kc * zeta[..., None], vc)
        return R, o

    R0 = jnp.zeros((B, H, dk, dv), f32)
    _, o = lax.scan(step, R0, (chunks(q), chunks(k), chunks(v)))
    return jnp.moveaxis(o, 0, 2).reshape(B, H, S, dv)


def _t5_bucket(dist):
    max_exact = REL_BUCKETS // 2
    d_f = jnp.maximum(dist, 1).astype(f32)
    large = max_exact + (jnp.log(d_f / max_exact) / math.log(REL_MAX_DIST / max_exact)
                         * (REL_BUCKETS - max_exact)).astype(jnp.int32)
    large = jnp.minimum(large, REL_BUCKETS - 1)
    return jnp.where(dist < max_exact, dist, large)


def _dilated_branch(q, k, v, bias_tab, window, dilation):
    B, H, S, hd = q.shape
    n_back = window // dilation
    blk = n_back
    span = dilation * blk
    L = -(-S // span) * span
    nb = L // span

    def to_stream(t):
        t = jnp.pad(t, ((0, 0), (0, 0), (0, L - S), (0, 0))).reshape(B, H, L // dilation, dilation, hd)
        return jnp.swapaxes(t, 2, 3).reshape(B, H, dilation, nb, blk, hd)

    def with_prev(t):
        prev = jnp.pad(t[:, :, :, :-1], ((0, 0), (0, 0), (0, 0), (1, 0), (0, 0), (0, 0)))
        return jnp.concatenate([prev, t], axis=4)

    def from_stream(t):
        t = t.reshape(B, H, dilation, L // dilation, t.shape[-1])
        return jnp.swapaxes(t, 2, 3).reshape(B, H, L, t.shape[-1])[:, :, :S]

    qs = to_stream(q)
    kc = with_prev(to_stream(k))
    vc = with_prev(to_stream(v))
    i = jnp.arange(blk)[:, None]
    j = jnp.arange(2 * blk)[None, :]
    steps = blk + i - j
    band = (steps >= 0) & (steps <= n_back)
    not_before_start = (jnp.arange(nb)[:, None, None] > 0) | (j[None] >= blk)
    mask = band[None] & not_before_start
    bucket = _t5_bucket(dilation * jnp.maximum(steps, 0))
    bias = jnp.transpose(bias_tab[bucket], (2, 0, 1))

    logits = jnp.einsum('bhrnqd,bhrnkd->bhrnqk', qs, kc) * (hd ** -0.5) + bias[:, None, None]
    logits = jnp.where(mask, logits, NEG_INF)
    m = jnp.max(logits, axis=-1, keepdims=True)
    p = jnp.exp(logits - m)
    den = jnp.sum(p, axis=-1, keepdims=True)
    o = jnp.einsum('bhrnqk,bhrnkd->bhrnqd', p, vc) / den
    lse = m + jnp.log(den)
    return from_stream(o), from_stream(lse)


def _mixer(h, w_in, b_gate, sg_ln_g, sg_ln_b, sg_w, sg_b, rel_bias,
           w_proj_ret, w_proj_sg, w_proj_att, w_out):
    B, S, _ = h.shape
    z = h @ w_in
    offs = [int(o) for o in np.cumsum(IN_SPLITS)[:-1]]
    rq, rk, rv, rg, su, sv, aq, ak, av, gl = jnp.split(z, offs, axis=-1)

    def heads(t, n):
        return jnp.swapaxes(t.reshape(B, S, n, -1), 1, 2).astype(f32)

    def merge_heads(t):
        return jnp.swapaxes(t, 1, 2).reshape(B, S, -1).astype(h.dtype)

    pos = jnp.arange(S)
    ret = _retention(_rotary(heads(rq, RET_HEADS), pos), _rotary(heads(rk, RET_HEADS), pos), heads(rv, RET_HEADS))
    ret = ret * lax.rsqrt(jnp.mean(ret * ret, axis=-1, keepdims=True) + EPS)
    y_ret = (jax.nn.silu(rg) * merge_heads(ret)) @ w_proj_ret

    su = jax.nn.gelu(su)
    sv = _layernorm(jax.nn.gelu(sv), sg_ln_g, sg_ln_b)
    vch = sv.reshape(B, S // BLOCK, BLOCK, SG_GROUPS, SG_GROUP_DIM)
    w_causal = sg_w * jnp.tril(jnp.ones((BLOCK, BLOCK), sg_w.dtype))
    s_mix = jnp.einsum('gts,bnsgc->bntgc', w_causal, vch) + sg_b.T[:, :, None]
    y_sg = (su * s_mix.reshape(B, S, SG_W)) @ w_proj_sg

    qa, ka, va = heads(aq, ATT_HEADS), heads(ak, ATT_HEADS), heads(av, ATT_HEADS)
    bias_tab = rel_bias.astype(f32)
    outs, lses = [], []
    for window, dil in DILATION_CONFIGS:
        o, l = _dilated_branch(qa, ka, va, bias_tab, window, dil)
        outs.append(o)
        lses.append(l)
    wts = jax.nn.softmax(jnp.stack(lses), axis=0)
    att = jnp.sum(wts * jnp.stack(outs), axis=0)
    y_att = merge_heads(att) @ w_proj_att

    gates = jax.nn.sigmoid((gl + b_gate).astype(f32)).astype(h.dtype).reshape(B, S, N_BRANCH, D_MODEL)
    merged = gates[:, :, 0] * y_ret + gates[:, :, 1] * y_sg + gates[:, :, 2] * y_att
    return merged @ w_out


def setup_inputs(seed: int = 0) -> dict:
    key = jax.random.key(seed)
    ks = jax.random.split(key, 24)

    def nrm(k, shape, scale):
        return jax.random.normal(k, shape, f32) * scale

    def gain(k, shape):
        return 1.0 + 0.02 * jax.random.normal(k, shape, f32)

    return {
        'x': nrm(ks[0], (BATCH, SEQ, D_MODEL), 1.0),
        'ffn1_norm': gain(ks[1], (DEPTH, D_MODEL)),
        'ffn1_w_gate': nrm(ks[2], (DEPTH, D_MODEL, D_FF), D_MODEL ** -0.5),
        'ffn1_w_up': nrm(ks[3], (DEPTH, D_MODEL, D_FF), D_MODEL ** -0.5),
        'ffn1_w_down': nrm(ks[4], (DEPTH, D_FF, D_MODEL), D_FF ** -0.5),
        'mix_norm': gain(ks[5], (DEPTH, D_MODEL)),
        'w_in': nrm(ks[6], (DEPTH, D_MODEL, D_IN), D_MODEL ** -0.5),
        'b_gate': nrm(ks[7], (DEPTH, N_BRANCH * D_MODEL), 0.02),
        'sg_ln_g': gain(ks[8], (DEPTH, SG_W)),
        'sg_ln_b': nrm(ks[9], (DEPTH, SG_W), 0.02),
        'sg_w': nrm(ks[10], (DEPTH, SG_GROUPS, BLOCK, BLOCK), BLOCK ** -0.5),
        'sg_b': nrm(ks[11], (DEPTH, SG_GROUPS, BLOCK), 0.02),
        'rel_bias': nrm(ks[12], (REL_BUCKETS, ATT_HEADS), 0.5),
        'w_proj_ret': nrm(ks[13], (DEPTH, RET_V_W, D_MODEL), RET_V_W ** -0.5),
        'w_proj_sg': nrm(ks[14], (DEPTH, SG_W, D_MODEL), SG_W ** -0.5),
        'w_proj_att': nrm(ks[15], (DEPTH, ATT_W, D_MODEL), ATT_W ** -0.5),
        'w_out': nrm(ks[16], (DEPTH, D_MODEL, D_MODEL), D_MODEL ** -0.5),
        'ffn2_norm': gain(ks[17], (DEPTH, D_MODEL)),
        'ffn2_w_gate': nrm(ks[18], (DEPTH, D_MODEL, D_FF), D_MODEL ** -0.5),
        'ffn2_w_up': nrm(ks[19], (DEPTH, D_MODEL, D_FF), D_MODEL ** -0.5),
        'ffn2_w_down': nrm(ks[20], (DEPTH, D_FF, D_MODEL), D_FF ** -0.5),
        'final_norm': gain(ks[21], (D_MODEL,)),
    }


def reference(x, ffn1_norm, ffn1_w_gate, ffn1_w_up, ffn1_w_down, mix_norm, w_in, b_gate,
              sg_ln_g, sg_ln_b, sg_w, sg_b, rel_bias, w_proj_ret, w_proj_sg, w_proj_att, w_out,
              ffn2_norm, ffn2_w_gate, ffn2_w_up, ffn2_w_down, final_norm):
    for l in range(DEPTH):
        x = x + 0.5 * _swiglu(_rmsnorm(x, ffn1_norm[l]), ffn1_w_gate[l], ffn1_w_up[l], ffn1_w_down[l])
        x = x + _mixer(_rmsnorm(x, mix_norm[l]), w_in[l], b_gate[l], sg_ln_g[l], sg_ln_b[l],
                       sg_w[l], sg_b[l], rel_bias, w_proj_ret[l], w_proj_sg[l], w_proj_att[l], w_out[l])
        x = x + 0.5 * _swiglu(_rmsnorm(x, ffn2_norm[l]), ffn2_w_gate[l], ffn2_w_up[l], ffn2_w_down[l])
    return _rmsnorm(x, final_norm)
```

```cpp
#include <hip/hip_runtime.h>
#include <cstdio>
#include <cstdint>

#ifndef MK_PER_PHASE
#define MK_PER_PHASE 0
#endif

namespace pg8 {
#define PG8_LAS __attribute__((address_space(3)))
typedef unsigned short bf16_t;
typedef short bf16x8 __attribute__((ext_vector_type(8)));
typedef float f32x4 __attribute__((ext_vector_type(4)));
typedef unsigned u32x4 __attribute__((ext_vector_type(4)));
typedef unsigned u32x2 __attribute__((ext_vector_type(2)));
constexpr int BM = 256, BK = 64, HALF = 128, HTB = HALF * BK * 2  , STAGE_BYTES = 8 * HTB, NXCD = 8, WGM = 8;

__host__ __device__ __forceinline__ int lds_byte(int r, int c) { const int st = (r >> 4) * 2 + (c >> 5), rr = r & 15, cc = c & 31, ob = rr * 64 + cc * 2; return st * 1024 + (ob ^ (((ob >> 9) & 1) << 5)); }
__host__ __device__ __forceinline__ void stage_rc(int b, int& R, int& C) { const int st = b / 1024, sb = b % 1024, swz = sb ^ (((sb >> 9) & 1) << 5); R = (st >> 1) * 16 + swz / 64; C = (st & 1) * 32 + (swz % 64) / 2; }
__host__ __device__ __forceinline__ int perm32(int rho) { const int n = rho >> 4, i = rho & 15; return 8 * (i >> 2) + 4 * n + (i & 3); }

struct Unit { int pm, pn; };
struct Gemm { const bf16_t* A; const bf16_t* Bt; int M, N, K; };

struct StaticOrder {
    int nM, nN, nwg, G, c, wgm;
    __host__ __device__ void init(int M, int N, int G_, int c_, int wgm_ = WGM) { nM = M / BM; nN = N / BM; nwg = nM * nN; G = G_; c = c_; wgm = wgm_; }
    __host__ __device__ bool next(int i, Unit& u) const {
        const long L = (long)i * G + c; if (L >= nwg) return false;
        int wgid = (int)L; { const int q = nwg / NXCD, r = nwg % NXCD, xcd = wgid % NXCD, off = wgid / NXCD; wgid = (xcd < r ? xcd * (q + 1) : r * (q + 1) + (xcd - r) * q) + off; }
        const int nig = wgm * nN, gid = wgid / nig, fm = gid * wgm, gsz = (nM - fm) < wgm ? (nM - fm) : wgm;
        u.pm = fm + ((wgid % nig) % gsz); u.pn = (wgid % nig) / gsz; return true;
    }
    __device__ __forceinline__ void a_ready(const Unit&) const {}
    __device__ __forceinline__ void done(const Unit&) const {}
};

typedef float f32x2v_t __attribute__((ext_vector_type(2))); typedef __bf16 bf16x2v_t __attribute__((ext_vector_type(2)));
__device__ __forceinline__ unsigned cvt_pk_bf16(float lo, float hi) { const f32x2v_t v = {lo, hi}; const bf16x2v_t b = __builtin_convertvector(v, bf16x2v_t); return __builtin_bit_cast(unsigned, b); }
__device__ __forceinline__ float bf_lo(unsigned w) { return __uint_as_float(w << 16); }
__device__ __forceinline__ float bf_hi(unsigned w) { return __uint_as_float(w & 0xffff0000u); }
__device__ __forceinline__ float fast_sigmoid(float x) { return __builtin_amdgcn_rcpf(1.0f + __builtin_amdgcn_exp2f(-1.4426950408889634f * x)); }
__device__ __forceinline__ float silu_f(float x) { return x * fast_sigmoid(x); }
__device__ __forceinline__ float gelu_tanh_f(float x) { const float u = 0.7978845608028654f * (x + 0.044715f * x * x * x); return x * fast_sigmoid(2.0f * u); }

template <class Epi, class Sched, bool ALIGN_EPI = false, bool SP2 = false>
__device__ __forceinline__ void gemm_phase(PG8_LAS unsigned char* lds, const Gemm g, const Sched& S, const Epi& E, int wid) {
    int lane_; asm volatile("v_mbcnt_lo_u32_b32 %0, -1, 0\n\tv_mbcnt_hi_u32_b32 %0, -1, %0" : "=v"(lane_));
    const int lane = lane_, tid = wid * 64 + lane, wr = wid >> 2, wc = wid & 3, fr = lane & 15, fq = lane >> 4;
    const int K = g.K, nt = K / BK;
    unsigned voffA[2], voffB[2];
#pragma unroll
    for (int i = 0; i < 2; ++i) { int R, C; stage_rc(tid * 16 + i * 8192, R, C); const int Rb = Epi::PERM ? ((R & ~31) + perm32(R & 31)) : R;
        voffA[i] = (unsigned)(R * K + C) * 2u; voffB[i] = (unsigned)(Rb * K + C) * 2u; }
    const size_t kstep = (size_t)(BK * 2);
    const size_t hstep = (size_t)HALF * K * 2;
    const size_t tstep = 2 * hstep;
    const unsigned ldsw = (unsigned)wid * 1024u;
    const int aoff = lds_byte(wr * 64 + fr, fq * 8), boff = lds_byte(wc * 32 + fr, fq * 8);
#define PG8_SA(b, h) (((b) * 2 + (h)) * HTB)
#define PG8_SB(b, h) ((4 + (b) * 2 + (h)) * HTB)
#define PG8_STAGE(bufoff, gbase, voff) do { _Pragma("unroll") for (int _i = 0; _i < 2; ++_i) \
        __builtin_amdgcn_global_load_lds((const unsigned*)((const char*)(gbase) + (voff)[_i]), (PG8_LAS unsigned*)(lds + (bufoff) + ldsw + _i * 8192), 16, 0, 0); } while (0)
#define PG8_LDA(dst, b, h) do { _Pragma("unroll") for (int m = 0; m < 4; ++m) _Pragma("unroll") for (int k = 0; k < 2; ++k) dst[m][k] = *(const PG8_LAS bf16x8*)(lds + PG8_SA(b, h) + aoff + m * 2048 + k * 1024); } while (0)
#define PG8_LDB(dst, b, h) do { _Pragma("unroll") for (int n = 0; n < 2; ++n) _Pragma("unroll") for (int k = 0; k < 2; ++k) dst[n][k] = *(const PG8_LAS bf16x8*)(lds + PG8_SB(b, h) + boff + n * 2048 + k * 1024); } while (0)
#define PG8_MMA(ai, bj, At, Bt) do { __builtin_amdgcn_s_setprio(1); _Pragma("unroll") for (int m = 0; m < 4; ++m) _Pragma("unroll") for (int n = 0; n < 2; ++n) _Pragma("unroll") for (int k = 0; k < 2; ++k) \
        acc[ai][bj][m][n] = __builtin_amdgcn_mfma_f32_16x16x32_bf16(Bt[n][k], At[m][k], acc[ai][bj][m][n], 0, 0, 0); __builtin_amdgcn_s_setprio(0); } while (0)
#define PG8_WAIT_V(n) asm volatile("s_waitcnt vmcnt(" #n ")" ::: "memory")
#define PG8_WAIT_L(n) asm volatile("s_waitcnt lgkmcnt(" #n ")" ::: "memory")
#define PG8_BAR __builtin_amdgcn_s_barrier()
#define PG8_SCHED __builtin_amdgcn_sched_barrier(0)
    Unit cur, nxt; int ui = 0;
    if (!S.next(0, cur)) return;
    f32x4 acc[2][2][4][2];
#pragma unroll
    for (int a = 0; a < 2; ++a)
#pragma unroll
        for (int b = 0; b < 2; ++b)
#pragma unroll
            for (int m = 0; m < 4; ++m)
#pragma unroll
                for (int n = 0; n < 2; ++n) acc[a][b][m][n] = (f32x4){0.f, 0.f, 0.f, 0.f};
    bf16x8 At[4][2], B0[2][2], B1[2][2];
    const char* cA = (const char*)g.A + (size_t)cur.pm * tstep; const char* cB = (const char*)g.Bt + (size_t)cur.pn * tstep;
    S.a_ready(cur);
    if constexpr (SP2) {
        PG8_STAGE(PG8_SB(0, 0), cB, voffB); PG8_STAGE(PG8_SB(0, 1), cB + hstep, voffB); PG8_STAGE(PG8_SA(0, 0), cA, voffA); PG8_STAGE(PG8_SA(0, 1), cA + hstep, voffA);
        if (wr == 1) PG8_BAR;
        PG8_WAIT_V(2); PG8_BAR;
        PG8_STAGE(PG8_SB(1, 0), cB + kstep, voffB); PG8_STAGE(PG8_SA(1, 0), cA + kstep, voffA); PG8_STAGE(PG8_SB(1, 1), cB + hstep + kstep, voffB);
        PG8_WAIT_V(6); PG8_BAR;
    } else {
        PG8_STAGE(PG8_SB(0, 0), cB, voffB); PG8_STAGE(PG8_SA(0, 0), cA, voffA); PG8_STAGE(PG8_SB(0, 1), cB + hstep, voffB); PG8_STAGE(PG8_SA(0, 1), cA + hstep, voffA);
        if (wr == 1) PG8_BAR;
        PG8_WAIT_V(4); PG8_BAR;
        PG8_STAGE(PG8_SB(1, 0), cB + kstep, voffB); PG8_STAGE(PG8_SA(1, 0), cA + kstep, voffA); PG8_STAGE(PG8_SB(1, 1), cB + hstep + kstep, voffB);
        PG8_WAIT_V(6); PG8_BAR;
    }
    for (;;) {
        const bool has_next = S.next(ui + 1, nxt);
        const char* nA = has_next ? (const char*)g.A + (size_t)nxt.pm * tstep : cA; const char* nB = has_next ? (const char*)g.Bt + (size_t)nxt.pn * tstep : cB;
        for (int t = 0; t < nt; t += 2) {
            const bool last = (t == nt - 2);
            const char* a1 = cA + (size_t)(t + 1) * kstep;
            const char* a2 = last ? nA : cA + (size_t)(t + 2) * kstep; const char* b2 = last ? nB : cB + (size_t)(t + 2) * kstep;
            const char* a3 = a2 + kstep; const char* b3 = b2 + kstep;
            if (last && has_next) S.a_ready(nxt);
            if constexpr (Epi::MID) { if (t == Epi::MID_T0 || t == Epi::MID_T1) E.mid(acc, cur, t, wr, wc, fr, fq); }
            if constexpr (SP2) {
            PG8_LDB(B0, 0, 0); PG8_LDB(B1, 0, 1); PG8_SCHED; PG8_LDA(At, 0, 0); PG8_STAGE(PG8_SA(1, 1), a1 + hstep, voffA);
            PG8_WAIT_V(8); PG8_WAIT_L(0); PG8_BAR; PG8_MMA(0, 0, At, B0); PG8_MMA(0, 1, At, B1); PG8_BAR; PG8_SCHED;
            PG8_LDA(At, 0, 1); PG8_STAGE(PG8_SB(0, 0), b2, voffB); PG8_STAGE(PG8_SB(0, 1), b2 + hstep, voffB); PG8_STAGE(PG8_SA(0, 0), a2, voffA);
            PG8_WAIT_V(8); PG8_WAIT_L(0); PG8_BAR; PG8_MMA(1, 0, At, B0); PG8_MMA(1, 1, At, B1); PG8_BAR; PG8_SCHED;
            PG8_LDB(B0, 1, 0); PG8_LDB(B1, 1, 1); PG8_SCHED; PG8_LDA(At, 1, 0); PG8_STAGE(PG8_SA(0, 1), a2 + hstep, voffA);
            PG8_WAIT_V(8); PG8_WAIT_L(0); PG8_BAR; PG8_MMA(0, 0, At, B0); PG8_MMA(0, 1, At, B1); PG8_BAR; PG8_SCHED;
            PG8_LDA(At, 1, 1); PG8_STAGE(PG8_SB(1, 0), b3, voffB); PG8_STAGE(PG8_SB(1, 1), b3 + hstep, voffB); PG8_STAGE(PG8_SA(1, 0), a3, voffA);
            PG8_WAIT_V(8); PG8_WAIT_L(0); PG8_BAR; PG8_MMA(1, 0, At, B0); PG8_MMA(1, 1, At, B1); PG8_BAR; PG8_SCHED;
            } else {
            PG8_LDB(B0, 0, 0); PG8_SCHED; PG8_LDA(At, 0, 0); PG8_STAGE(PG8_SA(1, 1), a1 + hstep, voffA);
            PG8_WAIT_L(8); PG8_BAR; PG8_WAIT_L(0); PG8_MMA(0, 0, At, B0); PG8_BAR; PG8_SCHED;
            PG8_LDB(B1, 0, 1); PG8_STAGE(PG8_SB(0, 0), b2, voffB);
            PG8_BAR; PG8_WAIT_L(0); PG8_MMA(0, 1, At, B1); PG8_BAR;
            PG8_LDA(At, 0, 1); PG8_STAGE(PG8_SA(0, 0), a2, voffA);
            PG8_BAR; PG8_WAIT_L(0); PG8_MMA(1, 0, At, B0); PG8_BAR; PG8_SCHED;
            PG8_STAGE(PG8_SB(0, 1), b2 + hstep, voffB);
            PG8_WAIT_V(6); PG8_BAR; PG8_MMA(1, 1, At, B1); PG8_BAR;
            PG8_LDB(B0, 1, 0); PG8_SCHED; PG8_LDA(At, 1, 0); PG8_STAGE(PG8_SA(0, 1), a2 + hstep, voffA);
            PG8_WAIT_L(8); PG8_BAR; PG8_WAIT_L(0); PG8_MMA(0, 0, At, B0); PG8_BAR; PG8_SCHED;
            PG8_LDB(B1, 1, 1); PG8_STAGE(PG8_SB(1, 0), b3, voffB);
            PG8_BAR; PG8_WAIT_L(0); PG8_MMA(0, 1, At, B1); PG8_BAR;
            PG8_LDA(At, 1, 1); PG8_STAGE(PG8_SA(1, 0), a3, voffA);
            PG8_BAR; PG8_WAIT_L(0); PG8_MMA(1, 0, At, B0); PG8_BAR; PG8_SCHED;
            PG8_STAGE(PG8_SB(1, 1), b3 + hstep, voffB);
            PG8_WAIT_V(6); PG8_BAR; PG8_MMA(1, 1, At, B1); PG8_BAR;
            }
        }
        if constexpr (ALIGN_EPI) { if (wr == 0) PG8_BAR; }
        E(acc, cur, wr, wc, fr, fq); S.done(cur);
        if (!has_next) break;
#pragma unroll
        for (int a = 0; a < 2; ++a)
#pragma unroll
            for (int b = 0; b < 2; ++b)
#pragma unroll
                for (int m = 0; m < 4; ++m)
#pragma unroll
                    for (int n = 0; n < 2; ++n) acc[a][b][m][n] = (f32x4){0.f, 0.f, 0.f, 0.f};
        cur = nxt; cA = nA; cB = nB; ++ui;
        if constexpr (ALIGN_EPI) { if (wr == 1) PG8_BAR; }
    }
    PG8_WAIT_V(0);
    if constexpr (!ALIGN_EPI) { if (wr == 0) PG8_BAR; }
    PG8_BAR;
#undef PG8_SA
#undef PG8_SB
#undef PG8_STAGE
#undef PG8_LDA
#undef PG8_LDB
#undef PG8_MMA
#undef PG8_WAIT_V
#undef PG8_WAIT_L
#undef PG8_BAR
#undef PG8_SCHED
}
}

constexpr int BATCH = 2, T = 8192, M = BATCH * T, D = 2048, FF = 5632, DIN = 17408, DEPTH = 4;
constexpr int C_RQ = 0, C_RK = 1024, C_RV = 2048, C_RG = 4096, C_SU = 6144, C_SV = 7168, C_AQ = 8192, C_AK = 9216, C_AV = 10240, C_GL = 11264;
constexpr int KCAT = 4096;
constexpr float EPS = 1e-6f, LOG2E = 1.4426950408889634f;
constexpr int NWAVES = 8;

constexpr size_t MiB = 1u << 20;
constexpr size_t WS_CTL = 0, CTL_ZERO_BYTES = 2 * MiB;
constexpr size_t WS_SVSTAT = 1 * MiB;
constexpr size_t WS_BIAS = 2 * MiB;
constexpr size_t WS_WC = 3 * MiB;
constexpr size_t WS_LSE = 4 * MiB;
constexpr size_t WS_ROPEC = 8 * MiB, WS_ROPES = 12 * MiB;
constexpr size_t WS_W = 16 * MiB;
constexpr size_t WO_GU1 = 0, WO_D1 = 44 * MiB, WO_IN = 66 * MiB, WO_CAT = 134 * MiB, WO_OUT = 150 * MiB, WO_GU2 = 158 * MiB, WO_D2 = 202 * MiB, W_BYTES = 224 * MiB;
constexpr size_t WS_X = 240 * MiB;
constexpr size_t WS_XB = 368 * MiB;
constexpr size_t WS_Z = 432 * MiB;
constexpr size_t WS_RT = 976 * MiB;
constexpr size_t WS_ACAT = 1104 * MiB;
constexpr size_t WS_OPART = 1232 * MiB;
constexpr size_t WS_MERGED = 1328 * MiB;
constexpr size_t WS_END = 1392 * MiB;
constexpr size_t WS_PART = 6 * MiB;
static_assert((size_t)11264 * 2048 * 2 == 44 * MiB && (size_t)2048 * 5632 * 2 == 22 * MiB && (size_t)17408 * 2048 * 2 == 68 * MiB && (size_t)2048 * 4096 * 2 == 16 * MiB, "weight map");
static_assert((size_t)M * DIN * 2 == 544 * MiB && (size_t)M * D * 4 == 128 * MiB, "activation map");
constexpr int CW_TMO = 0, CW_BAR = 4096;

constexpr int RING_OFF = 0, RING_BYTES = 155648;
constexpr int LDSCTL_OFF = RING_BYTES, MISC_OFF = LDSCTL_OFF + 320;
constexpr int LDS_BYTES = 157696;

#define GAS __attribute__((address_space(1)))
#define LAS __attribute__((address_space(3)))
typedef unsigned short bf16;
typedef unsigned v4u __attribute__((ext_vector_type(4)));
typedef unsigned v2u __attribute__((ext_vector_type(2)));
typedef float f32x4 __attribute__((ext_vector_type(4)));
typedef short bf16x8 __attribute__((ext_vector_type(8)));
typedef short s16x4 __attribute__((ext_vector_type(4)));
typedef GAS unsigned gu32;
#define RLX_AGENT __ATOMIC_RELAXED, __HIP_MEMORY_SCOPE_AGENT
#define LDS_WAIT() asm volatile("s_waitcnt lgkmcnt(0)" ::: "memory")
#define VM_WAIT() asm volatile("s_waitcnt vmcnt(0)" ::: "memory")
__device__ __forceinline__ unsigned f2bf(float f) { unsigned u = __builtin_bit_cast(unsigned, f); return (u + 0x7fffu + ((u >> 16) & 1u)) >> 16; }
__device__ __forceinline__ unsigned pk2(float lo, float hi) { return f2bf(lo) | (f2bf(hi) << 16); }
using pg8::cvt_pk_bf16; using pg8::bf_lo; using pg8::bf_hi;

#define XB_TMO      128
#define XB_XCNT(j)  (256  + 64 * (j))
#define XB_XSUB(j)  (1280 + 64 * (j))
#define XB_XGEN(j)  (2304 + 64 * (j))
#define XB_TOP      3328
#define XB_TOPGEN   3392
#define XCD_BAR_WORDS 3456
#define XB_SPIN_CAP (1u << 20)

__device__ __forceinline__ unsigned xb_ld(unsigned* p)              { return __hip_atomic_load(p, __ATOMIC_RELAXED, __HIP_MEMORY_SCOPE_AGENT); }
__device__ __forceinline__ unsigned xb_add(unsigned* p, unsigned v) { return __hip_atomic_fetch_add(p, v, __ATOMIC_RELAXED, __HIP_MEMORY_SCOPE_AGENT); }
__device__ __forceinline__ unsigned xb_xcc_id() { return (unsigned)__builtin_amdgcn_s_getreg((3 << 11) | 20) & 0xFu; }
#define XB_SPIN(cond, bar) do { unsigned _sp = 0; while (cond) { __builtin_amdgcn_s_sleep(1); \
    if ((++_sp & 255u) == 0u) { if (xb_ld(&(bar)[XB_TMO])) break; if (_sp > XB_SPIN_CAP) { atomicAdd(&(bar)[XB_TMO], 1u); break; } } } } while (0)

struct XcdBarrier { unsigned* bar; unsigned x; volatile LAS unsigned* st; };

__device__ __forceinline__ XcdBarrier xcd_barrier_post(unsigned* bar, volatile LAS unsigned* st) {
    XcdBarrier b; b.bar = bar; b.x = xb_xcc_id(); b.st = st;
    if (threadIdx.x == 0) (void)xb_add(&bar[XB_XCNT(b.x)], 1u);
    return b;
}
__device__ __forceinline__ void xcd_barrier_complete(unsigned* bar, unsigned x, unsigned& nloc, unsigned& nx) {
    const unsigned G = gridDim.x * gridDim.y * gridDim.z;
    unsigned sum, cnt, mine, sp = 0u;
    for (;;) {
        sum = 0u; cnt = 0u; mine = 0u;
#pragma unroll
        for (unsigned j = 0; j < 16; ++j) { const unsigned c = xb_ld(&bar[XB_XCNT(j)]); sum += c; cnt += (c > 0u) ? 1u : 0u; mine = (j == x) ? c : mine; }
        if (sum == G) break;
        __builtin_amdgcn_s_sleep(1);
        if ((++sp & 255u) == 0u) { if (xb_ld(&bar[XB_TMO])) break; if (sp > XB_SPIN_CAP) { atomicAdd(&bar[XB_TMO], 1u); break; } }
    }
    nloc = mine > 0u ? mine : 1u; nx = cnt > 0u ? cnt : 1u;
}
__device__ __forceinline__ void xcd_barrier(const XcdBarrier& b, int wave) {
    asm volatile("s_waitcnt vmcnt(0)" ::: "memory");
    __syncthreads();
    int lane0_; asm volatile("v_mbcnt_lo_u32_b32 %0, -1, 0\n\tv_mbcnt_hi_u32_b32 %0, -1, %0" : "=v"(lane0_));
    if (wave == 0 && lane0_ == 0) {
        unsigned* bar = b.bar;
        __builtin_amdgcn_s_waitcnt(0);
        unsigned nloc = b.st[0], nx = b.st[1];
        if (nloc == 0u) { xcd_barrier_complete(bar, b.x, nloc, nx); b.st[0] = nloc; b.st[1] = nx; }
        const unsigned old = xb_add(&bar[XB_XSUB(b.x)], 1u);
        const unsigned gen = old / nloc;
        if (old + 1u == (gen + 1u) * nloc) {
            __builtin_amdgcn_fence(__ATOMIC_RELEASE, "agent");
            asm volatile("s_waitcnt vmcnt(0)" ::: "memory");
            const unsigned og = xb_add(&bar[XB_TOP], 1u);
            const unsigned tg = og / nx;
            if (og + 1u == (tg + 1u) * nx) xb_add(&bar[XB_TOPGEN], 1u);
            else XB_SPIN(xb_ld(&bar[XB_TOPGEN]) == tg, bar);
            __builtin_amdgcn_fence(__ATOMIC_ACQUIRE, "agent");
            xb_add(&bar[XB_XGEN(b.x)], 1u);
            asm volatile("s_waitcnt vmcnt(0)" ::: "memory");
        } else {
            XB_SPIN(xb_ld(&bar[XB_XGEN(b.x)]) == gen, bar);
            __builtin_amdgcn_fence(__ATOMIC_ACQUIRE, "agent");
            asm volatile("s_waitcnt vmcnt(0)" ::: "memory");
        }
    }
    __syncthreads();
}

namespace pg8 {

__device__ __forceinline__ float row_rstd(const float* part, int row, int fq) {
    const f32x4 a = *(const f32x4*)(part + (size_t)row * 32 + 8 * fq), b = *(const f32x4*)(part + (size_t)row * 32 + 8 * fq + 4);
    float s = ((a[0] + a[1]) + (a[2] + a[3])) + ((b[0] + b[1]) + (b[2] + b[3]));
    s += __shfl_xor(s, 16); s += __shfl_xor(s, 32);
    return 1.0f / sqrtf(s * (1.0f / 2048.0f) + 1e-6f);
}
struct EpiGU {
    static constexpr bool PERM = true, MID = false; static constexpr int MID_T0 = -1, MID_T1 = -1;
    bf16_t* O; const float* part;
    __device__ __forceinline__ void operator()(const f32x4 (&acc)[2][2][4][2], const Unit& u, int wr, int wc, int fr_, int fq_) const {
        int fr = fr_, fq = fq_; asm volatile("" : "+v"(fr), "+v"(fq));
        const int row0 = u.pm * BM + wr * 64 + fr, col0 = u.pn * HALF + wc * 32 + 8 * fq;
        float rs[2][4];
#pragma unroll
        for (int ai = 0; ai < 2; ++ai)
#pragma unroll
            for (int m = 0; m < 4; ++m) rs[ai][m] = row_rstd(part, row0 + ai * HALF + m * 16, fq);
#pragma unroll
        for (int ai = 0; ai < 2; ++ai)
#pragma unroll
            for (int m = 0; m < 4; ++m) { bf16_t* rowp = O + (size_t)(row0 + ai * HALF + m * 16) * FF + col0; const float r = rs[ai][m];
                const f32x4 g0 = acc[ai][0][m][0] * r, g1 = acc[ai][0][m][1] * r, u0 = acc[ai][1][m][0] * r, u1 = acc[ai][1][m][1] * r;
                u32x4 w; w.x = cvt_pk_bf16(silu_f(g0[0]) * u0[0], silu_f(g0[1]) * u0[1]); w.y = cvt_pk_bf16(silu_f(g0[2]) * u0[2], silu_f(g0[3]) * u0[3]);
                w.z = cvt_pk_bf16(silu_f(g1[0]) * u1[0], silu_f(g1[1]) * u1[1]); w.w = cvt_pk_bf16(silu_f(g1[2]) * u1[2], silu_f(g1[3]) * u1[3]);
                *(u32x4*)rowp = w; }
    }
};
struct EpiRes {
    static constexpr bool PERM = false, MID = false; static constexpr int MID_T0 = -1, MID_T1 = -1;
    const float* Xin; float* Xout; bf16_t* XBo; float* part; float scale;
    __device__ __forceinline__ void operator()(const f32x4 (&acc)[2][2][4][2], const Unit& u, int wr, int wc, int fr_, int fq_) const {
        int fr = fr_, fq = fq_; asm volatile("" : "+v"(fr), "+v"(fq));
        const int row0 = u.pm * BM + wr * 64 + fr, col0 = u.pn * BM + wc * 32 + 4 * fq;
#pragma unroll
        for (int ai = 0; ai < 2; ++ai) { f32x4 bs[4][2][2];
#pragma unroll
            for (int m = 0; m < 4; ++m) { const size_t off = (size_t)(row0 + ai * HALF + m * 16) * D + col0;
#pragma unroll
                for (int bj = 0; bj < 2; ++bj)
#pragma unroll
                    for (int n = 0; n < 2; ++n) bs[m][bj][n] = *(const f32x4*)(Xin + off + bj * HALF + n * 16); }
            asm volatile("" ::: "memory");
#pragma unroll
            for (int m = 0; m < 4; ++m) { const int row = row0 + ai * HALF + m * 16; const size_t off = (size_t)row * D + col0; float ss = 0.f;
#pragma unroll
                for (int bj = 0; bj < 2; ++bj)
#pragma unroll
                    for (int n = 0; n < 2; ++n) { const f32x4 x = bs[m][bj][n] + acc[ai][bj][m][n] * scale; *(f32x4*)(Xout + off + bj * HALF + n * 16) = x;
                        u32x2 w; w.x = cvt_pk_bf16(x[0], x[1]); w.y = cvt_pk_bf16(x[2], x[3]); *(u32x2*)(XBo + off + bj * HALF + n * 16) = w;
                        ss += (x[0] * x[0] + x[1] * x[1]) + (x[2] * x[2] + x[3] * x[3]); }
                ss += __shfl_xor(ss, 16); ss += __shfl_xor(ss, 32);
                if (fq == 0) part[(size_t)row * 32 + u.pn * 4 + wc] = ss; }
            asm volatile("" ::: "memory"); }
    }
};
struct EpiProj {
    static constexpr bool PERM = true, MID = true; static constexpr int MID_T0 = 32, MID_T1 = 48;
    const bf16_t* Z; bf16_t* O;
    __device__ __forceinline__ void mid(f32x4 (&acc)[2][2][4][2], const Unit& u, int t, int wr, int wc, int fr_, int fq_) const {
        int fr = fr_, fq = fq_; asm volatile("" : "+v"(fr), "+v"(fq));
        const int row0 = u.pm * BM + wr * 64 + fr, col0 = u.pn * BM + wc * 32 + 8 * fq; const int cn = (t == MID_T0) ? C_GL : C_GL + D;
#pragma unroll
        for (int ai = 0; ai < 2; ++ai) { u32x4 ga[4][2], gb[4][2];
#pragma unroll
            for (int m = 0; m < 4; ++m) { const bf16_t* zp = Z + (size_t)(row0 + ai * HALF + m * 16) * DIN + col0 + cn;
#pragma unroll
                for (int bj = 0; bj < 2; ++bj) { ga[m][bj] = *(const u32x4*)(zp + bj * HALF); gb[m][bj] = *(const u32x4*)(zp + D + bj * HALF); } }
            asm volatile("" ::: "memory");
#pragma unroll
            for (int m = 0; m < 4; ++m)
#pragma unroll
                for (int bj = 0; bj < 2; ++bj) { const u32x4 a = ga[m][bj], b = gb[m][bj]; f32x4& v0 = acc[ai][bj][m][0]; f32x4& v1 = acc[ai][bj][m][1];
                    v0[0] *= bf_lo(a.x) * __builtin_amdgcn_rcpf(bf_lo(b.x)); v0[1] *= bf_hi(a.x) * __builtin_amdgcn_rcpf(bf_hi(b.x)); v0[2] *= bf_lo(a.y) * __builtin_amdgcn_rcpf(bf_lo(b.y)); v0[3] *= bf_hi(a.y) * __builtin_amdgcn_rcpf(bf_hi(b.y));
                    v1[0] *= bf_lo(a.z) * __builtin_amdgcn_rcpf(bf_lo(b.z)); v1[1] *= bf_hi(a.z) * __builtin_amdgcn_rcpf(bf_hi(b.z)); v1[2] *= bf_lo(a.w) * __builtin_amdgcn_rcpf(bf_lo(b.w)); v1[3] *= bf_hi(a.w) * __builtin_amdgcn_rcpf(bf_hi(b.w)); }
            asm volatile("" ::: "memory"); }
    }
    __device__ __forceinline__ void operator()(const f32x4 (&acc)[2][2][4][2], const Unit& u, int wr, int wc, int fr_, int fq_) const {
        int fr = fr_, fq = fq_; asm volatile("" : "+v"(fr), "+v"(fq));
        const int row0 = u.pm * BM + wr * 64 + fr, col0 = u.pn * BM + wc * 32 + 8 * fq;
#pragma unroll
        for (int ai = 0; ai < 2; ++ai)
#pragma unroll
            for (int m = 0; m < 4; ++m) { const int row = row0 + ai * HALF + m * 16; const bf16_t* zp = Z + (size_t)row * DIN + C_GL + 2 * D + col0; bf16_t* op = O + (size_t)row * D + col0;
#pragma unroll
                for (int bj = 0; bj < 2; ++bj) { const u32x4 a = *(const u32x4*)(zp + bj * HALF); const f32x4 v0 = acc[ai][bj][m][0], v1 = acc[ai][bj][m][1];
                    u32x4 w; w.x = cvt_pk_bf16(v0[0] * bf_lo(a.x), v0[1] * bf_hi(a.x)); w.y = cvt_pk_bf16(v0[2] * bf_lo(a.y), v0[3] * bf_hi(a.y));
                    w.z = cvt_pk_bf16(v1[0] * bf_lo(a.z), v1[1] * bf_hi(a.z)); w.w = cvt_pk_bf16(v1[2] * bf_lo(a.w), v1[3] * bf_hi(a.w));
                    *(u32x4*)(op + bj * HALF) = w; } }
    }
};
struct EpiWin {
    static constexpr bool PERM = true, MID = false; static constexpr int MID_T0 = -1, MID_T1 = -1;
    bf16_t* Z; const float* bgate; const float* ropeC; const float* ropeS; const float* part;
    __device__ __forceinline__ void operator()(const f32x4 (&acc)[2][2][4][2], const Unit& u, int wr, int wc, int fr_, int fq_) const {
        int fr = fr_, fq = fq_; asm volatile("" : "+v"(fr), "+v"(fq));
        const int pn = u.pn, row0 = u.pm * BM + wr * 64 + fr, cl = wc * 32 + 8 * fq;
        float rs[2][4];
#pragma unroll
        for (int ai = 0; ai < 2; ++ai)
#pragma unroll
            for (int m = 0; m < 4; ++m) rs[ai][m] = row_rstd(part, row0 + ai * HALF + m * 16, fq);
        if (pn < 8) {
            const int h = pn & 3; const bool isk = pn >= 4;
            const float l2g = __builtin_log2f(1.0f - __builtin_amdgcn_exp2f(-5.0f - (float)h));
#pragma unroll
            for (int ai = 0; ai < 2; ++ai)
#pragma unroll
                for (int m = 0; m < 4; ++m) { const int row = row0 + ai * HALF + m * 16, pos = row & (T - 1), ci = row & 127;
                    const float sc = (isk ? __builtin_amdgcn_exp2f(-(float)ci * l2g) * 0.0625f : __builtin_amdgcn_exp2f((float)ci * l2g)) * rs[ai][m];
                    const float* cp = ropeC + (size_t)pos * 128 + cl; const float* sp = ropeS + (size_t)pos * 128 + cl;
                    const f32x4 c0 = *(const f32x4*)cp, c1 = *(const f32x4*)(cp + 4), s0 = *(const f32x4*)sp, s1 = *(const f32x4*)(sp + 4);
                    const f32x4 t1a = acc[ai][0][m][0], t1b = acc[ai][0][m][1], t2a = acc[ai][1][m][0], t2b = acc[ai][1][m][1];
                    const f32x4 o1a = (t1a * c0 - t2a * s0) * sc, o1b = (t1b * c1 - t2b * s1) * sc, o2a = (t1a * s0 + t2a * c0) * sc, o2b = (t1b * s1 + t2b * c1) * sc;
                    bf16_t* zp = Z + (size_t)row * DIN + pn * BM + cl;
                    u32x4 w; w.x = cvt_pk_bf16(o1a[0], o1a[1]); w.y = cvt_pk_bf16(o1a[2], o1a[3]); w.z = cvt_pk_bf16(o1b[0], o1b[1]); w.w = cvt_pk_bf16(o1b[2], o1b[3]); *(u32x4*)zp = w;
                    w.x = cvt_pk_bf16(o2a[0], o2a[1]); w.y = cvt_pk_bf16(o2a[2], o2a[3]); w.z = cvt_pk_bf16(o2b[0], o2b[1]); w.w = cvt_pk_bf16(o2b[2], o2b[3]); *(u32x4*)(zp + HALF) = w; }
            return;
        }
        const int mode = pn < 16 ? 0 : pn < 24 ? 1 : pn < 28 ? 2 : pn < 32 ? 3 : pn < 36 ? 4 : pn < 44 ? 0 : 5;
        const float qs = 0.08838834764831845f * LOG2E;
#pragma unroll
        for (int ai = 0; ai < 2; ++ai)
#pragma unroll
            for (int m = 0; m < 4; ++m) { const int row = row0 + ai * HALF + m * 16; bf16_t* zp = Z + (size_t)row * DIN + pn * BM + cl;
#pragma unroll
                for (int bj = 0; bj < 2; ++bj) { f32x4 v0 = acc[ai][bj][m][0] * rs[ai][m], v1 = acc[ai][bj][m][1] * rs[ai][m];
                    if (mode == 1) {
#pragma unroll
                        for (int j = 0; j < 4; ++j) { v0[j] = silu_f(v0[j]); v1[j] = silu_f(v1[j]); } }
                    else if (mode == 2 || mode == 3) {
#pragma unroll
                        for (int j = 0; j < 4; ++j) { v0[j] = gelu_tanh_f(v0[j]); v1[j] = gelu_tanh_f(v1[j]); } }
                    else if (mode == 4) { v0 = v0 * qs; v1 = v1 * qs; }
                    else if (mode == 5) { const float* bp = bgate + (pn * BM - C_GL) + bj * HALF + cl; const f32x4 b0 = *(const f32x4*)bp, b1 = *(const f32x4*)(bp + 4);
#pragma unroll
                        for (int j = 0; j < 4; ++j) { v0[j] = fast_sigmoid(v0[j] + b0[j]); v1[j] = fast_sigmoid(v1[j] + b1[j]); } }
                    u32x4 w; w.x = cvt_pk_bf16(v0[0], v0[1]); w.y = cvt_pk_bf16(v0[2], v0[3]); w.z = cvt_pk_bf16(v1[0], v1[1]); w.w = cvt_pk_bf16(v1[2], v1[3]);
                    *(u32x4*)(zp + bj * HALF) = w;
                     }
 }
    }
};
}

__device__ __forceinline__ float wave_sum(float v) {
#pragma unroll
    for (int o = 1; o < 64; o <<= 1) v += __shfl_xor(v, o);
    return v;
}
__device__ __forceinline__ void transpose_item(const float* W, int N, bf16* WT, int ldk, int koff, int drow0, LAS float* scr, int k0, int n0, int lane, const float* gain) {
#pragma unroll 8
    for (int i = 0; i < 32; ++i) { const int kk = 2 * i + (lane >> 5); const float gk = gain ? gain[k0 + kk] : 1.0f; scr[kk * 33 + (lane & 31)] = W[(size_t)(k0 + kk) * N + n0 + (lane & 31)] * gk; }
    LDS_WAIT(); asm volatile("" ::: "memory");
    const int c = lane & 7;
#pragma unroll
    for (int j = 0; j < 4; ++j) { const int n = (lane >> 3) + 8 * j; const LAS float* s = scr + (8 * c) * 33 + n;
        v4u o; o.x = pk2(s[0 * 33], s[1 * 33]); o.y = pk2(s[2 * 33], s[3 * 33]); o.z = pk2(s[4 * 33], s[5 * 33]); o.w = pk2(s[6 * 33], s[7 * 33]);
        *(v4u*)(WT + (size_t)(drow0 + n) * ldk + koff + k0 + 8 * c) = o; }
    LDS_WAIT(); asm volatile("" ::: "memory");
}
struct ConvMat { const float* W; bf16* WT; int K, N, ldk, koff, gu; const float* gain; };
__device__ __forceinline__ void conv_matrix(const ConvMat& c, LAS float* scr, int gw, int NGW, int lane) {
    const int nn = c.N / 32, items = (c.K / 64) * nn;
    for (int it = gw; it < items; it += NGW) { const int kb = it / nn, nb = it - kb * nn, n0 = 32 * nb;
        const int drow0 = c.gu ? ((n0 >> 7) * 256 + (n0 & 127) + (c.gu - 1) * 128) : n0;
        transpose_item(c.W, c.N, c.WT, c.ldk, c.koff, drow0, scr, 64 * kb, n0, lane, c.gain); }
}
template <bool F32OUT>
__device__ __forceinline__ void rms_row(const float* xrow, const float* gain, void* orow, int lane) {
    const f32x4* xr = (const f32x4*)xrow + lane; const f32x4* gr = (const f32x4*)gain + lane;
    f32x4 v[8]; float s = 0.f;
#pragma unroll
    for (int j = 0; j < 8; ++j) { v[j] = xr[64 * j]; s += (v[j].x * v[j].x + v[j].y * v[j].y) + (v[j].z * v[j].z + v[j].w * v[j].w); }
    const float rstd = 1.0f / sqrtf(wave_sum(s) * (1.0f / D) + EPS);
#pragma unroll
    for (int j = 0; j < 8; ++j) { const f32x4 g = gr[64 * j]; const f32x4 o = v[j] * rstd * g;
        if (F32OUT) ((f32x4*)orow + lane)[64 * j] = o;
        else { v2u w; w.x = cvt_pk_bf16(o.x, o.y); w.y = cvt_pk_bf16(o.z, o.w); ((v2u*)orow + lane)[64 * j] = w; } }
}

__device__ __forceinline__ void x_row_prep(const float* xrow, bf16* orow, float* prow, int lane) {
    const f32x4* xr = (const f32x4*)xrow + lane; float s = 0.f;
#pragma unroll
    for (int j = 0; j < 8; ++j) { const f32x4 v = xr[64 * j]; s += (v.x * v.x + v.y * v.y) + (v.z * v.z + v.w * v.w);
        v2u w; w.x = cvt_pk_bf16(v.x, v.y); w.y = cvt_pk_bf16(v.z, v.w); ((v2u*)orow + lane)[64 * j] = w; }
    s = wave_sum(s);
    if (lane < 32) prow[lane] = lane == 0 ? s : 0.f;
}

#define MFMA16(a, b, c) __builtin_amdgcn_mfma_f32_16x16x32_bf16(a, b, c, 0, 0, 0)
__device__ __forceinline__ bf16x8 ldg16(const bf16* p) { return *(const bf16x8*)p; }
__device__ __forceinline__ s16x4 lds_tr(LAS unsigned char* p) { return __builtin_amdgcn_ds_read_tr16_b64_v4i16((LAS s16x4*)p); }
__device__ __forceinline__ bf16x8 cat8(s16x4 a, s16x4 b) { return (bf16x8){a[0], a[1], a[2], a[3], b[0], b[1], b[2], b[3]}; }
__device__ __forceinline__ bf16x8 pack8(f32x4 a, f32x4 b) { v4u w; w.x = cvt_pk_bf16(a[0], a[1]); w.y = cvt_pk_bf16(a[2], a[3]); w.z = cvt_pk_bf16(b[0], b[1]); w.w = cvt_pk_bf16(b[2], b[3]); return __builtin_bit_cast(bf16x8, w); }
__device__ __forceinline__ float head_gamma(int h) { return 1.0f - __builtin_amdgcn_exp2f(-5.0f - (float)h); }

constexpr int SG_VSTRIDE = 544;
__device__ __forceinline__ void sgu_unit(LAS unsigned char* lds, const bf16* Z, bf16* ACAT, const bf16* WC, const float* lng, const float* lnb, const float* sgb, int uid, int w, int lane_in) {
    int lane = lane_in; asm volatile("" : "+v"(lane)); const int tid = w * 64 + lane;
    const int b = uid >> 8, n = (uid >> 2) & 63, gq = uid & 3, row0 = b * T + n * 128;
    const int fr = lane & 15, g = lane >> 4;
    LAS unsigned char* VN = lds; LAS float* ST = (LAS float*)(lds + 128 * SG_VSTRIDE);
#pragma unroll 4
    for (int r = 0; r < 16; ++r) { const int row = 16 * w + r; const v4u* p = (const v4u*)(Z + (size_t)(row0 + row) * DIN + C_SV) + lane;
        const v4u a = p[0], b = p[64]; float s1, s2;
        { const float a0 = bf_lo(a.x), a1 = bf_hi(a.x), a2 = bf_lo(a.y), a3 = bf_hi(a.y), a4 = bf_lo(a.z), a5 = bf_hi(a.z), a6 = bf_lo(a.w), a7 = bf_hi(a.w);
          const float b0 = bf_lo(b.x), b1 = bf_hi(b.x), b2 = bf_lo(b.y), b3 = bf_hi(b.y), b4 = bf_lo(b.z), b5 = bf_hi(b.z), b6 = bf_lo(b.w), b7 = bf_hi(b.w);
          s1 = (((a0 + a1) + (a2 + a3)) + ((a4 + a5) + (a6 + a7))) + (((b0 + b1) + (b2 + b3)) + ((b4 + b5) + (b6 + b7)));
          s2 = (((a0 * a0 + a1 * a1) + (a2 * a2 + a3 * a3)) + ((a4 * a4 + a5 * a5) + (a6 * a6 + a7 * a7))) + (((b0 * b0 + b1 * b1) + (b2 * b2 + b3 * b3)) + ((b4 * b4 + b5 * b5) + (b6 * b6 + b7 * b7))); }
        s1 = wave_sum(s1); s2 = wave_sum(s2);
        if (lane == 0) { const float mean = s1 * (1.0f / 1024.0f), var = fmaxf(s2 * (1.0f / 1024.0f) - mean * mean, 0.f); ST[row * 2] = mean; ST[row * 2 + 1] = 1.0f / sqrtf(var + EPS); } }
    LDS_WAIT(); __syncthreads();
#pragma unroll
    for (int it = 0; it < 8; ++it) { const int p = tid + 512 * it, row = p >> 5, c8 = (p & 31) * 8;
        const v4u x = *(const v4u*)(Z + (size_t)(row0 + row) * DIN + C_SV + gq * 256 + c8);
        const float mean = ST[row * 2], rstd = ST[row * 2 + 1];
        const f32x4 g0 = *(const f32x4*)(lng + gq * 256 + c8), g1 = *(const f32x4*)(lng + gq * 256 + c8 + 4), b0 = *(const f32x4*)(lnb + gq * 256 + c8), b1 = *(const f32x4*)(lnb + gq * 256 + c8 + 4);
        v4u o;
        o.x = cvt_pk_bf16((bf_lo(x.x) - mean) * rstd * g0[0] + b0[0], (bf_hi(x.x) - mean) * rstd * g0[1] + b0[1]);
        o.y = cvt_pk_bf16((bf_lo(x.y) - mean) * rstd * g0[2] + b0[2], (bf_hi(x.y) - mean) * rstd * g0[3] + b0[3]);
        o.z = cvt_pk_bf16((bf_lo(x.z) - mean) * rstd * g1[0] + b1[0], (bf_hi(x.z) - mean) * rstd * g1[1] + b1[1]);
        o.w = cvt_pk_bf16((bf_lo(x.w) - mean) * rstd * g1[2] + b1[2], (bf_hi(x.w) - mean) * rstd * g1[3] + b1[3]);
        *(LAS v4u*)(VN + row * SG_VSTRIDE + c8 * 2) = o; }
    bf16x8 wf[4];
#pragma unroll
    for (int ks = 0; ks < 4; ++ks) wf[ks] = ldg16(WC + (size_t)(gq * 128 + 16 * w + fr) * 128 + ks * 32 + 8 * g);
    LDS_WAIT(); __syncthreads();
    const int row = row0 + 16 * w + fr; const float bias = sgb[gq * 128 + 16 * w + fr];
    const bf16* sup = Z + (size_t)row * DIN + C_SU + gq * 256 + 4 * g; bf16* op = ACAT + (size_t)row * KCAT + 2048 + gq * 256 + 4 * g;
    LAS unsigned char* vb = VN + (8 * g + (fr >> 2)) * SG_VSTRIDE + (fr & 3) * 8;
#pragma unroll
    for (int ct = 0; ct < 16; ++ct) { f32x4 a = (f32x4){0.f, 0.f, 0.f, 0.f};
#pragma unroll
        for (int ks = 0; ks < 4; ++ks) { const bf16x8 af = cat8(lds_tr(vb + (32 * ks) * SG_VSTRIDE + ct * 32), lds_tr(vb + (32 * ks + 4) * SG_VSTRIDE + ct * 32)); a = MFMA16(af, wf[ks], a); }
        const v2u su = *(const v2u*)(sup + 16 * ct);
        v2u o; o.x = cvt_pk_bf16(bf_lo(su.x) * (a[0] + bias), bf_hi(su.x) * (a[1] + bias)); o.y = cvt_pk_bf16(bf_lo(su.y) * (a[2] + bias), bf_hi(su.y) * (a[3] + bias));
        *(v2u*)(op + 16 * ct) = o; }
    __syncthreads();
}


constexpr int CS_KSTRIDE = 544, CS_VSTRIDE = 288, CS_VOFF = 128 * CS_KSTRIDE;
constexpr int CS_UNITS = 2 * 4 * 63 * 4;
__device__ __forceinline__ void cs_phase(LAS unsigned char* lds, const bf16* Z, bf16* SB, int first, int stride, int w, int lane_in) {
    int lane = lane_in; asm volatile("" : "+v"(lane)); const int tid = w * 64 + lane;
    const int fr = lane & 15, g = lane >> 4;
    LAS unsigned char* KC = lds; LAS unsigned char* VC = lds + CS_VOFF;
    v4u kreg[8], vreg[4];
#define CS_DECODE(u_, eq_, n_, bh_) const int eq_ = (u_) & 3, n_ = ((u_) >> 2) % 63, bh_ = ((u_) >> 2) / 63
#define CS_LOAD(u_) do { CS_DECODE(u_, eq_, n_, bh_); const bf16* zr = Z + (size_t)((bh_ >> 2) * T + n_ * 128) * DIN; \
        _Pragma("unroll") for (int it = 0; it < 8; ++it) { const int p = tid + 512 * it; kreg[it] = *(const v4u*)(zr + (size_t)(p >> 5) * DIN + C_RK + (bh_ & 3) * 256 + (p & 31) * 8); } \
        _Pragma("unroll") for (int it = 0; it < 4; ++it) { const int p = tid + 512 * it; vreg[it] = *(const v4u*)(zr + (size_t)(p >> 4) * DIN + C_RV + (bh_ & 3) * 512 + eq_ * 128 + (p & 15) * 8); } } while (0)
    if (first < CS_UNITS) CS_LOAD(first);
    LAS unsigned char* ka = KC + (4 * g + (fr >> 2)) * CS_KSTRIDE + (32 * w) * 2 + (fr & 3) * 8;
    LAS unsigned char* va = VC + (4 * g + (fr >> 2)) * CS_VSTRIDE + (fr & 3) * 8;
    for (int u = first; u < CS_UNITS; u += stride) {
#pragma unroll
        for (int it = 0; it < 8; ++it) { const int p = tid + 512 * it; *(LAS v4u*)(KC + (p >> 5) * CS_KSTRIDE + (p & 31) * 16) = kreg[it]; }
#pragma unroll
        for (int it = 0; it < 4; ++it) { const int p = tid + 512 * it; *(LAS v4u*)(VC + (p >> 4) * CS_VSTRIDE + (p & 15) * 16) = vreg[it]; }
        LDS_WAIT(); __syncthreads();
        if (u + stride < CS_UNITS) CS_LOAD(u + stride);
        f32x4 S[2][8];
#pragma unroll
        for (int i = 0; i < 2; ++i)
#pragma unroll
            for (int j = 0; j < 8; ++j) S[i][j] = (f32x4){0.f, 0.f, 0.f, 0.f};
#pragma unroll
        for (int ks = 0; ks < 4; ++ks) { bf16x8 af[2], bfv[8];
#pragma unroll
            for (int i = 0; i < 2; ++i) af[i] = cat8(lds_tr(ka + (32 * ks) * CS_KSTRIDE + i * 32), lds_tr(ka + (32 * ks + 16) * CS_KSTRIDE + i * 32));
#pragma unroll
            for (int j = 0; j < 8; ++j) bfv[j] = cat8(lds_tr(va + (32 * ks) * CS_VSTRIDE + j * 32), lds_tr(va + (32 * ks + 16) * CS_VSTRIDE + j * 32));
#pragma unroll
            for (int i = 0; i < 2; ++i)
#pragma unroll
                for (int j = 0; j < 8; ++j) S[i][j] = MFMA16(af[i], bfv[j], S[i][j]); }
        { CS_DECODE(u, eq, n, bh);
          bf16* sp = SB + ((size_t)((bh * 64 + n) * 512) + eq * 128 + fr) * 256 + 32 * w + 4 * g;
#pragma unroll
          for (int i = 0; i < 2; ++i)
#pragma unroll
              for (int j = 0; j < 8; ++j) { v2u o; o.x = cvt_pk_bf16(S[i][j][0], S[i][j][1]); o.y = cvt_pk_bf16(S[i][j][2], S[i][j][3]); *(v2u*)(sp + j * 16 * 256 + i * 16) = o; } }
        __syncthreads();
    }
#undef CS_LOAD
#undef CS_DECODE
}

__device__ __forceinline__ void prefix_phase(bf16* SB, int gt, int NGT) {
    for (int idx = gt; idx < 8 * 512 * 32; idx += NGT) {
        const int bh = idx >> 14, h = bh & 3; const float l2g = __builtin_log2f(head_gamma(h)), g127 = __builtin_amdgcn_exp2f(127.f * l2g), g128 = __builtin_amdgcn_exp2f(128.f * l2g);
        bf16* p = SB + (size_t)bh * 64 * 512 * 256 + (size_t)(idx & 16383) * 8;
        float r[8];
#pragma unroll
        for (int k = 0; k < 8; ++k) r[k] = 0.f;
        for (int n0 = 0; n0 < 64; n0 += 8) { v4u s[8];
#pragma unroll
            for (int k = 0; k < 8; ++k) s[k] = (n0 + k < 63) ? *(const v4u*)(p + (size_t)(n0 + k) * 512 * 256) : (v4u){0u, 0u, 0u, 0u};
#pragma unroll
            for (int k = 0; k < 8; ++k) { v4u o; o.x = cvt_pk_bf16(r[0], r[1]); o.y = cvt_pk_bf16(r[2], r[3]); o.z = cvt_pk_bf16(r[4], r[5]); o.w = cvt_pk_bf16(r[6], r[7]);
                *(v4u*)(p + (size_t)(n0 + k) * 512 * 256) = o;
                r[0] = r[0] * g128 + bf_lo(s[k].x) * g127; r[1] = r[1] * g128 + bf_hi(s[k].x) * g127; r[2] = r[2] * g128 + bf_lo(s[k].y) * g127; r[3] = r[3] * g128 + bf_hi(s[k].y) * g127;
                r[4] = r[4] * g128 + bf_lo(s[k].z) * g127; r[5] = r[5] * g128 + bf_hi(s[k].z) * g127; r[6] = r[6] * g128 + bf_lo(s[k].w) * g127; r[7] = r[7] * g128 + bf_hi(s[k].w) * g127; } }
    }
}

constexpr int AT_STRIDE = 288, AT_SLOT = 128 * AT_STRIDE, AT_VOFF = 2 * AT_SLOT, AT_BOFF = 4 * AT_SLOT;
#define AT_LOADBLK(sbk_) do { _Pragma("unroll") for (int it = 0; it < 4; ++it) { const int p = tid + 512 * it; const bf16* zr = zb + (size_t)(((((sbk_) * 128) + (p >> 4)) << dsh) + rr) * DIN + (p & 15) * 8; \
        kreg[it] = *(const v4u*)(zr + C_AK); vreg[it] = *(const v4u*)(zr + C_AV); } } while (0)
#define AT_WRITEBLK(slot_) do { _Pragma("unroll") for (int it = 0; it < 4; ++it) { const int p = tid + 512 * it; const int o = (slot_) * AT_SLOT + (p >> 4) * AT_STRIDE + (p & 15) * 16; \
        *(LAS v4u*)(lds + o) = kreg[it]; *(LAS v4u*)(lds + AT_VOFF + o) = vreg[it]; } } while (0)
template <int PAR>
__device__ __forceinline__ void attn_unit(LAS unsigned char* lds, const bf16* Z, const bf16* zb, bf16* OP, float* LSE, v4u (&kreg)[4], v4u (&vreg)[4], int cfg, int b, int h, int dsh, int rr, int sb, bool has_next, int w, int tid, int fr, int g) {
    LAS float* BL = (LAS float*)(lds + AT_BOFF);
    if (has_next) AT_LOADBLK(sb + 1);
    const int rowq = b * T + ((sb * 128 + 16 * w + fr) << dsh) + rr;
    bf16x8 qf[4];
#pragma unroll
    for (int ks = 0; ks < 4; ++ks) qf[ks] = ldg16(Z + (size_t)rowq * DIN + C_AQ + h * 128 + ks * 32 + 8 * g);
    int wv = 16 * w; asm volatile("" : "+v"(wv));
#define AT_ROWOFF(kt_) (((((wv + 16 * (kt_)) >> 7) ^ PAR ^ 1) & 1) * AT_SLOT + ((wv + 16 * (kt_)) & 127) * AT_STRIDE)
    f32x4 st[9];
#pragma unroll
    for (int kt = 0; kt < 9; ++kt) { LAS unsigned char* kp = lds + AT_ROWOFF(kt) + fr * AT_STRIDE + g * 16; f32x4 a = (f32x4){0.f, 0.f, 0.f, 0.f};
#pragma unroll
        for (int ks = 0; ks < 4; ++ks) a = MFMA16(*(LAS bf16x8*)(kp + ks * 64), qf[ks], a);
        st[kt] = a; }
    LAS float* blp = BL + (15 + 4 * g - fr);
#pragma unroll
    for (int kt = 0; kt < 9; ++kt)
#pragma unroll
        for (int r = 0; r < 4; ++r) st[kt][r] += blp[16 * kt + r];
    if (sb == 0) {
#pragma unroll
        for (int kt = 0; kt < 9; ++kt)
#pragma unroll
            for (int r = 0; r < 4; ++r) if (wv + 16 * kt + 4 * g + r < 128) st[kt][r] = -__builtin_inff(); }
    float mx = -__builtin_inff();
#pragma unroll
    for (int kt = 0; kt < 9; ++kt)
#pragma unroll
        for (int r = 0; r < 4; ++r) mx = fmaxf(mx, st[kt][r]);
    mx = fmaxf(mx, __shfl_xor(mx, 16)); mx = fmaxf(mx, __shfl_xor(mx, 32));
    float den = 0.f;
#pragma unroll
    for (int kt = 0; kt < 9; ++kt)
#pragma unroll
        for (int r = 0; r < 4; ++r) { const float p = __builtin_amdgcn_exp2f(st[kt][r] - mx); st[kt][r] = p; den += p; }
    den += __shfl_xor(den, 16); den += __shfl_xor(den, 32);
    bf16x8 pf[5];
#pragma unroll
    for (int kk = 0; kk < 4; ++kk) pf[kk] = pack8(st[2 * kk], st[2 * kk + 1]);
    pf[4] = pack8(st[8], (f32x4){0.f, 0.f, 0.f, 0.f});
    const float rden = 1.0f / den;
    bf16* op = OP + ((size_t)cfg * M + rowq) * 1024 + h * 128 + 4 * g;
    LAS unsigned char* vb = lds + AT_VOFF + (4 * g + (fr >> 2)) * AT_STRIDE + (fr & 3) * 8;
#pragma unroll
    for (int mt = 0; mt < 8; ++mt) { f32x4 o = (f32x4){0.f, 0.f, 0.f, 0.f};
#pragma unroll
        for (int kk = 0; kk < 5; ++kk) { const int t0 = 2 * kk, t1 = (2 * kk + 1 > 8) ? 8 : 2 * kk + 1;
            const bf16x8 a = cat8(lds_tr(vb + AT_ROWOFF(t0) + mt * 32), lds_tr(vb + AT_ROWOFF(t1) + mt * 32));
            o = MFMA16(a, pf[kk], o); }
        v2u wv; wv.x = cvt_pk_bf16(o[0] * rden, o[1] * rden); wv.y = cvt_pk_bf16(o[2] * rden, o[3] * rden);
        *(v2u*)(op + 16 * mt) = wv; }
    if (g == 0) LSE[((size_t)cfg * M + rowq) * 8 + h] = mx + __builtin_log2f(den);
    __syncthreads();
    if (has_next) { AT_WRITEBLK(PAR ^ 1); LDS_WAIT(); __syncthreads(); }
#undef AT_ROWOFF
}
__device__ __forceinline__ void attn_run(LAS unsigned char* lds, const bf16* Z, bf16* OP, float* LSE, const float* BIAS, int item, int w, int lane_in) {
    int lane = lane_in; asm volatile("" : "+v"(lane)); const int tid = w * 64 + lane;
    const int cfg = item >> 8, b = (item >> 7) & 1, h = (item >> 4) & 7, run = item & 15;
    const int dsh = 2 * cfg, rr = run & ((1 << dsh) - 1), sb0 = 4 * (run >> dsh);
    const int fr = lane & 15, g = lane >> 4;
    LAS float* BL = (LAS float*)(lds + AT_BOFF);
    const bf16* zb = Z + (size_t)(b * T) * DIN + h * 128;
    v4u kreg[4], vreg[4];
    { const int pb = sb0 > 0 ? sb0 - 1 : 0; AT_LOADBLK(pb); AT_WRITEBLK(1); }
    AT_LOADBLK(sb0);
    if (tid < 160) { const int dl = tid - 15; BL[tid] = (dl >= 0 && dl <= 128) ? BIAS[(cfg * 8 + h) * 132 + 128 - dl] : -__builtin_inff(); }
    AT_WRITEBLK(0);
    LDS_WAIT(); __syncthreads();
#pragma unroll 1
    for (int up = 0; up < 2; ++up) {
        attn_unit<0>(lds, Z, zb, OP, LSE, kreg, vreg, cfg, b, h, dsh, rr, sb0 + 2 * up, true, w, tid, fr, g);
        attn_unit<1>(lds, Z, zb, OP, LSE, kreg, vreg, cfg, b, h, dsh, rr, sb0 + 2 * up + 1, up == 0, w, tid, fr, g);
    }
}
#undef AT_LOADBLK
#undef AT_WRITEBLK

constexpr int RO_KSTRIDE = 544, RO_VSTRIDE = 160, RO_VOFF = 64 * RO_KSTRIDE, RO_BUF = RO_VOFF + 128 * RO_VSTRIDE;
__device__ __forceinline__ void retout_unit(LAS unsigned char* lds, const bf16* Z, const bf16* RT, bf16* ACAT, int uid, int w, int lane_in) {
    int lane = lane_in; asm volatile("" : "+v"(lane)); const int tid = w * 64 + lane;
    const int b = uid >> 8, h = (uid >> 6) & 3, n = uid & 63, row0 = b * T + n * 128;
    const int fr = lane & 15, g = lane >> 4, rowq = row0 + 16 * w + fr;
    const float gamma = head_gamma(h);
    const bf16* vsrc = Z + (size_t)row0 * DIN + C_RV + h * 512;
    const bf16* rsrc = RT + (size_t)(((b * 4 + h) * 64 + n) * 512) * 256;
    v4u rreg[4], vreg[2];
#define RO_LOAD(c_) do { _Pragma("unroll") for (int it = 0; it < 4; ++it) { const int p = tid + 512 * it; rreg[it] = *(const v4u*)(rsrc + (size_t)((c_) * 64 + (p >> 5)) * 256 + (p & 31) * 8); } \
        _Pragma("unroll") for (int it = 0; it < 2; ++it) { const int p = tid + 512 * it; vreg[it] = *(const v4u*)(vsrc + (size_t)(p >> 3) * DIN + (c_) * 64 + (p & 7) * 8); } } while (0)
#define RO_WRITE(buf_) do { _Pragma("unroll") for (int it = 0; it < 4; ++it) { const int p = tid + 512 * it; *(LAS v4u*)(lds + (buf_) * RO_BUF + (p >> 5) * RO_KSTRIDE + (p & 31) * 16) = rreg[it]; } \
        _Pragma("unroll") for (int it = 0; it < 2; ++it) { const int p = tid + 512 * it; *(LAS v4u*)(lds + (buf_) * RO_BUF + RO_VOFF + (p >> 3) * RO_VSTRIDE + (p & 7) * 16) = vreg[it]; } } while (0)
    { v4u kreg[8];
#pragma unroll
      for (int it = 0; it < 8; ++it) { const int p = tid + 512 * it; kreg[it] = *(const v4u*)(Z + (size_t)(row0 + (p >> 5)) * DIN + C_RK + h * 256 + (p & 31) * 8); }
#pragma unroll
      for (int it = 0; it < 8; ++it) { const int p = tid + 512 * it; *(LAS v4u*)(lds + (p >> 5) * RO_KSTRIDE + (p & 31) * 16) = kreg[it]; } }
    bf16x8 qf[8];
#pragma unroll
    for (int ks = 0; ks < 8; ++ks) qf[ks] = ldg16(Z + (size_t)rowq * DIN + C_RQ + h * 256 + ks * 32 + 8 * g);
    LDS_WAIT(); __syncthreads();
    RO_LOAD(0);
    f32x4 st[8];
#pragma unroll
    for (int jt = 0; jt < 8; ++jt) { st[jt] = (f32x4){0.f, 0.f, 0.f, 0.f};
        if (jt <= w) { LAS unsigned char* kp = lds + (16 * jt + fr) * RO_KSTRIDE + g * 16; f32x4 a = (f32x4){0.f, 0.f, 0.f, 0.f};
#pragma unroll
            for (int ks = 0; ks < 8; ++ks) a = MFMA16(*(LAS bf16x8*)(kp + ks * 64), qf[ks], a);
            if (jt == w) {
#pragma unroll
                for (int r = 0; r < 4; ++r) if (4 * g + r > fr) a[r] = 0.f; }
            st[jt] = a; } }
    bf16x8 pf[4];
#pragma unroll
    for (int kk = 0; kk < 4; ++kk) pf[kk] = pack8(st[2 * kk], st[2 * kk + 1]);
    __syncthreads();
    RO_WRITE(0); LDS_WAIT(); __syncthreads();
    f32x4 o[32];
    LAS unsigned char* ra = lds + fr * RO_KSTRIDE + g * 16;
    LAS unsigned char* va = lds + RO_VOFF + (4 * g + (fr >> 2)) * RO_VSTRIDE + (fr & 3) * 8;
#pragma unroll
    for (int c = 0; c < 8; ++c) {
        if (c < 7) RO_LOAD(c + 1);
#pragma unroll
        for (int e4 = 0; e4 < 4; ++e4) { f32x4 a = (f32x4){0.f, 0.f, 0.f, 0.f};
#pragma unroll
            for (int ks = 0; ks < 8; ++ks) a = MFMA16(*(LAS bf16x8*)(ra + (c & 1) * RO_BUF + e4 * 16 * RO_KSTRIDE + ks * 64), qf[ks], a);
            a = a * gamma;
#pragma unroll
            for (int kk = 0; kk < 4; ++kk) if (2 * kk <= w) {
                const bf16x8 af = cat8(lds_tr(va + (c & 1) * RO_BUF + (32 * kk) * RO_VSTRIDE + e4 * 32), lds_tr(va + (c & 1) * RO_BUF + (32 * kk + 16) * RO_VSTRIDE + e4 * 32));
                a = MFMA16(af, pf[kk], a); }
            o[4 * c + e4] = a; }
        if (c < 7) RO_WRITE((c + 1) & 1);
        LDS_WAIT(); __syncthreads();
    }
    float ss = 0.f;
#pragma unroll
    for (int et = 0; et < 32; ++et) ss += (o[et][0] * o[et][0] + o[et][1] * o[et][1]) + (o[et][2] * o[et][2] + o[et][3] * o[et][3]);
    ss += __shfl_xor(ss, 16); ss += __shfl_xor(ss, 32);
    const float rn = 1.0f / sqrtf(ss * (1.0f / 512.0f) + EPS);
    const bf16* rgp = Z + (size_t)rowq * DIN + C_RG + h * 512 + 4 * g; bf16* op = ACAT + (size_t)rowq * KCAT + h * 512 + 4 * g;
#pragma unroll
    for (int et = 0; et < 32; ++et) { const v2u rg = *(const v2u*)(rgp + 16 * et);
        v2u ov; ov.x = cvt_pk_bf16(bf_lo(rg.x) * o[et][0] * rn, bf_hi(rg.x) * o[et][1] * rn); ov.y = cvt_pk_bf16(bf_lo(rg.y) * o[et][2] * rn, bf_hi(rg.y) * o[et][3] * rn);
        *(v2u*)(op + 16 * et) = ov; }
#undef RO_LOAD
#undef RO_WRITE
}
constexpr int AT1_VSTRIDE = 288;
__device__ __forceinline__ void attn_unit(LAS unsigned char* lds, const bf16* Z, bf16* OP, float* LSE, const float* BIAS, int uid, int w, int lane_in) {
    int lane = lane_in; asm volatile("" : "+v"(lane)); const int tid = w * 64 + lane;
    const int cfg = uid >> 10, b = (uid >> 9) & 1, h = (uid >> 6) & 7, u64 = uid & 63;
    const int dsh = 2 * cfg, dm = (1 << dsh) - 1, rr = u64 & dm, sb = u64 >> dsh;
    LAS unsigned char* VS = lds; LAS float* BL = (LAS float*)(lds + 256 * AT1_VSTRIDE);
    const int fr = lane & 15, g = lane >> 4;
#pragma unroll
    for (int it = 0; it < 8; ++it) { const int p = tid + 512 * it, row = p >> 4, c16 = p & 15; int s = (sb - 1) * 128 + row; s = s < 0 ? 0 : s;
        const v4u v = *(const v4u*)(Z + (size_t)(b * T + (s << dsh) + rr) * DIN + C_AV + h * 128 + c16 * 8);
        *(LAS v4u*)(VS + row * AT1_VSTRIDE + c16 * 16) = v; }
    if (tid < 132) BL[tid] = BIAS[(cfg * 8 + h) * 132 + tid];
    const int rowq = b * T + ((sb * 128 + 16 * w + fr) << dsh) + rr;
    bf16x8 qf[4];
#pragma unroll
    for (int ks = 0; ks < 4; ++ks) qf[ks] = ldg16(Z + (size_t)rowq * DIN + C_AQ + h * 128 + ks * 32 + 8 * g);
    f32x4 st[9];
#pragma unroll
    for (int kt = 0; kt < 9; ++kt) { int s = (sb - 1) * 128 + 16 * w + 16 * kt + fr; s = s < 0 ? 0 : s;
        const bf16* kp = Z + (size_t)(b * T + (s << dsh) + rr) * DIN + C_AK + h * 128 + 8 * g; f32x4 a = (f32x4){0.f, 0.f, 0.f, 0.f};
#pragma unroll
        for (int ks = 0; ks < 4; ++ks) a = MFMA16(ldg16(kp + ks * 32), qf[ks], a);
        st[kt] = a; }
    LDS_WAIT(); __syncthreads();
    float mx = (-__builtin_inff());
#pragma unroll
    for (int kt = 0; kt < 9; ++kt)
#pragma unroll
        for (int r = 0; r < 4; ++r) { const int delta = 16 * kt + 4 * g + r - fr, jj = 16 * w + 16 * kt + 4 * g + r;
            const bool ok = (delta >= 0) && (delta <= 128) && (sb > 0 || jj >= 128);
            const int steps = ok ? 128 - delta : 0;
            const float l = ok ? st[kt][r] + BL[steps] : (-__builtin_inff()); st[kt][r] = l; mx = fmaxf(mx, l); }
    mx = fmaxf(mx, __shfl_xor(mx, 16)); mx = fmaxf(mx, __shfl_xor(mx, 32));
    float den = 0.f;
#pragma unroll
    for (int kt = 0; kt < 9; ++kt)
#pragma unroll
        for (int r = 0; r < 4; ++r) { const float p = __builtin_amdgcn_exp2f(st[kt][r] - mx); st[kt][r] = p; den += p; }
    den += __shfl_xor(den, 16); den += __shfl_xor(den, 32);
    bf16x8 pf[5];
#pragma unroll
    for (int kk = 0; kk < 4; ++kk) pf[kk] = pack8(st[2 * kk], st[2 * kk + 1]);
    pf[4] = pack8(st[8], (f32x4){0.f, 0.f, 0.f, 0.f});
    const float rden = 1.0f / den;
    bf16* op = OP + ((size_t)cfg * M + rowq) * 1024 + h * 128 + 4 * g;
    LAS unsigned char* vb = VS + (16 * w + 4 * g + (fr >> 2)) * AT1_VSTRIDE + (fr & 3) * 8;
#pragma unroll
    for (int mt = 0; mt < 8; ++mt) { f32x4 o = (f32x4){0.f, 0.f, 0.f, 0.f};
#pragma unroll
        for (int kk = 0; kk < 5; ++kk) { const int t0 = 2 * kk, t1 = (2 * kk + 1 > 8) ? 8 : 2 * kk + 1;
            const bf16x8 a = cat8(lds_tr(vb + t0 * 16 * AT1_VSTRIDE + mt * 32), lds_tr(vb + t1 * 16 * AT1_VSTRIDE + mt * 32));
            o = MFMA16(a, pf[kk], o); }
        v2u wv; wv.x = cvt_pk_bf16(o[0] * rden, o[1] * rden); wv.y = cvt_pk_bf16(o[2] * rden, o[3] * rden);
        *(v2u*)(op + 16 * mt) = wv; }
    if (g == 0) LSE[((size_t)cfg * M + rowq) * 8 + h] = mx + __builtin_log2f(den);
    __syncthreads();
}

constexpr int SC_KSTRIDE = 544, SC_VSTRIDE = 160, SC_VOFF = 128 * SC_KSTRIDE;
__device__ __forceinline__ void scan_unit(LAS unsigned char* lds, const bf16* Z, bf16* RT, int uid, int w, int lane_in) {
    int lane = lane_in; asm volatile("" : "+v"(lane)); const int tid = w * 64 + lane;
    const int b = uid >> 5, h = (uid >> 3) & 3, es = uid & 7;
    const int fr = lane & 15, g = lane >> 4;
    const float l2g = __builtin_log2f(head_gamma(h)), g127 = __builtin_amdgcn_exp2f(127.f * l2g), g128 = __builtin_amdgcn_exp2f(128.f * l2g);
    LAS unsigned char* KC = lds; LAS unsigned char* VC = lds + SC_VOFF;
    v4u kreg[8], vreg[2];
    const bf16* kbase = Z + (size_t)(b * T) * DIN + C_RK + h * 256; const bf16* vbase = Z + (size_t)(b * T) * DIN + C_RV + h * 512 + es * 64;
#define SC_LOAD(n_) do { _Pragma("unroll") for (int it = 0; it < 8; ++it) { const int p = tid + 512 * it; kreg[it] = *(const v4u*)(kbase + (size_t)((n_) * 128 + (p >> 5)) * DIN + (p & 31) * 8); } \
        _Pragma("unroll") for (int it = 0; it < 2; ++it) { const int p = tid + 512 * it; vreg[it] = *(const v4u*)(vbase + (size_t)((n_) * 128 + (p >> 3)) * DIN + (p & 7) * 8); } } while (0)
    SC_LOAD(0);
    f32x4 R[2][4];
#pragma unroll
    for (int i = 0; i < 2; ++i)
#pragma unroll
        for (int j = 0; j < 4; ++j) R[i][j] = (f32x4){0.f, 0.f, 0.f, 0.f};
    bf16* rtb = RT + ((size_t)((b * 4 + h) * 64) * 512 + es * 64 + fr) * 256 + 32 * w + 4 * g;
    LAS unsigned char* ka = KC + (8 * g + (fr >> 2)) * SC_KSTRIDE + (32 * w) * 2 + (fr & 3) * 8;
    LAS unsigned char* va = VC + (8 * g + (fr >> 2)) * SC_VSTRIDE + (fr & 3) * 8;
    for (int n = 0; n < 64; ++n) {
#pragma unroll
        for (int it = 0; it < 8; ++it) { const int p = tid + 512 * it; *(LAS v4u*)(KC + (p >> 5) * SC_KSTRIDE + (p & 31) * 16) = kreg[it]; }
#pragma unroll
        for (int it = 0; it < 2; ++it) { const int p = tid + 512 * it; *(LAS v4u*)(VC + (p >> 3) * SC_VSTRIDE + (p & 7) * 16) = vreg[it]; }
        LDS_WAIT(); __syncthreads();
        if (n < 63) SC_LOAD(n + 1);
#pragma unroll
        for (int i = 0; i < 2; ++i)
#pragma unroll
            for (int j = 0; j < 4; ++j) { v2u o; o.x = cvt_pk_bf16(R[i][j][0], R[i][j][1]); o.y = cvt_pk_bf16(R[i][j][2], R[i][j][3]);
                *(v2u*)(rtb + (size_t)n * 512 * 256 + j * 16 * 256 + i * 16) = o; }
        if (n < 63) {
            f32x4 S[2][4];
#pragma unroll
            for (int i = 0; i < 2; ++i)
#pragma unroll
                for (int j = 0; j < 4; ++j) S[i][j] = (f32x4){0.f, 0.f, 0.f, 0.f};
#pragma unroll
            for (int ks = 0; ks < 4; ++ks) { bf16x8 af[2], bfv[4];
#pragma unroll
                for (int i = 0; i < 2; ++i) af[i] = cat8(lds_tr(ka + (32 * ks) * SC_KSTRIDE + i * 32), lds_tr(ka + (32 * ks + 4) * SC_KSTRIDE + i * 32));
#pragma unroll
                for (int j = 0; j < 4; ++j) bfv[j] = cat8(lds_tr(va + (32 * ks) * SC_VSTRIDE + j * 32), lds_tr(va + (32 * ks + 4) * SC_VSTRIDE + j * 32));
#pragma unroll
                for (int i = 0; i < 2; ++i)
#pragma unroll
                    for (int j = 0; j < 4; ++j) S[i][j] = MFMA16(af[i], bfv[j], S[i][j]); }
#pragma unroll
            for (int i = 0; i < 2; ++i)
#pragma unroll
                for (int j = 0; j < 4; ++j) R[i][j] = R[i][j] * g128 + S[i][j] * g127;
        }
        LDS_WAIT(); __syncthreads();
    }
#undef SC_LOAD
}

constexpr int RO1_VSTRIDE = 288, RO1_VBUF = 128 * RO1_VSTRIDE;
__device__ __forceinline__ void retout_old_unit(LAS unsigned char* lds, const bf16* Z, const bf16* RT, bf16* ACAT, int uid, int w, int lane_in) {
    int lane = lane_in; asm volatile("" : "+v"(lane)); const int tid = w * 64 + lane;
    const int b = uid >> 8, h = (uid >> 6) & 3, n = uid & 63, row0 = b * T + n * 128;
    const int fr = lane & 15, g = lane >> 4, rowq = row0 + 16 * w + fr;
    const float gamma = head_gamma(h);
    const bf16* vsrc = Z + (size_t)row0 * DIN + C_RV + h * 512;
    v4u vreg[4];
#define RO1_LOAD(ec_) do { _Pragma("unroll") for (int it = 0; it < 4; ++it) { const int p = tid + 512 * it; vreg[it] = *(const v4u*)(vsrc + (size_t)(p >> 4) * DIN + (ec_) * 128 + (p & 15) * 8); } } while (0)
#define RO1_WRITE(buf_) do { _Pragma("unroll") for (int it = 0; it < 4; ++it) { const int p = tid + 512 * it; *(LAS v4u*)(lds + (buf_) * RO1_VBUF + (p >> 4) * RO1_VSTRIDE + (p & 15) * 16) = vreg[it]; } } while (0)
    RO1_LOAD(0);
    bf16x8 qf[8];
#pragma unroll
    for (int ks = 0; ks < 8; ++ks) qf[ks] = ldg16(Z + (size_t)rowq * DIN + C_RQ + h * 256 + ks * 32 + 8 * g);
    f32x4 st[8];
#pragma unroll
    for (int jt = 0; jt < 8; ++jt) { st[jt] = (f32x4){0.f, 0.f, 0.f, 0.f};
        if (jt <= w) { const bf16* kp = Z + (size_t)(row0 + 16 * jt + fr) * DIN + C_RK + h * 256 + 8 * g; f32x4 a = (f32x4){0.f, 0.f, 0.f, 0.f};
#pragma unroll
            for (int ks = 0; ks < 8; ++ks) a = MFMA16(ldg16(kp + ks * 32), qf[ks], a);
            if (jt == w) {
#pragma unroll
                for (int r = 0; r < 4; ++r) if (4 * g + r > fr) a[r] = 0.f; }
            st[jt] = a; } }
    bf16x8 pf[4];
#pragma unroll
    for (int kk = 0; kk < 4; ++kk) pf[kk] = pack8(st[2 * kk], st[2 * kk + 1]);
    RO1_WRITE(0); LDS_WAIT(); __syncthreads();
    f32x4 o[32];
    const bf16* rtp = RT + ((size_t)(((b * 4 + h) * 64 + n) * 512) + fr) * 256 + 8 * g;
    LAS unsigned char* vb0 = lds + (4 * g + (fr >> 2)) * RO1_VSTRIDE + (fr & 3) * 8;
#pragma unroll
    for (int ec = 0; ec < 4; ++ec) {
        if (ec < 3) RO1_LOAD(ec + 1);
        LAS unsigned char* vb = vb0 + (ec & 1) * RO1_VBUF;
#pragma unroll
        for (int e8 = 0; e8 < 8; ++e8) { const int et = 8 * ec + e8; f32x4 a = (f32x4){0.f, 0.f, 0.f, 0.f};
#pragma unroll
            for (int ks = 0; ks < 8; ++ks) a = MFMA16(ldg16(rtp + (size_t)et * 16 * 256 + ks * 32), qf[ks], a);
            a = a * gamma;
#pragma unroll
            for (int kk = 0; kk < 4; ++kk) if (2 * kk <= w) {
                const bf16x8 af = cat8(lds_tr(vb + (32 * kk) * RO1_VSTRIDE + e8 * 32), lds_tr(vb + (32 * kk + 16) * RO1_VSTRIDE + e8 * 32));
                a = MFMA16(af, pf[kk], a); }
            o[et] = a; }
        if (ec < 3) RO1_WRITE((ec + 1) & 1);
        LDS_WAIT(); __syncthreads();
    }
    float ss = 0.f;
#pragma unroll
    for (int et = 0; et < 32; ++et) ss += (o[et][0] * o[et][0] + o[et][1] * o[et][1]) + (o[et][2] * o[et][2] + o[et][3] * o[et][3]);
    ss += __shfl_xor(ss, 16); ss += __shfl_xor(ss, 32);
    const float rn = 1.0f / sqrtf(ss * (1.0f / 512.0f) + EPS);
    const bf16* rgp = Z + (size_t)rowq * DIN + C_RG + h * 512 + 4 * g; bf16* op = ACAT + (size_t)rowq * KCAT + h * 512 + 4 * g;
#pragma unroll
    for (int et = 0; et < 32; ++et) { const v2u rg = *(const v2u*)(rgp + 16 * et);
        v2u ov; ov.x = cvt_pk_bf16(bf_lo(rg.x) * o[et][0] * rn, bf_hi(rg.x) * o[et][1] * rn); ov.y = cvt_pk_bf16(bf_lo(rg.y) * o[et][2] * rn, bf_hi(rg.y) * o[et][3] * rn);
        *(v2u*)(op + 16 * et) = ov; }
#undef RO1_LOAD
#undef RO1_WRITE
}
#ifndef NEW_RET
#define NEW_RET 1
#endif
#ifndef NEW_ATTN
#define NEW_ATTN 1
#endif
#ifndef NEW_RETOUT
#define NEW_RETOUT 1
#endif
#ifndef SUB_MASK
#define SUB_MASK 7
#endif
#ifndef DUP_MASK
#define DUP_MASK 0u
#endif
#define DUPN(k_) (1 + (int)((DUP_MASK >> (k_)) & 1u))
#ifndef SITE_MASK
#define SITE_MASK 0xFFFFFFFFu
#endif

struct Params { const float* in[22]; float* out; unsigned char* ws; int ph_lo, ph_hi; };
typedef __attribute__((address_space(4))) const unsigned char* kargp_t;
typedef GAS unsigned char* g_u8p; typedef GAS float* g_f32p; typedef const GAS float* g_cf32p;
typedef __attribute__((address_space(4))) const g_u8p* kslot_u8; typedef __attribute__((address_space(4))) const g_f32p* kslot_f32; typedef __attribute__((address_space(4))) const g_cf32p* kslot_cf32;

__global__ void __launch_bounds__(NWAVES * 64, 2) fwd_kernel(Params P) {
    extern __shared__ __attribute__((aligned(16))) unsigned char lds_raw[];
    LAS unsigned char* lds = (LAS unsigned char*)lds_raw;
    const int wave = __builtin_amdgcn_readfirstlane((int)threadIdx.x >> 6);
    for (int u = threadIdx.x; u < (LDS_BYTES - LDSCTL_OFF) / 4; u += NWAVES * 64) ((LAS unsigned*)(lds + LDSCTL_OFF))[u] = 0u;
    __syncthreads();
#if MK_PER_PHASE
    XcdBarrier bar; bar.bar = nullptr; bar.x = 0; bar.st = nullptr;
#else
    XcdBarrier bar = xcd_barrier_post((unsigned*)(P.ws + WS_CTL) + CW_BAR, (volatile LAS unsigned*)(lds + MISC_OFF) + 8);
#endif
    const int lo = P.ph_lo, hi = P.ph_hi;
    int ph = 0, site = 0;
#define IN_PH(k_) (((SITE_MASK >> (k_)) & 1u) && lo <= ph && ph < hi)
#define PH_IDS() int lanep; asm volatile("v_mbcnt_lo_u32_b32 %0, -1, 0\n\tv_mbcnt_hi_u32_b32 %0, -1, %0" : "=v"(lanep)); const int tidp = wave * 64 + lanep; (void)tidp; \
    kargp_t ka_ = (kargp_t)__builtin_amdgcn_kernarg_segment_ptr(); asm volatile("" : "+s"(ka_)); \
    unsigned char* const ws = (unsigned char*)*(kslot_u8)(ka_ + 184); (void)ws; \
    int G = gridDim.x, wg = blockIdx.x; asm volatile("" : "+s"(G), "+s"(wg)); const int gw = wg * NWAVES + wave, NGW = G * NWAVES; (void)gw; (void)NGW
#define KIN(i) ((const float*)*(kslot_cf32)(ka_ + 8 * (i)))
#define KOUT() ((float*)*(kslot_f32)(ka_ + 176))
#if MK_PER_PHASE
#define END_PH() do { ++ph; } while (0)
#else
#define END_PH() do { ++ph; xcd_barrier(bar, wave); } while (0)
#endif
#define WSP(T_, off_) ((T_*)(ws + (off_)))
    (void)site;

    for (int l = 0; l < DEPTH; ++l) {
        if (IN_PH(0)) for (int rep_ = 0; rep_ < DUPN(0); ++rep_) { PH_IDS();
            LAS float* scr = (LAS float*)(lds + RING_OFF + wave * 16384);
            unsigned char* wb = ws + WS_W;
            const size_t oGU = (size_t)l * D * FF, oD = (size_t)l * FF * D;
            { ConvMat c{KIN(2) + oGU, (bf16*)(wb + WO_GU1), D, FF, D, 0, 1, KIN(1) + (size_t)l * D}; conv_matrix(c, scr, gw, NGW, lanep); }
            { ConvMat c{KIN(3) + oGU, (bf16*)(wb + WO_GU1), D, FF, D, 0, 2, KIN(1) + (size_t)l * D}; conv_matrix(c, scr, gw, NGW, lanep); }
            { ConvMat c{KIN(4) + oD, (bf16*)(wb + WO_D1), FF, D, FF, 0, 0, nullptr}; conv_matrix(c, scr, gw, NGW, lanep); }
            { ConvMat c{KIN(6) + (size_t)l * D * DIN, (bf16*)(wb + WO_IN), D, DIN, D, 0, 0, KIN(5) + (size_t)l * D}; conv_matrix(c, scr, gw, NGW, lanep); }
            { ConvMat c{KIN(13) + (size_t)l * 2048 * D, (bf16*)(wb + WO_CAT), 2048, D, KCAT, 0, 0, nullptr}; conv_matrix(c, scr, gw, NGW, lanep); }
            { ConvMat c{KIN(14) + (size_t)l * 1024 * D, (bf16*)(wb + WO_CAT), 1024, D, KCAT, 2048, 0, nullptr}; conv_matrix(c, scr, gw, NGW, lanep); }
            { ConvMat c{KIN(15) + (size_t)l * 1024 * D, (bf16*)(wb + WO_CAT), 1024, D, KCAT, 3072, 0, nullptr}; conv_matrix(c, scr, gw, NGW, lanep); }
            { ConvMat c{KIN(16) + (size_t)l * D * D, (bf16*)(wb + WO_OUT), D, D, D, 0, 0, nullptr}; conv_matrix(c, scr, gw, NGW, lanep); }
            { ConvMat c{KIN(18) + oGU, (bf16*)(wb + WO_GU2), D, FF, D, 0, 1, KIN(17) + (size_t)l * D}; conv_matrix(c, scr, gw, NGW, lanep); }
            { ConvMat c{KIN(19) + oGU, (bf16*)(wb + WO_GU2), D, FF, D, 0, 2, KIN(17) + (size_t)l * D}; conv_matrix(c, scr, gw, NGW, lanep); }
            { ConvMat c{KIN(20) + oD, (bf16*)(wb + WO_D2), FF, D, FF, 0, 0, nullptr}; conv_matrix(c, scr, gw, NGW, lanep); }
            const int gt = wg * (NWAVES * 64) + tidp, NGT = G * NWAVES * 64;
            { const float* sw = KIN(10) + (size_t)l * 4 * 128 * 128; bf16* WCb = WSP(bf16, WS_WC);
              for (int i = gt; i < 4 * 128 * 128; i += NGT) { const int s = i & 127, t = (i >> 7) & 127; WCb[i] = (bf16)(s <= t ? f2bf(sw[i]) : 0u); } }
            if (l == 0) {
                { const float* xin0 = KIN(0); bf16* XB = WSP(bf16, WS_XB); float* PART = WSP(float, WS_PART);
                  for (int m = gw; m < M; m += NGW) x_row_prep(xin0 + (size_t)m * D, XB + (size_t)m * D, PART + (size_t)m * 32, lanep); }
                float* ROPEC = WSP(float, WS_ROPEC); float* ROPES = WSP(float, WS_ROPES); float* BIAS = WSP(float, WS_BIAS); const float* relb = KIN(12);
                for (int i = gt; i < T * 128; i += NGT) { const int pos = i >> 7, fi = i & 127;
                    double inv = 1.0;
                    if (fi & 1) inv *= 0.930572040929699; if (fi & 2) inv *= 0.8659643233600654; if (fi & 4) inv *= 0.7498942093324559; if (fi & 8) inv *= 0.5623413251903491;
                    if (fi & 16) inv *= 0.31622776601683794; if (fi & 32) inv *= 0.1; if (fi & 64) inv *= 0.01;
                    const double ang = (double)pos * inv; const double k = __builtin_rint(ang * 0.15915494309189535);
                    double red = __builtin_fma(-k, 6.283185307179586, ang); red = __builtin_fma(-k, 2.4492935982947064e-16, red);
                    const float rf = (float)red; ROPEC[i] = cosf(rf); ROPES[i] = sinf(rf); }
                for (int i = gt; i < 3 * 8 * 132; i += NGT) { const int st = i % 132, hh = (i / 132) % 8, cfg = i / (132 * 8); float v = 0.f;
                    if (st <= 128) { const int dist = st << (2 * cfg); int bk;
                        if (dist < 16) bk = dist; else { bk = 16 + (int)(logf((float)dist / 16.0f) / 4.852030263919617f * 16.0f); bk = bk > 31 ? 31 : bk; }
                        v = relb[bk * 8 + hh] * LOG2E; }
                    BIAS[i] = v; }
            }
        }
        END_PH();
        for (int half = 0; half < 2; ++half) {
            const bool first = (l == 0 && half == 0);
            if (IN_PH(2)) for (int rep_ = 0; rep_ < DUPN(2); ++rep_) { PH_IDS(); pg8::Gemm g{WSP(const bf16, WS_XB), (const bf16*)(ws + WS_W + (half ? WO_GU2 : WO_GU1)), M, 2 * FF, D}; pg8::StaticOrder S; S.init(M, 2 * FF, G, wg);
                pg8::EpiGU E{WSP(bf16, WS_Z), WSP(const float, WS_PART)}; pg8::gemm_phase<pg8::EpiGU, pg8::StaticOrder, true, true>(lds + RING_OFF, g, S, E, wave); }
            END_PH();
            if (IN_PH(3)) for (int rep_ = 0; rep_ < DUPN(3); ++rep_) { PH_IDS(); pg8::Gemm g{WSP(const bf16, WS_Z), (const bf16*)(ws + WS_W + (half ? WO_D2 : WO_D1)), M, D, FF}; pg8::StaticOrder S; S.init(M, D, G, wg, 4);
                const float* xin = first ? KIN(0) : WSP(const float, WS_X);
                pg8::EpiRes E{xin, WSP(float, WS_X), WSP(bf16, WS_XB), WSP(float, WS_PART), 0.5f}; pg8::gemm_phase<pg8::EpiRes, pg8::StaticOrder, true, true>(lds + RING_OFF, g, S, E, wave); }
            END_PH();
            if (half == 0) {
                if (IN_PH(5)) for (int rep_ = 0; rep_ < DUPN(5); ++rep_) { PH_IDS(); pg8::Gemm g{WSP(const bf16, WS_XB), (const bf16*)(ws + WS_W + WO_IN), M, DIN, D}; pg8::StaticOrder S; S.init(M, DIN, G, wg);
                    pg8::EpiWin E{WSP(bf16, WS_Z), KIN(7) + (size_t)l * 3 * D, WSP(const float, WS_ROPEC), WSP(const float, WS_ROPES), WSP(const float, WS_PART)};
                    pg8::gemm_phase<pg8::EpiWin, pg8::StaticOrder, true, true>(lds + RING_OFF, g, S, E, wave); }
                END_PH();
                if (IN_PH(6)) for (int rep_ = 0; rep_ < DUPN(6); ++rep_) { PH_IDS();
#if NEW_RET == 2
                    { for (int it = wg; it < 64; it += G) scan_unit(lds, WSP(const bf16, WS_Z), WSP(bf16, WS_RT), it, wave, lanep); }
                    { PH_IDS(); cs_phase(lds, WSP(const bf16, WS_Z), WSP(bf16, WS_END), wg, G, wave, lanep); }
#if DBG_CMP == 2
                    { PH_IDS(); cs_phase(lds, WSP(const bf16, WS_Z), WSP(bf16, WS_END + 128 * MiB), wg, G, wave, lanep); }
#endif
#elif NEW_RET
                    if (SUB_MASK & 1) cs_phase(lds, WSP(const bf16, WS_Z), WSP(bf16, WS_RT), wg, G, wave, lanep);
#else
                    if (SUB_MASK & 1) { for (int it = wg; it < 64; it += G) scan_unit(lds, WSP(const bf16, WS_Z), WSP(bf16, WS_RT), it, wave, lanep); }
#endif
#if NEW_ATTN
                    if (SUB_MASK & 2) { PH_IDS(); for (int it = wg; it < 768; it += G) attn_run(lds, WSP(const bf16, WS_Z), WSP(bf16, WS_OPART), WSP(float, WS_LSE), WSP(const float, WS_BIAS), it, wave, lanep); }
#else
                    if (SUB_MASK & 2) { PH_IDS(); for (int it = wg; it < 3072; it += G) attn_unit(lds, WSP(const bf16, WS_Z), WSP(bf16, WS_OPART), WSP(float, WS_LSE), WSP(const float, WS_BIAS), it, wave, lanep); }
#endif
                    if (SUB_MASK & 4) { PH_IDS(); for (int it = wg; it < 512; it += G)
                        sgu_unit(lds, WSP(const bf16, WS_Z), WSP(bf16, WS_ACAT), WSP(const bf16, WS_WC), KIN(8) + (size_t)l * 1024, KIN(9) + (size_t)l * 1024, KIN(11) + (size_t)l * 512, it, wave, lanep); }
                }
                END_PH();
                if (IN_PH(11)) for (int rep_ = 0; rep_ < DUPN(11); ++rep_) { PH_IDS();
                    const int gt = wg * (NWAVES * 64) + tidp, NGT = G * NWAVES * 64;
#if NEW_RET == 2
#if DBG_CMP != 2
                    prefix_phase(WSP(bf16, WS_END), gt, NGT);
#endif
#elif NEW_RET
                    if (rep_ == 0) prefix_phase(WSP(bf16, WS_RT), gt, NGT);
#endif
                    const float* LSE = WSP(const float, WS_LSE); const bf16* OPART = WSP(const bf16, WS_OPART); bf16* ACAT = WSP(bf16, WS_ACAT);
                    for (int p = gt; p < M * 128; p += NGT) { const int row = p >> 7, hh = (p >> 4) & 7, c8 = (p & 15) * 8;
                        const float l0 = LSE[((size_t)0 * M + row) * 8 + hh], l1 = LSE[((size_t)1 * M + row) * 8 + hh], l2 = LSE[((size_t)2 * M + row) * 8 + hh];
                        const float mx = fmaxf(l0, fmaxf(l1, l2)); float w0 = __builtin_amdgcn_exp2f(l0 - mx), w1 = __builtin_amdgcn_exp2f(l1 - mx), w2 = __builtin_amdgcn_exp2f(l2 - mx);
                        const float rs = 1.0f / (w0 + w1 + w2); w0 *= rs; w1 *= rs; w2 *= rs;
                        const size_t o = (size_t)row * 1024 + hh * 128 + c8;
                        const v4u a = *(const v4u*)(OPART + o), b = *(const v4u*)(OPART + (size_t)M * 1024 + o), c = *(const v4u*)(OPART + (size_t)2 * M * 1024 + o);
                        v4u r;
                        r.x = cvt_pk_bf16(w0 * bf_lo(a.x) + w1 * bf_lo(b.x) + w2 * bf_lo(c.x), w0 * bf_hi(a.x) + w1 * bf_hi(b.x) + w2 * bf_hi(c.x));
                        r.y = cvt_pk_bf16(w0 * bf_lo(a.y) + w1 * bf_lo(b.y) + w2 * bf_lo(c.y), w0 * bf_hi(a.y) + w1 * bf_hi(b.y) + w2 * bf_hi(c.y));
                        r.z = cvt_pk_bf16(w0 * bf_lo(a.z) + w1 * bf_lo(b.z) + w2 * bf_lo(c.z), w0 * bf_hi(a.z) + w1 * bf_hi(b.z) + w2 * bf_hi(c.z));
                        r.w = cvt_pk_bf16(w0 * bf_lo(a.w) + w1 * bf_lo(b.w) + w2 * bf_lo(c.w), w0 * bf_hi(a.w) + w1 * bf_hi(b.w) + w2 * bf_hi(c.w));
                        *(v4u*)(ACAT + (size_t)row * KCAT + 3072 + hh * 128 + c8) = r; }
                }
                END_PH();
                if (IN_PH(7)) for (int rep_ = 0; rep_ < DUPN(7); ++rep_) { PH_IDS();
#if NEW_RET == 2 && defined(DBG_CMP)
                    { const bf16* A_ = (DBG_CMP == 2) ? WSP(const bf16, WS_END + 128 * MiB) : WSP(const bf16, WS_RT); const bf16* B_ = WSP(const bf16, WS_END); float dmx = 0.f;
                      for (size_t i = (size_t)wg * 512 + tidp; i < (size_t)8 * 64 * 512 * 256; i += (size_t)G * 512) { if (DBG_CMP == 2 && ((i >> 17) & 63) == 63) continue; const float d_ = fabsf(__uint_as_float((unsigned)A_[i] << 16) - __uint_as_float((unsigned)B_[i] << 16)); dmx = d_ > dmx ? d_ : dmx; }
                      atomicMax(WSP(unsigned, WS_CTL) + 64, __float_as_uint(dmx)); }
#endif
#if NEW_RETOUT
                    for (int it = wg; it < 512; it += G) retout_unit(lds, WSP(const bf16, WS_Z), WSP(const bf16, WS_RT), WSP(bf16, WS_ACAT), it, wave, lanep);
#else
                    for (int it = wg; it < 512; it += G) retout_old_unit(lds, WSP(const bf16, WS_Z), WSP(const bf16, WS_RT), WSP(bf16, WS_ACAT), it, wave, lanep);
#endif
                }
                END_PH();
                if (IN_PH(8)) for (int rep_ = 0; rep_ < DUPN(8); ++rep_) { PH_IDS(); pg8::Gemm g{WSP(const bf16, WS_ACAT), (const bf16*)(ws + WS_W + WO_CAT), M, D, KCAT}; pg8::StaticOrder S; S.init(M, D, G, wg, 4);
                    pg8::EpiProj E{WSP(const bf16, WS_Z), WSP(bf16, WS_MERGED)}; pg8::gemm_phase<pg8::EpiProj, pg8::StaticOrder, true, true>(lds + RING_OFF, g, S, E, wave); }
                END_PH();
                if (IN_PH(9)) for (int rep_ = 0; rep_ < DUPN(9); ++rep_) { PH_IDS(); pg8::Gemm g{WSP(const bf16, WS_MERGED), (const bf16*)(ws + WS_W + WO_OUT), M, D, D}; pg8::StaticOrder S; S.init(M, D, G, wg, 4);
                    pg8::EpiRes E{WSP(const float, WS_X), WSP(float, WS_X), WSP(bf16, WS_XB), WSP(float, WS_PART), 1.0f}; pg8::gemm_phase<pg8::EpiRes, pg8::StaticOrder, true, true>(lds + RING_OFF, g, S, E, wave); }
                END_PH();
            }
        }
    }
    if (IN_PH(10)) for (int rep_ = 0; rep_ < DUPN(10); ++rep_) { PH_IDS(); const float* X = WSP(const float, WS_X); const float* gain = KIN(21); float* out = KOUT();
        for (int m = gw; m < M; m += NGW) rms_row<true>(X + (size_t)m * D, gain, out + (size_t)m * D, lanep);
#if NEW_RET == 2 && defined(DBG_CMP)
        { asm volatile("s_waitcnt vmcnt(0)" ::: "memory"); const float dv = 1000.0f * __uint_as_float(__hip_atomic_load(WSP(unsigned, WS_CTL) + 64, __ATOMIC_RELAXED, __HIP_MEMORY_SCOPE_AGENT)); for (int m = gw; m < M; m += NGW) for (int c = lanep; c < D; c += 64) out[(size_t)m * D + c] = dv; }
#endif
    }
#undef IN_PH
#undef END_PH
}
constexpr int N_PHASES = DEPTH * (1 + 2 + 6 + 2) + 1;

extern "C" void kernel_launch(void* const* d_in, const int* in_sizes, int n_in, void* d_out, int out_size, void* d_ws, size_t ws_size, hipStream_t stream) {
    static int grid = 0;
    if (grid == 0) {
        if (n_in != 22 || ws_size < WS_END) { fprintf(stderr, "kernel_launch: unexpected n_in %d / ws %zu\n", n_in, ws_size); grid = -1; return; }
        int dev = 0, cus = 0, per_cu = 0;
        if (hipGetDevice(&dev) != hipSuccess || hipDeviceGetAttribute(&cus, hipDeviceAttributeMultiprocessorCount, dev) != hipSuccess) { grid = -1; return; }
        if (hipFuncSetAttribute((const void*)fwd_kernel, hipFuncAttributeMaxDynamicSharedMemorySize, LDS_BYTES) != hipSuccess) { fprintf(stderr, "kernel_launch: hipFuncSetAttribute failed\n"); grid = -1; return; }
        if (hipOccupancyMaxActiveBlocksPerMultiprocessor(&per_cu, (const void*)fwd_kernel, NWAVES * 64, LDS_BYTES) != hipSuccess || per_cu < 1)
            fprintf(stderr, "kernel_launch: occupancy query reports %d workgroups per CU\n", per_cu);
        (void)hipGetLastError();
        grid = cus;
    }
    if (grid < 0) return;
    (void)hipMemsetAsync((char*)d_ws + WS_CTL, 0, CTL_ZERO_BYTES, stream);
    Params p{};
    for (int i = 0; i < 22; ++i) p.in[i] = (const float*)d_in[i];
    p.out = (float*)d_out; p.ws = (unsigned char*)d_ws;
#if MK_PER_PHASE
    for (int k = 0; k < N_PHASES; ++k) { p.ph_lo = k; p.ph_hi = k + 1; hipLaunchKernelGGL(fwd_kernel, dim3(grid), dim3(NWAVES * 64), LDS_BYTES, stream, p); }
#else
    p.ph_lo = 0; p.ph_hi = N_PHASES;
    hipLaunchKernelGGL(fwd_kernel, dim3(grid), dim3(NWAVES * 64), LDS_BYTES, stream, p);
#endif
}
```

```cpp
#include <hip/hip_runtime.h>
#include <cstdio>
#include <cstdint>

#ifndef MK_PER_PHASE
#define MK_PER_PHASE 0
#endif

namespace pg8 {
#define PG8_LAS __attribute__((address_space(3)))
typedef unsigned short bf16_t;
typedef short bf16x8 __attribute__((ext_vector_type(8)));
typedef float f32x4 __attribute__((ext_vector_type(4)));
typedef unsigned u32x4 __attribute__((ext_vector_type(4)));
typedef unsigned u32x2 __attribute__((ext_vector_type(2)));
constexpr int BM = 256, BK = 64, HALF = 128, HTB = HALF * BK * 2  , STAGE_BYTES = 8 * HTB, NXCD = 8, WGM = 8;

__host__ __device__ __forceinline__ int lds_byte(int r, int c) { const int st = (r >> 4) * 2 + (c >> 5), rr = r & 15, cc = c & 31, ob = rr * 64 + cc * 2; return st * 1024 + (ob ^ (((ob >> 9) & 1) << 5)); }
__host__ __device__ __forceinline__ void stage_rc(int b, int& R, int& C) { const int st = b / 1024, sb = b % 1024, swz = sb ^ (((sb >> 9) & 1) << 5); R = (st >> 1) * 16 + swz / 64; C = (st & 1) * 32 + (swz % 64) / 2; }
__host__ __device__ __forceinline__ int perm32(int rho) { const int n = rho >> 4, i = rho & 15; return 8 * (i >> 2) + 4 * n + (i & 3); }

struct Unit { int pm, pn; };
struct Gemm { const bf16_t* A; const bf16_t* Bt; int M, N, K; };

struct StaticOrder {
    int nM, nN, nwg, G, c, wgm;
    __host__ __device__ void init(int M, int N, int G_, int c_, int wgm_ = WGM) { nM = M / BM; nN = N / BM; nwg = nM * nN; G = G_; c = c_; wgm = wgm_; }
    __host__ __device__ bool next(int i, Unit& u) const {
        const long L = (long)i * G + c; if (L >= nwg) return false;
        int wgid = (int)L; { const int q = nwg / NXCD, r = nwg % NXCD, xcd = wgid % NXCD, off = wgid / NXCD; wgid = (xcd < r ? xcd * (q + 1) : r * (q + 1) + (xcd - r) * q) + off; }
        const int nig = wgm * nN, gid = wgid / nig, fm = gid * wgm, gsz = (nM - fm) < wgm ? (nM - fm) : wgm;
        u.pm = fm + ((wgid % nig) % gsz); u.pn = (wgid % nig) / gsz; return true;
    }
    __device__ __forceinline__ void a_ready(const Unit&) const {}
    __device__ __forceinline__ void done(const Unit&) const {}
};

typedef float f32x2v_t __attribute__((ext_vector_type(2))); typedef __bf16 bf16x2v_t __attribute__((ext_vector_type(2)));
__device__ __forceinline__ unsigned cvt_pk_bf16(float lo, float hi) { const f32x2v_t v = {lo, hi}; const bf16x2v_t b = __builtin_convertvector(v, bf16x2v_t); return __builtin_bit_cast(unsigned, b); }
__device__ __forceinline__ float bf_lo(unsigned w) { return __uint_as_float(w << 16); }
__device__ __forceinline__ float bf_hi(unsigned w) { return __uint_as_float(w & 0xffff0000u); }
__device__ __forceinline__ float fast_sigmoid(float x) { return __builtin_amdgcn_rcpf(1.0f + __builtin_amdgcn_exp2f(-1.4426950408889634f * x)); }
__device__ __forceinline__ float silu_f(float x) { return x * fast_sigmoid(x); }
__device__ __forceinline__ float gelu_tanh_f(float x) { const float u = 0.7978845608028654f * (x + 0.044715f * x * x * x); return x * fast_sigmoid(2.0f * u); }

template <class Epi, class Sched, bool ALIGN_EPI = false, bool SP2 = false>
__device__ __forceinline__ void gemm_phase(PG8_LAS unsigned char* lds, const Gemm g, const Sched& S, const Epi& E, int wid) {
    int lane_; asm volatile("v_mbcnt_lo_u32_b32 %0, -1, 0\n\tv_mbcnt_hi_u32_b32 %0, -1, %0" : "=v"(lane_));
    const int lane = lane_, tid = wid * 64 + lane, wr = wid >> 2, wc = wid & 3, fr = lane & 15, fq = lane >> 4;
    const int K = g.K, nt = K / BK;
    unsigned voffA[2], voffB[2];
#pragma unroll
    for (int i = 0; i < 2; ++i) { int R, C; stage_rc(tid * 16 + i * 8192, R, C); const int Rb = Epi::PERM ? ((R & ~31) + perm32(R & 31)) : R;
        voffA[i] = (unsigned)(R * K + C) * 2u; voffB[i] = (unsigned)(Rb * K + C) * 2u; }
    const size_t kstep = (size_t)(BK * 2);
    const size_t hstep = (size_t)HALF * K * 2;
    const size_t tstep = 2 * hstep;
    const unsigned ldsw = (unsigned)wid * 1024u;
    const int aoff = lds_byte(wr * 64 + fr, fq * 8), boff = lds_byte(wc * 32 + fr, fq * 8);
#define PG8_SA(b, h) (((b) * 2 + (h)) * HTB)
#define PG8_SB(b, h) ((4 + (b) * 2 + (h)) * HTB)
#define PG8_STAGE(bufoff, gbase, voff) do { _Pragma("unroll") for (int _i = 0; _i < 2; ++_i) \
        __builtin_amdgcn_global_load_lds((const unsigned*)((const char*)(gbase) + (voff)[_i]), (PG8_LAS unsigned*)(lds + (bufoff) + ldsw + _i * 8192), 16, 0, 0); } while (0)
#define PG8_LDA(dst, b, h) do { _Pragma("unroll") for (int m = 0; m < 4; ++m) _Pragma("unroll") for (int k = 0; k < 2; ++k) dst[m][k] = *(const PG8_LAS bf16x8*)(lds + PG8_SA(b, h) + aoff + m * 2048 + k * 1024); } while (0)
#define PG8_LDB(dst, b, h) do { _Pragma("unroll") for (int n = 0; n < 2; ++n) _Pragma("unroll") for (int k = 0; k < 2; ++k) dst[n][k] = *(const PG8_LAS bf16x8*)(lds + PG8_SB(b, h) + boff + n * 2048 + k * 1024); } while (0)
#define PG8_MMA(ai, bj, At, Bt) do { __builtin_amdgcn_s_setprio(1); _Pragma("unroll") for (int m = 0; m < 4; ++m) _Pragma("unroll") for (int n = 0; n < 2; ++n) _Pragma("unroll") for (int k = 0; k < 2; ++k) \
        acc[ai][bj][m][n] = __builtin_amdgcn_mfma_f32_16x16x32_bf16(Bt[n][k], At[m][k], acc[ai][bj][m][n], 0, 0, 0); __builtin_amdgcn_s_setprio(0); } while (0)
#define PG8_WAIT_V(n) asm volatile("s_waitcnt vmcnt(" #n ")" ::: "memory")
#define PG8_WAIT_L(n) asm volatile("s_waitcnt lgkmcnt(" #n ")" ::: "memory")
#define PG8_BAR __builtin_amdgcn_s_barrier()
#define PG8_SCHED __builtin_amdgcn_sched_barrier(0)
    Unit cur, nxt; int ui = 0;
    if (!S.next(0, cur)) return;
    f32x4 acc[2][2][4][2];
#pragma unroll
    for (int a = 0; a < 2; ++a)
#pragma unroll
        for (int b = 0; b < 2; ++b)
#pragma unroll
            for (int m = 0; m < 4; ++m)
#pragma unroll
                for (int n = 0; n < 2; ++n) acc[a][b][m][n] = (f32x4){0.f, 0.f, 0.f, 0.f};
    bf16x8 At[4][2], B0[2][2], B1[2][2];
    const char* cA = (const char*)g.A + (size_t)cur.pm * tstep; const char* cB = (const char*)g.Bt + (size_t)cur.pn * tstep;
    S.a_ready(cur);
    if constexpr (SP2) {
        PG8_STAGE(PG8_SB(0, 0), cB, voffB); PG8_STAGE(PG8_SB(0, 1), cB + hstep, voffB); PG8_STAGE(PG8_SA(0, 0), cA, voffA); PG8_STAGE(PG8_SA(0, 1), cA + hstep, voffA);
        if (wr == 1) PG8_BAR;
        PG8_WAIT_V(2); PG8_BAR;
        PG8_STAGE(PG8_SB(1, 0), cB + kstep, voffB); PG8_STAGE(PG8_SA(1, 0), cA + kstep, voffA); PG8_STAGE(PG8_SB(1, 1), cB + hstep + kstep, voffB);
        PG8_WAIT_V(6); PG8_BAR;
    } else {
        PG8_STAGE(PG8_SB(0, 0), cB, voffB); PG8_STAGE(PG8_SA(0, 0), cA, voffA); PG8_STAGE(PG8_SB(0, 1), cB + hstep, voffB); PG8_STAGE(PG8_SA(0, 1), cA + hstep, voffA);
        if (wr == 1) PG8_BAR;
        PG8_WAIT_V(4); PG8_BAR;
        PG8_STAGE(PG8_SB(1, 0), cB + kstep, voffB); PG8_STAGE(PG8_SA(1, 0), cA + kstep, voffA); PG8_STAGE(PG8_SB(1, 1), cB + hstep + kstep, voffB);
        PG8_WAIT_V(6); PG8_BAR;
    }
    for (;;) {
        const bool has_next = S.next(ui + 1, nxt);
        const char* nA = has_next ? (const char*)g.A + (size_t)nxt.pm * tstep : cA; const char* nB = has_next ? (const char*)g.Bt + (size_t)nxt.pn * tstep : cB;
        for (int t = 0; t < nt; t += 2) {
            const bool last = (t == nt - 2);
            const char* a1 = cA + (size_t)(t + 1) * kstep;
            const char* a2 = last ? nA : cA + (size_t)(t + 2) * kstep; const char* b2 = last ? nB : cB + (size_t)(t + 2) * kstep;
            const char* a3 = a2 + kstep; const char* b3 = b2 + kstep;
            if (last && has_next) S.a_ready(nxt);
            if constexpr (Epi::MID) { if (t == Epi::MID_T0 || t == Epi::MID_T1) E.mid(acc, cur, t, wr, wc, fr, fq); }
            if constexpr (SP2) {
            PG8_LDB(B0, 0, 0); PG8_LDB(B1, 0, 1); PG8_SCHED; PG8_LDA(At, 0, 0); PG8_STAGE(PG8_SA(1, 1), a1 + hstep, voffA);
            PG8_WAIT_V(8); PG8_WAIT_L(0); PG8_BAR; PG8_MMA(0, 0, At, B0); PG8_MMA(0, 1, At, B1); PG8_BAR; PG8_SCHED;
            PG8_LDA(At, 0, 1); PG8_STAGE(PG8_SB(0, 0), b2, voffB); PG8_STAGE(PG8_SB(0, 1), b2 + hstep, voffB); PG8_STAGE(PG8_SA(0, 0), a2, voffA);
            PG8_WAIT_V(8); PG8_WAIT_L(0); PG8_BAR; PG8_MMA(1, 0, At, B0); PG8_MMA(1, 1, At, B1); PG8_BAR; PG8_SCHED;
            PG8_LDB(B0, 1, 0); PG8_LDB(B1, 1, 1); PG8_SCHED; PG8_LDA(At, 1, 0); PG8_STAGE(PG8_SA(0, 1), a2 + hstep, voffA);
            PG8_WAIT_V(8); PG8_WAIT_L(0); PG8_BAR; PG8_MMA(0, 0, At, B0); PG8_MMA(0, 1, At, B1); PG8_BAR; PG8_SCHED;
            PG8_LDA(At, 1, 1); PG8_STAGE(PG8_SB(1, 0), b3, voffB); PG8_STAGE(PG8_SB(1, 1), b3 + hstep, voffB); PG8_STAGE(PG8_SA(1, 0), a3, voffA);
            PG8_WAIT_V(8); PG8_WAIT_L(0); PG8_BAR; PG8_MMA(1, 0, At, B0); PG8_MMA(1, 1, At, B1); PG8_BAR; PG8_SCHED;
            } else {
            PG8_LDB(B0, 0, 0); PG8_SCHED; PG8_LDA(At, 0, 0); PG8_STAGE(PG8_SA(1, 1), a1 + hstep, voffA);
            PG8_WAIT_L(8); PG8_BAR; PG8_WAIT_L(0); PG8_MMA(0, 0, At, B0); PG8_BAR; PG8_SCHED;
            PG8_LDB(B1, 0, 1); PG8_STAGE(PG8_SB(0, 0), b2, voffB);
            PG8_BAR; PG8_WAIT_L(0); PG8_MMA(0, 1, At, B1); PG8_BAR;
            PG8_LDA(At, 0, 1); PG8_STAGE(PG8_SA(0, 0), a2, voffA);
            PG8_BAR; PG8_WAIT_L(0); PG8_MMA(1, 0, At, B0); PG8_BAR; PG8_SCHED;
            PG8_STAGE(PG8_SB(0, 1), b2 + hstep, voffB);
            PG8_WAIT_V(6); PG8_BAR; PG8_MMA(1, 1, At, B1); PG8_BAR;
            PG8_LDB(B0, 1, 0); PG8_SCHED; PG8_LDA(At, 1, 0); PG8_STAGE(PG8_SA(0, 1), a2 + hstep, voffA);
            PG8_WAIT_L(8); PG8_BAR; PG8_WAIT_L(0); PG8_MMA(0, 0, At, B0); PG8_BAR; PG8_SCHED;
            PG8_LDB(B1, 1, 1); PG8_STAGE(PG8_SB(1, 0), b3, voffB);
            PG8_BAR; PG8_WAIT_L(0); PG8_MMA(0, 1, At, B1); PG8_BAR;
            PG8_LDA(At, 1, 1); PG8_STAGE(PG8_SA(1, 0), a3, voffA);
            PG8_BAR; PG8_WAIT_L(0); PG8_MMA(1, 0, At, B0); PG8_BAR; PG8_SCHED;
            PG8_STAGE(PG8_SB(1, 1), b3 + hstep, voffB);
            PG8_WAIT_V(6); PG8_BAR; PG8_MMA(1, 1, At, B1); PG8_BAR;
            }
        }
        if constexpr (ALIGN_EPI) { if (wr == 0) PG8_BAR; }
        E(acc, cur, wr, wc, fr, fq); S.done(cur);
        if (!has_next) break;
#pragma unroll
        for (int a = 0; a < 2; ++a)
#pragma unroll
            for (int b = 0; b < 2; ++b)
#pragma unroll
                for (int m = 0; m < 4; ++m)
#pragma unroll
                    for (int n = 0; n < 2; ++n) acc[a][b][m][n] = (f32x4){0.f, 0.f, 0.f, 0.f};
        cur = nxt; cA = nA; cB = nB; ++ui;
        if constexpr (ALIGN_EPI) { if (wr == 1) PG8_BAR; }
    }
    PG8_WAIT_V(0);
    if constexpr (!ALIGN_EPI) { if (wr == 0) PG8_BAR; }
    PG8_BAR;
#undef PG8_SA
#undef PG8_SB
#undef PG8_STAGE
#undef PG8_LDA
#undef PG8_LDB
#undef PG8_MMA
#undef PG8_WAIT_V
#undef PG8_WAIT_L
#undef PG8_BAR
#undef PG8_SCHED
}
}

constexpr int BATCH = 2, T = 8192, M = BATCH * T, D = 2048, FF = 5632, DIN = 17408, DEPTH = 4;
constexpr int C_RQ = 0, C_RK = 1024, C_RV = 2048, C_RG = 4096, C_SU = 6144, C_SV = 7168, C_AQ = 8192, C_AK = 9216, C_AV = 10240, C_GL = 11264;
constexpr int KCAT = 4096;
constexpr float EPS = 1e-6f, LOG2E = 1.4426950408889634f;
constexpr int NWAVES = 8;

constexpr size_t MiB = 1u << 20;
constexpr size_t WS_CTL = 0, CTL_ZERO_BYTES = 2 * MiB;
constexpr size_t WS_SVSTAT = 1 * MiB;
constexpr size_t WS_BIAS = 2 * MiB;
constexpr size_t WS_WC = 3 * MiB;
constexpr size_t WS_LSE = 4 * MiB;
constexpr size_t WS_ROPEC = 8 * MiB, WS_ROPES = 12 * MiB;
constexpr size_t WS_W = 16 * MiB;
constexpr size_t WO_GU1 = 0, WO_D1 = 44 * MiB, WO_IN = 66 * MiB, WO_CAT = 134 * MiB, WO_OUT = 150 * MiB, WO_GU2 = 158 * MiB, WO_D2 = 202 * MiB, W_BYTES = 224 * MiB;
constexpr size_t WS_X = 240 * MiB;
constexpr size_t WS_XB = 368 * MiB;
constexpr size_t WS_Z = 432 * MiB;
constexpr size_t WS_RT = 976 * MiB;
constexpr size_t WS_ACAT = 1104 * MiB;
constexpr size_t WS_OPART = 1232 * MiB;
constexpr size_t WS_MERGED = 1328 * MiB;
constexpr size_t WS_END = 1392 * MiB;
constexpr size_t WS_PART = 6 * MiB;
static_assert((size_t)11264 * 2048 * 2 == 44 * MiB && (size_t)2048 * 5632 * 2 == 22 * MiB && (size_t)17408 * 2048 * 2 == 68 * MiB && (size_t)2048 * 4096 * 2 == 16 * MiB, "weight map");
static_assert((size_t)M * DIN * 2 == 544 * MiB && (size_t)M * D * 4 == 128 * MiB, "activation map");
constexpr int CW_TMO = 0, CW_BAR = 4096;

constexpr int RING_OFF = 0, RING_BYTES = 155648;
constexpr int LDSCTL_OFF = RING_BYTES, MISC_OFF = LDSCTL_OFF + 320;
constexpr int LDS_BYTES = 157696;

#define GAS __attribute__((address_space(1)))
#define LAS __attribute__((address_space(3)))
typedef unsigned short bf16;
typedef unsigned v4u __attribute__((ext_vector_type(4)));
typedef unsigned v2u __attribute__((ext_vector_type(2)));
typedef float f32x4 __attribute__((ext_vector_type(4)));
typedef short bf16x8 __attribute__((ext_vector_type(8)));
typedef short s16x4 __attribute__((ext_vector_type(4)));
typedef GAS unsigned gu32;
#define RLX_AGENT __ATOMIC_RELAXED, __HIP_MEMORY_SCOPE_AGENT
#define LDS_WAIT() asm volatile("s_waitcnt lgkmcnt(0)" ::: "memory")
#define VM_WAIT() asm volatile("s_waitcnt vmcnt(0)" ::: "memory")
__device__ __forceinline__ unsigned f2bf(float f) { unsigned u = __builtin_bit_cast(unsigned, f); return (u + 0x7fffu + ((u >> 16) & 1u)) >> 16; }
__device__ __forceinline__ unsigned pk2(float lo, float hi) { return f2bf(lo) | (f2bf(hi) << 16); }
using pg8::cvt_pk_bf16; using pg8::bf_lo; using pg8::bf_hi;

#define XB_TMO      128
#define XB_XCNT(j)  (256  + 64 * (j))
#define XB_XSUB(j)  (1280 + 64 * (j))
#define XB_XGEN(j)  (2304 + 64 * (j))
#define XB_TOP      3328
#define XB_TOPGEN   3392
#define XCD_BAR_WORDS 3456
#define XB_SPIN_CAP (1u << 20)

__device__ __forceinline__ unsigned xb_ld(unsigned* p)              { return __hip_atomic_load(p, __ATOMIC_RELAXED, __HIP_MEMORY_SCOPE_AGENT); }
__device__ __forceinline__ unsigned xb_add(unsigned* p, unsigned v) { return __hip_atomic_fetch_add(p, v, __ATOMIC_RELAXED, __HIP_MEMORY_SCOPE_AGENT); }
__device__ __forceinline__ unsigned xb_xcc_id() { return (unsigned)__builtin_amdgcn_s_getreg((3 << 11) | 20) & 0xFu; }
#define XB_SPIN(cond, bar) do { unsigned _sp = 0; while (cond) { __builtin_amdgcn_s_sleep(1); \
    if ((++_sp & 255u) == 0u) { if (xb_ld(&(bar)[XB_TMO])) break; if (_sp > XB_SPIN_CAP) { atomicAdd(&(bar)[XB_TMO], 1u); break; } } } } while (0)

struct XcdBarrier { unsigned* bar; unsigned x; volatile LAS unsigned* st; };

__device__ __forceinline__ XcdBarrier xcd_barrier_post(unsigned* bar, volatile LAS unsigned* st) {
    XcdBarrier b; b.bar = bar; b.x = xb_xcc_id(); b.st = st;
    if (threadIdx.x == 0) (void)xb_add(&bar[XB_XCNT(b.x)], 1u);
    return b;
}
__device__ __forceinline__ void xcd_barrier_complete(unsigned* bar, unsigned x, unsigned& nloc, unsigned& nx) {
    const unsigned G = gridDim.x * gridDim.y * gridDim.z;
    unsigned sum, cnt, mine, sp = 0u;
    for (;;) {
        sum = 0u; cnt = 0u; mine = 0u;
#pragma unroll
        for (unsigned j = 0; j < 16; ++j) { const unsigned c = xb_ld(&bar[XB_XCNT(j)]); sum += c; cnt += (c > 0u) ? 1u : 0u; mine = (j == x) ? c : mine; }
        if (sum == G) break;
        __builtin_amdgcn_s_sleep(1);
        if ((++sp & 255u) == 0u) { if (xb_ld(&bar[XB_TMO])) break; if (sp > XB_SPIN_CAP) { atomicAdd(&bar[XB_TMO], 1u); break; } }
    }
    nloc = mine > 0u ? mine : 1u; nx = cnt > 0u ? cnt : 1u;
}
__device__ __forceinline__ void xcd_barrier(const XcdBarrier& b, int wave) {
    asm volatile("s_waitcnt vmcnt(0)" ::: "memory");
    __syncthreads();
    int lane0_; asm volatile("v_mbcnt_lo_u32_b32 %0, -1, 0\n\tv_mbcnt_hi_u32_b32 %0, -1, %0" : "=v"(lane0_));
    if (wave == 0 && lane0_ == 0) {
        unsigned* bar = b.bar;
        __builtin_amdgcn_s_waitcnt(0);
        unsigned nloc = b.st[0], nx = b.st[1];
        if (nloc == 0u) { xcd_barrier_complete(bar, b.x, nloc, nx); b.st[0] = nloc; b.st[1] = nx; }
        const unsigned old = xb_add(&bar[XB_XSUB(b.x)], 1u);
        const unsigned gen = old / nloc;
        if (old + 1u == (gen + 1u) * nloc) {
            __builtin_amdgcn_fence(__ATOMIC_RELEASE, "agent");
            asm volatile("s_waitcnt vmcnt(0)" ::: "memory");
            const unsigned og = xb_add(&bar[XB_TOP], 1u);
            const unsigned tg = og / nx;
            if (og + 1u == (tg + 1u) * nx) xb_add(&bar[XB_TOPGEN], 1u);
            else XB_SPIN(xb_ld(&bar[XB_TOPGEN]) == tg, bar);
            __builtin_amdgcn_fence(__ATOMIC_ACQUIRE, "agent");
            xb_add(&bar[XB_XGEN(b.x)], 1u);
            asm volatile("s_waitcnt vmcnt(0)" ::: "memory");
        } else {
            XB_SPIN(xb_ld(&bar[XB_XGEN(b.x)]) == gen, bar);
            __builtin_amdgcn_fence(__ATOMIC_ACQUIRE, "agent");
            asm volatile("s_waitcnt vmcnt(0)" ::: "memory");
        }
    }
    __syncthreads();
}

namespace pg8 {

__device__ __forceinline__ float row_rstd(const float* part, int row, int fq) {
    const f32x4 a = *(const f32x4*)(part + (size_t)row * 32 + 8 * fq), b = *(const f32x4*)(part + (size_t)row * 32 + 8 * fq + 4);
    float s = ((a[0] + a[1]) + (a[2] + a[3])) + ((b[0] + b[1]) + (b[2] + b[3]));
    s += __shfl_xor(s, 16); s += __shfl_xor(s, 32);
    return 1.0f / sqrtf(s * (1.0f / 2048.0f) + 1e-6f);
}
struct EpiGU {
    static constexpr bool PERM = true, MID = false; static constexpr int MID_T0 = -1, MID_T1 = -1;
    bf16_t* O;
    __device__ __forceinline__ void operator()(const f32x4 (&acc)[2][2][4][2], const Unit& u, int wr, int wc, int fr_, int fq_) const {
        int fr = fr_, fq = fq_; asm volatile("" : "+v"(fr), "+v"(fq));
        const int row0 = u.pm * BM + wr * 64 + fr, col0 = u.pn * HALF + wc * 32 + 8 * fq;
#pragma unroll
        for (int ai = 0; ai < 2; ++ai)
#pragma unroll
            for (int m = 0; m < 4; ++m) { bf16_t* rowp = O + (size_t)(row0 + ai * HALF + m * 16) * FF + col0;
                const f32x4 g0 = acc[ai][0][m][0], g1 = acc[ai][0][m][1], u0 = acc[ai][1][m][0], u1 = acc[ai][1][m][1];
                u32x4 w; w.x = cvt_pk_bf16(silu_f(g0[0]) * u0[0], silu_f(g0[1]) * u0[1]); w.y = cvt_pk_bf16(silu_f(g0[2]) * u0[2], silu_f(g0[3]) * u0[3]);
                w.z = cvt_pk_bf16(silu_f(g1[0]) * u1[0], silu_f(g1[1]) * u1[1]); w.w = cvt_pk_bf16(silu_f(g1[2]) * u1[2], silu_f(g1[3]) * u1[3]);
                *(u32x4*)rowp = w; }
    }
};
struct EpiRes {
    static constexpr bool PERM = false, MID = false; static constexpr int MID_T0 = -1, MID_T1 = -1;
    const float* Xin; float* Xout; float scale;
    __device__ __forceinline__ void operator()(const f32x4 (&acc)[2][2][4][2], const Unit& u, int wr, int wc, int fr_, int fq_) const {
        int fr = fr_, fq = fq_; asm volatile("" : "+v"(fr), "+v"(fq));
        const int row0 = u.pm * BM + wr * 64 + fr, col0 = u.pn * BM + wc * 32 + 4 * fq;
#pragma unroll
        for (int ai = 0; ai < 2; ++ai) { f32x4 bs[4][2][2];
#pragma unroll
            for (int m = 0; m < 4; ++m) { const size_t off = (size_t)(row0 + ai * HALF + m * 16) * D + col0;
#pragma unroll
                for (int bj = 0; bj < 2; ++bj)
#pragma unroll
                    for (int n = 0; n < 2; ++n) bs[m][bj][n] = *(const f32x4*)(Xin + off + bj * HALF + n * 16); }
            asm volatile("" ::: "memory");
#pragma unroll
            for (int m = 0; m < 4; ++m) { const size_t off = (size_t)(row0 + ai * HALF + m * 16) * D + col0;
#pragma unroll
                for (int bj = 0; bj < 2; ++bj)
#pragma unroll
                    for (int n = 0; n < 2; ++n) *(f32x4*)(Xout + off + bj * HALF + n * 16) = bs[m][bj][n] + acc[ai][bj][m][n] * scale; }
            asm volatile("" ::: "memory"); }
    }
};
struct EpiProj {
    static constexpr bool PERM = true, MID = true; static constexpr int MID_T0 = 32, MID_T1 = 48;
    const bf16_t* Z; bf16_t* O;
    __device__ __forceinline__ void mid(f32x4 (&acc)[2][2][4][2], const Unit& u, int t, int wr, int wc, int fr_, int fq_) const {
        int fr = fr_, fq = fq_; asm volatile("" : "+v"(fr), "+v"(fq));
        const int row0 = u.pm * BM + wr * 64 + fr, col0 = u.pn * BM + wc * 32 + 8 * fq; const int cn = (t == MID_T0) ? C_GL : C_GL + D;
#pragma unroll
        for (int ai = 0; ai < 2; ++ai) { u32x4 ga[4][2], gb[4][2];
#pragma unroll
            for (int m = 0; m < 4; ++m) { const bf16_t* zp = Z + (size_t)(row0 + ai * HALF + m * 16) * DIN + col0 + cn;
#pragma unroll
                for (int bj = 0; bj < 2; ++bj) { ga[m][bj] = *(const u32x4*)(zp + bj * HALF); gb[m][bj] = *(const u32x4*)(zp + D + bj * HALF); } }
            asm volatile("" ::: "memory");
#pragma unroll
            for (int m = 0; m < 4; ++m)
#pragma unroll
                for (int bj = 0; bj < 2; ++bj) { const u32x4 a = ga[m][bj], b = gb[m][bj]; f32x4& v0 = acc[ai][bj][m][0]; f32x4& v1 = acc[ai][bj][m][1];
                    v0[0] *= bf_lo(a.x) * __builtin_amdgcn_rcpf(bf_lo(b.x)); v0[1] *= bf_hi(a.x) * __builtin_amdgcn_rcpf(bf_hi(b.x)); v0[2] *= bf_lo(a.y) * __builtin_amdgcn_rcpf(bf_lo(b.y)); v0[3] *= bf_hi(a.y) * __builtin_amdgcn_rcpf(bf_hi(b.y));
                    v1[0] *= bf_lo(a.z) * __builtin_amdgcn_rcpf(bf_lo(b.z)); v1[1] *= bf_hi(a.z) * __builtin_amdgcn_rcpf(bf_hi(b.z)); v1[2] *= bf_lo(a.w) * __builtin_amdgcn_rcpf(bf_lo(b.w)); v1[3] *= bf_hi(a.w) * __builtin_amdgcn_rcpf(bf_hi(b.w)); }
            asm volatile("" ::: "memory"); }
    }
    __device__ __forceinline__ void operator()(const f32x4 (&acc)[2][2][4][2], const Unit& u, int wr, int wc, int fr_, int fq_) const {
        int fr = fr_, fq = fq_; asm volatile("" : "+v"(fr), "+v"(fq));
        const int row0 = u.pm * BM + wr * 64 + fr, col0 = u.pn * BM + wc * 32 + 8 * fq;
#pragma unroll
        for (int ai = 0; ai < 2; ++ai)
#pragma unroll
            for (int m = 0; m < 4; ++m) { const int row = row0 + ai * HALF + m * 16; const bf16_t* zp = Z + (size_t)row * DIN + C_GL + 2 * D + col0; bf16_t* op = O + (size_t)row * D + col0;
#pragma unroll
                for (int bj = 0; bj < 2; ++bj) { const u32x4 a = *(const u32x4*)(zp + bj * HALF); const f32x4 v0 = acc[ai][bj][m][0], v1 = acc[ai][bj][m][1];
                    u32x4 w; w.x = cvt_pk_bf16(v0[0] * bf_lo(a.x), v0[1] * bf_hi(a.x)); w.y = cvt_pk_bf16(v0[2] * bf_lo(a.y), v0[3] * bf_hi(a.y));
                    w.z = cvt_pk_bf16(v1[0] * bf_lo(a.z), v1[1] * bf_hi(a.z)); w.w = cvt_pk_bf16(v1[2] * bf_lo(a.w), v1[3] * bf_hi(a.w));
                    *(u32x4*)(op + bj * HALF) = w; } }
    }
};
struct EpiWin {
    static constexpr bool PERM = true, MID = false; static constexpr int MID_T0 = -1, MID_T1 = -1;
    bf16_t* Z; const float* bgate; const float* ropeC; const float* ropeS;
    __device__ __forceinline__ void operator()(const f32x4 (&acc)[2][2][4][2], const Unit& u, int wr, int wc, int fr_, int fq_) const {
        int fr = fr_, fq = fq_; asm volatile("" : "+v"(fr), "+v"(fq));
        const int pn = u.pn, row0 = u.pm * BM + wr * 64 + fr, cl = wc * 32 + 8 * fq;
        if (pn < 8) {
            const int h = pn & 3; const bool isk = pn >= 4;
            const float l2g = __builtin_log2f(1.0f - __builtin_amdgcn_exp2f(-5.0f - (float)h));
#pragma unroll
            for (int ai = 0; ai < 2; ++ai)
#pragma unroll
                for (int m = 0; m < 4; ++m) { const int row = row0 + ai * HALF + m * 16, pos = row & (T - 1), ci = row & 127;
                    const float sc = (isk ? __builtin_amdgcn_exp2f(-(float)ci * l2g) * 0.0625f : __builtin_amdgcn_exp2f((float)ci * l2g));
                    const float* cp = ropeC + (size_t)pos * 128 + cl; const float* sp = ropeS + (size_t)pos * 128 + cl;
                    const f32x4 c0 = *(const f32x4*)cp, c1 = *(const f32x4*)(cp + 4), s0 = *(const f32x4*)sp, s1 = *(const f32x4*)(sp + 4);
                    const f32x4 t1a = acc[ai][0][m][0], t1b = acc[ai][0][m][1], t2a = acc[ai][1][m][0], t2b = acc[ai][1][m][1];
                    const f32x4 o1a = (t1a * c0 - t2a * s0) * sc, o1b = (t1b * c1 - t2b * s1) * sc, o2a = (t1a * s0 + t2a * c0) * sc, o2b = (t1b * s1 + t2b * c1) * sc;
                    bf16_t* zp = Z + (size_t)row * DIN + pn * BM + cl;
                    u32x4 w; w.x = cvt_pk_bf16(o1a[0], o1a[1]); w.y = cvt_pk_bf16(o1a[2], o1a[3]); w.z = cvt_pk_bf16(o1b[0], o1b[1]); w.w = cvt_pk_bf16(o1b[2], o1b[3]); *(u32x4*)zp = w;
                    w.x = cvt_pk_bf16(o2a[0], o2a[1]); w.y = cvt_pk_bf16(o2a[2], o2a[3]); w.z = cvt_pk_bf16(o2b[0], o2b[1]); w.w = cvt_pk_bf16(o2b[2], o2b[3]); *(u32x4*)(zp + HALF) = w; }
            return;
        }
        const int mode = pn < 16 ? 0 : pn < 24 ? 1 : pn < 28 ? 2 : pn < 32 ? 3 : pn < 36 ? 4 : pn < 44 ? 0 : 5;
        const float qs = 0.08838834764831845f * LOG2E;
#pragma unroll
        for (int ai = 0; ai < 2; ++ai)
#pragma unroll
            for (int m = 0; m < 4; ++m) { const int row = row0 + ai * HALF + m * 16; bf16_t* zp = Z + (size_t)row * DIN + pn * BM + cl;
#pragma unroll
                for (int bj = 0; bj < 2; ++bj) { f32x4 v0 = acc[ai][bj][m][0], v1 = acc[ai][bj][m][1];
                    if (mode == 1) {
#pragma unroll
                        for (int j = 0; j < 4; ++j) { v0[j] = silu_f(v0[j]); v1[j] = silu_f(v1[j]); } }
                    else if (mode == 2 || mode == 3) {
#pragma unroll
                        for (int j = 0; j < 4; ++j) { v0[j] = gelu_tanh_f(v0[j]); v1[j] = gelu_tanh_f(v1[j]); } }
                    else if (mode == 4) { v0 = v0 * qs; v1 = v1 * qs; }
                    else if (mode == 5) { const float* bp = bgate + (pn * BM - C_GL) + bj * HALF + cl; const f32x4 b0 = *(const f32x4*)bp, b1 = *(const f32x4*)(bp + 4);
#pragma unroll
                        for (int j = 0; j < 4; ++j) { v0[j] = fast_sigmoid(v0[j] + b0[j]); v1[j] = fast_sigmoid(v1[j] + b1[j]); } }
                    u32x4 w; w.x = cvt_pk_bf16(v0[0], v0[1]); w.y = cvt_pk_bf16(v0[2], v0[3]); w.z = cvt_pk_bf16(v1[0], v1[1]); w.w = cvt_pk_bf16(v1[2], v1[3]);
                    *(u32x4*)(zp + bj * HALF) = w;
                     }
 }
    }
};
}

__device__ __forceinline__ float wave_sum(float v) {
#pragma unroll
    for (int o = 1; o < 64; o <<= 1) v += __shfl_xor(v, o);
    return v;
}
__device__ __forceinline__ void transpose_item(const float* W, int N, bf16* WT, int ldk, int koff, int drow0, LAS float* scr, int k0, int n0, int lane, const float* gain) {
#pragma unroll 8
    for (int i = 0; i < 32; ++i) { const int kk = 2 * i + (lane >> 5); scr[kk * 33 + (lane & 31)] = W[(size_t)(k0 + kk) * N + n0 + (lane & 31)]; }
    const int c = lane & 7;
    f32x4 g0 = (f32x4){1.f, 1.f, 1.f, 1.f}, g1 = g0;
    if (gain) { g0 = *(const f32x4*)(gain + k0 + 8 * c); g1 = *(const f32x4*)(gain + k0 + 8 * c + 4); }
    LDS_WAIT(); asm volatile("" ::: "memory");
#pragma unroll
    for (int j = 0; j < 4; ++j) { const int n = (lane >> 3) + 8 * j; const LAS float* s = scr + (8 * c) * 33 + n;
        v4u o; o.x = pk2(s[0 * 33] * g0[0], s[1 * 33] * g0[1]); o.y = pk2(s[2 * 33] * g0[2], s[3 * 33] * g0[3]); o.z = pk2(s[4 * 33] * g1[0], s[5 * 33] * g1[1]); o.w = pk2(s[6 * 33] * g1[2], s[7 * 33] * g1[3]);
        *(v4u*)(WT + (size_t)(drow0 + n) * ldk + koff + k0 + 8 * c) = o; }
    LDS_WAIT(); asm volatile("" ::: "memory");
}
struct ConvMat { const float* W; bf16* WT; int K, N, ldk, koff, gu; const float* gain; };
__device__ __forceinline__ void conv_matrix(const ConvMat& c, LAS float* scr, int gw, int NGW, int lane) {
    const int nn = c.N / 32, items = (c.K / 64) * nn;
    for (int it = gw; it < items; it += NGW) { const int kb = it / nn, nb = it - kb * nn, n0 = 32 * nb;
        const int drow0 = c.gu ? ((n0 >> 7) * 256 + (n0 & 127) + (c.gu - 1) * 128) : n0;
        transpose_item(c.W, c.N, c.WT, c.ldk, c.koff, drow0, scr, 64 * kb, n0, lane, c.gain); }
}
template <bool F32OUT>
__device__ __forceinline__ void rms_row(const float* xrow, const float* gain, void* orow, int lane) {
    const f32x4* xr = (const f32x4*)xrow + lane; const f32x4* gr = (const f32x4*)gain + lane;
    f32x4 v[8]; float s = 0.f;
#pragma unroll
    for (int j = 0; j < 8; ++j) { v[j] = xr[64 * j]; s += (v[j].x * v[j].x + v[j].y * v[j].y) + (v[j].z * v[j].z + v[j].w * v[j].w); }
    const float rstd = 1.0f / sqrtf(wave_sum(s) * (1.0f / D) + EPS);
#pragma unroll
    for (int j = 0; j < 8; ++j) { const f32x4 g = gr[64 * j]; const f32x4 o = v[j] * rstd * g;
        if (F32OUT) ((f32x4*)orow + lane)[64 * j] = o;
        else { v2u w; w.x = cvt_pk_bf16(o.x, o.y); w.y = cvt_pk_bf16(o.z, o.w); ((v2u*)orow + lane)[64 * j] = w; } }
}

__device__ __forceinline__ void x_row_prep(const float* xrow, bf16* orow, float* prow, int lane) {
    const f32x4* xr = (const f32x4*)xrow + lane; float s = 0.f;
#pragma unroll
    for (int j = 0; j < 8; ++j) { const f32x4 v = xr[64 * j]; s += (v.x * v.x + v.y * v.y) + (v.z * v.z + v.w * v.w);
        v2u w; w.x = cvt_pk_bf16(v.x, v.y); w.y = cvt_pk_bf16(v.z, v.w); ((v2u*)orow + lane)[64 * j] = w; }
    s = wave_sum(s);
    if (lane < 32) prow[lane] = lane == 0 ? s : 0.f;
}

#define MFMA16(a, b, c) __builtin_amdgcn_mfma_f32_16x16x32_bf16(a, b, c, 0, 0, 0)
__device__ __forceinline__ bf16x8 ldg16(const bf16* p) { return *(const bf16x8*)p; }
__device__ __forceinline__ s16x4 lds_tr(LAS unsigned char* p) { return __builtin_amdgcn_ds_read_tr16_b64_v4i16((LAS s16x4*)p); }
__device__ __forceinline__ bf16x8 cat8(s16x4 a, s16x4 b) { return (bf16x8){a[0], a[1], a[2], a[3], b[0], b[1], b[2], b[3]}; }
__device__ __forceinline__ bf16x8 pack8(f32x4 a, f32x4 b) { v4u w; w.x = cvt_pk_bf16(a[0], a[1]); w.y = cvt_pk_bf16(a[2], a[3]); w.z = cvt_pk_bf16(b[0], b[1]); w.w = cvt_pk_bf16(b[2], b[3]); return __builtin_bit_cast(bf16x8, w); }
__device__ __forceinline__ float head_gamma(int h) { return 1.0f - __builtin_amdgcn_exp2f(-5.0f - (float)h); }

constexpr int SG_VSTRIDE = 544;
__device__ __forceinline__ void sgu_unit(LAS unsigned char* lds, const bf16* Z, bf16* ACAT, const bf16* WC, const float* lng, const float* lnb, const float* sgb, int uid, int w, int lane_in) {
    int lane = lane_in; asm volatile("" : "+v"(lane)); const int tid = w * 64 + lane;
    const int b = uid >> 8, n = (uid >> 2) & 63, gq = uid & 3, row0 = b * T + n * 128;
    const int fr = lane & 15, g = lane >> 4;
    LAS unsigned char* VN = lds; LAS float* ST = (LAS float*)(lds + 128 * SG_VSTRIDE);
#pragma unroll 4
    for (int r = 0; r < 16; ++r) { const int row = 16 * w + r; const v4u* p = (const v4u*)(Z + (size_t)(row0 + row) * DIN + C_SV) + lane;
        const v4u a = p[0], b = p[64]; float s1, s2;
        { const float a0 = bf_lo(a.x), a1 = bf_hi(a.x), a2 = bf_lo(a.y), a3 = bf_hi(a.y), a4 = bf_lo(a.z), a5 = bf_hi(a.z), a6 = bf_lo(a.w), a7 = bf_hi(a.w);
          const float b0 = bf_lo(b.x), b1 = bf_hi(b.x), b2 = bf_lo(b.y), b3 = bf_hi(b.y), b4 = bf_lo(b.z), b5 = bf_hi(b.z), b6 = bf_lo(b.w), b7 = bf_hi(b.w);
          s1 = (((a0 + a1) + (a2 + a3)) + ((a4 + a5) + (a6 + a7))) + (((b0 + b1) + (b2 + b3)) + ((b4 + b5) + (b6 + b7)));
          s2 = (((a0 * a0 + a1 * a1) + (a2 * a2 + a3 * a3)) + ((a4 * a4 + a5 * a5) + (a6 * a6 + a7 * a7))) + (((b0 * b0 + b1 * b1) + (b2 * b2 + b3 * b3)) + ((b4 * b4 + b5 * b5) + (b6 * b6 + b7 * b7))); }
        s1 = wave_sum(s1); s2 = wave_sum(s2);
        if (lane == 0) { const float mean = s1 * (1.0f / 1024.0f), var = fmaxf(s2 * (1.0f / 1024.0f) - mean * mean, 0.f); ST[row * 2] = mean; ST[row * 2 + 1] = 1.0f / sqrtf(var + EPS); } }
    LDS_WAIT(); __syncthreads();
#pragma unroll
    for (int it = 0; it < 8; ++it) { const int p = tid + 512 * it, row = p >> 5, c8 = (p & 31) * 8;
        const v4u x = *(const v4u*)(Z + (size_t)(row0 + row) * DIN + C_SV + gq * 256 + c8);
        const float mean = ST[row * 2], rstd = ST[row * 2 + 1];
        const f32x4 g0 = *(const f32x4*)(lng + gq * 256 + c8), g1 = *(const f32x4*)(lng + gq * 256 + c8 + 4), b0 = *(const f32x4*)(lnb + gq * 256 + c8), b1 = *(const f32x4*)(lnb + gq * 256 + c8 + 4);
        v4u o;
        o.x = cvt_pk_bf16((bf_lo(x.x) - mean) * rstd * g0[0] + b0[0], (bf_hi(x.x) - mean) * rstd * g0[1] + b0[1]);
        o.y = cvt_pk_bf16((bf_lo(x.y) - mean) * rstd * g0[2] + b0[2], (bf_hi(x.y) - mean) * rstd * g0[3] + b0[3]);
        o.z = cvt_pk_bf16((bf_lo(x.z) - mean) * rstd * g1[0] + b1[0], (bf_hi(x.z) - mean) * rstd * g1[1] + b1[1]);
        o.w = cvt_pk_bf16((bf_lo(x.w) - mean) * rstd * g1[2] + b1[2], (bf_hi(x.w) - mean) * rstd * g1[3] + b1[3]);
        *(LAS v4u*)(VN + row * SG_VSTRIDE + c8 * 2) = o; }
    bf16x8 wf[4];
#pragma unroll
    for (int ks = 0; ks < 4; ++ks) wf[ks] = ldg16(WC + (size_t)(gq * 128 + 16 * w + fr) * 128 + ks * 32 + 8 * g);
    LDS_WAIT(); __syncthreads();
    const int row = row0 + 16 * w + fr; const float bias = sgb[gq * 128 + 16 * w + fr];
    const bf16* sup = Z + (size_t)row * DIN + C_SU + gq * 256 + 4 * g; bf16* op = ACAT + (size_t)row * KCAT + 2048 + gq * 256 + 4 * g;
    LAS unsigned char* vb = VN + (8 * g + (fr >> 2)) * SG_VSTRIDE + (fr & 3) * 8;
#pragma unroll
    for (int ct = 0; ct < 16; ++ct) { f32x4 a = (f32x4){0.f, 0.f, 0.f, 0.f};
#pragma unroll
        for (int ks = 0; ks < 4; ++ks) { const bf16x8 af = cat8(lds_tr(vb + (32 * ks) * SG_VSTRIDE + ct * 32), lds_tr(vb + (32 * ks + 4) * SG_VSTRIDE + ct * 32)); a = MFMA16(af, wf[ks], a); }
        const v2u su = *(const v2u*)(sup + 16 * ct);
        v2u o; o.x = cvt_pk_bf16(bf_lo(su.x) * (a[0] + bias), bf_hi(su.x) * (a[1] + bias)); o.y = cvt_pk_bf16(bf_lo(su.y) * (a[2] + bias), bf_hi(su.y) * (a[3] + bias));
        *(v2u*)(op + 16 * ct) = o; }
    __syncthreads();
}


constexpr int CS_KSTRIDE = 544, CS_VSTRIDE = 288, CS_VOFF = 128 * CS_KSTRIDE;
constexpr int CS_UNITS = 2 * 4 * 63 * 4;
__device__ __forceinline__ void cs_phase(LAS unsigned char* lds, const bf16* Z, bf16* SB, int first, int stride, int w, int lane_in) {
    int lane = lane_in; asm volatile("" : "+v"(lane)); const int tid = w * 64 + lane;
    const int fr = lane & 15, g = lane >> 4;
    LAS unsigned char* KC = lds; LAS unsigned char* VC = lds + CS_VOFF;
    v4u kreg[8], vreg[4];
#define CS_DECODE(u_, eq_, n_, bh_) const int eq_ = (u_) & 3, n_ = ((u_) >> 2) % 63, bh_ = ((u_) >> 2) / 63
#define CS_LOAD(u_) do { CS_DECODE(u_, eq_, n_, bh_); const bf16* zr = Z + (size_t)((bh_ >> 2) * T + n_ * 128) * DIN; \
        _Pragma("unroll") for (int it = 0; it < 8; ++it) { const int p = tid + 512 * it; kreg[it] = *(const v4u*)(zr + (size_t)(p >> 5) * DIN + C_RK + (bh_ & 3) * 256 + (p & 31) * 8); } \
        _Pragma("unroll") for (int it = 0; it < 4; ++it) { const int p = tid + 512 * it; vreg[it] = *(const v4u*)(zr + (size_t)(p >> 4) * DIN + C_RV + (bh_ & 3) * 512 + eq_ * 128 + (p & 15) * 8); } } while (0)
    if (first < CS_UNITS) CS_LOAD(first);
    LAS unsigned char* ka = KC + (4 * g + (fr >> 2)) * CS_KSTRIDE + (32 * w) * 2 + (fr & 3) * 8;
    LAS unsigned char* va = VC + (4 * g + (fr >> 2)) * CS_VSTRIDE + (fr & 3) * 8;
    for (int u = first; u < CS_UNITS; u += stride) {
#pragma unroll
        for (int it = 0; it < 8; ++it) { const int p = tid + 512 * it; *(LAS v4u*)(KC + (p >> 5) * CS_KSTRIDE + (p & 31) * 16) = kreg[it]; }
#pragma unroll
        for (int it = 0; it < 4; ++it) { const int p = tid + 512 * it; *(LAS v4u*)(VC + (p >> 4) * CS_VSTRIDE + (p & 15) * 16) = vreg[it]; }
        LDS_WAIT(); __syncthreads();
        if (u + stride < CS_UNITS) CS_LOAD(u + stride);
        f32x4 S[2][8];
#pragma unroll
        for (int i = 0; i < 2; ++i)
#pragma unroll
            for (int j = 0; j < 8; ++j) S[i][j] = (f32x4){0.f, 0.f, 0.f, 0.f};
#pragma unroll
        for (int ks = 0; ks < 4; ++ks) { bf16x8 af[2], bfv[8];
#pragma unroll
            for (int i = 0; i < 2; ++i) af[i] = cat8(lds_tr(ka + (32 * ks) * CS_KSTRIDE + i * 32), lds_tr(ka + (32 * ks + 16) * CS_KSTRIDE + i * 32));
#pragma unroll
            for (int j = 0; j < 8; ++j) bfv[j] = cat8(lds_tr(va + (32 * ks) * CS_VSTRIDE + j * 32), lds_tr(va + (32 * ks + 16) * CS_VSTRIDE + j * 32));
#pragma unroll
            for (int i = 0; i < 2; ++i)
#pragma unroll
                for (int j = 0; j < 8; ++j) S[i][j] = MFMA16(af[i], bfv[j], S[i][j]); }
        { CS_DECODE(u, eq, n, bh);
          bf16* sp = SB + ((size_t)((bh * 64 + n) * 512) + eq * 128 + fr) * 256 + 32 * w + 4 * g;
#pragma unroll
          for (int i = 0; i < 2; ++i)
#pragma unroll
              for (int j = 0; j < 8; ++j) { v2u o; o.x = cvt_pk_bf16(S[i][j][0], S[i][j][1]); o.y = cvt_pk_bf16(S[i][j][2], S[i][j][3]); *(v2u*)(sp + j * 16 * 256 + i * 16) = o; } }
        __syncthreads();
    }
#undef CS_LOAD
#undef CS_DECODE
}

__device__ __forceinline__ void prefix_phase(bf16* SB, int gt, int NGT) {
    for (int idx = gt; idx < 8 * 512 * 32; idx += NGT) {
        const int bh = idx >> 14, h = bh & 3; const float l2g = __builtin_log2f(head_gamma(h)), g127 = __builtin_amdgcn_exp2f(127.f * l2g), g128 = __builtin_amdgcn_exp2f(128.f * l2g);
        bf16* p = SB + (size_t)bh * 64 * 512 * 256 + (size_t)(idx & 16383) * 8;
        float r[8];
#pragma unroll
        for (int k = 0; k < 8; ++k) r[k] = 0.f;
        for (int n0 = 0; n0 < 64; n0 += 8) { v4u s[8];
#pragma unroll
            for (int k = 0; k < 8; ++k) s[k] = (n0 + k < 63) ? *(const v4u*)(p + (size_t)(n0 + k) * 512 * 256) : (v4u){0u, 0u, 0u, 0u};
#pragma unroll
            for (int k = 0; k < 8; ++k) { v4u o; o.x = cvt_pk_bf16(r[0], r[1]); o.y = cvt_pk_bf16(r[2], r[3]); o.z = cvt_pk_bf16(r[4], r[5]); o.w = cvt_pk_bf16(r[6], r[7]);
                *(v4u*)(p + (size_t)(n0 + k) * 512 * 256) = o;
                r[0] = r[0] * g128 + bf_lo(s[k].x) * g127; r[1] = r[1] * g128 + bf_hi(s[k].x) * g127; r[2] = r[2] * g128 + bf_lo(s[k].y) * g127; r[3] = r[3] * g128 + bf_hi(s[k].y) * g127;
                r[4] = r[4] * g128 + bf_lo(s[k].z) * g127; r[5] = r[5] * g128 + bf_hi(s[k].z) * g127; r[6] = r[6] * g128 + bf_lo(s[k].w) * g127; r[7] = r[7] * g128 + bf_hi(s[k].w) * g127; } }
    }
}

constexpr int AT_STRIDE = 288, AT_SLOT = 128 * AT_STRIDE, AT_VOFF = 2 * AT_SLOT, AT_BOFF = 4 * AT_SLOT;
#define AT_LOADBLK(sbk_) do { _Pragma("unroll") for (int it = 0; it < 4; ++it) { const int p = tid + 512 * it; const bf16* zr = zb + (size_t)(((((sbk_) * 128) + (p >> 4)) << dsh) + rr) * DIN + (p & 15) * 8; \
        kreg[it] = *(const v4u*)(zr + C_AK); vreg[it] = *(const v4u*)(zr + C_AV); } } while (0)
#define AT_WRITEBLK(slot_) do { _Pragma("unroll") for (int it = 0; it < 4; ++it) { const int p = tid + 512 * it; const int o = (slot_) * AT_SLOT + (p >> 4) * AT_STRIDE + (p & 15) * 16; \
        *(LAS v4u*)(lds + o) = kreg[it]; *(LAS v4u*)(lds + AT_VOFF + o) = vreg[it]; } } while (0)
template <int PAR>
__device__ __forceinline__ void attn_unit(LAS unsigned char* lds, const bf16* Z, const bf16* zb, bf16* OP, float* LSE, v4u (&kreg)[4], v4u (&vreg)[4], int cfg, int b, int h, int dsh, int rr, int sb, bool has_next, int w, int tid, int fr, int g) {
    LAS float* BL = (LAS float*)(lds + AT_BOFF);
    if (has_next) AT_LOADBLK(sb + 1);
    const int rowq = b * T + ((sb * 128 + 16 * w + fr) << dsh) + rr;
    bf16x8 qf[4];
#pragma unroll
    for (int ks = 0; ks < 4; ++ks) qf[ks] = ldg16(Z + (size_t)rowq * DIN + C_AQ + h * 128 + ks * 32 + 8 * g);
    int wv = 16 * w; asm volatile("" : "+v"(wv));
#define AT_ROWOFF(kt_) (((((wv + 16 * (kt_)) >> 7) ^ PAR ^ 1) & 1) * AT_SLOT + ((wv + 16 * (kt_)) & 127) * AT_STRIDE)
    f32x4 st[9];
#pragma unroll
    for (int kt = 0; kt < 9; ++kt) { LAS unsigned char* kp = lds + AT_ROWOFF(kt) + fr * AT_STRIDE + g * 16; f32x4 a = (f32x4){0.f, 0.f, 0.f, 0.f};
#pragma unroll
        for (int ks = 0; ks < 4; ++ks) a = MFMA16(*(LAS bf16x8*)(kp + ks * 64), qf[ks], a);
        st[kt] = a; }
    LAS float* blp = BL + (15 + 4 * g - fr);
#pragma unroll
    for (int kt = 0; kt < 9; ++kt)
#pragma unroll
        for (int r = 0; r < 4; ++r) st[kt][r] += blp[16 * kt + r];
    if (sb == 0) {
#pragma unroll
        for (int kt = 0; kt < 9; ++kt)
#pragma unroll
            for (int r = 0; r < 4; ++r) if (wv + 16 * kt + 4 * g + r < 128) st[kt][r] = -__builtin_inff(); }
    float mx = -__builtin_inff();
#pragma unroll
    for (int kt = 0; kt < 9; ++kt)
#pragma unroll
        for (int r = 0; r < 4; ++r) mx = fmaxf(mx, st[kt][r]);
    mx = fmaxf(mx, __shfl_xor(mx, 16)); mx = fmaxf(mx, __shfl_xor(mx, 32));
    float den = 0.f;
#pragma unroll
    for (int kt = 0; kt < 9; ++kt)
#pragma unroll
        for (int r = 0; r < 4; ++r) { const float p = __builtin_amdgcn_exp2f(st[kt][r] - mx); st[kt][r] = p; den += p; }
    den += __shfl_xor(den, 16); den += __shfl_xor(den, 32);
    bf16x8 pf[5];
#pragma unroll
    for (int kk = 0; kk < 4; ++kk) pf[kk] = pack8(st[2 * kk], st[2 * kk + 1]);
    pf[4] = pack8(st[8], (f32x4){0.f, 0.f, 0.f, 0.f});
    const float rden = 1.0f / den;
    bf16* op = OP + ((size_t)cfg * M + rowq) * 1024 + h * 128 + 4 * g;
    LAS unsigned char* vb = lds + AT_VOFF + (4 * g + (fr >> 2)) * AT_STRIDE + (fr & 3) * 8;
#pragma unroll
    for (int mt = 0; mt < 8; ++mt) { f32x4 o = (f32x4){0.f, 0.f, 0.f, 0.f};
#pragma unroll
        for (int kk = 0; kk < 5; ++kk) { const int t0 = 2 * kk, t1 = (2 * kk + 1 > 8) ? 8 : 2 * kk + 1;
            const bf16x8 a = cat8(lds_tr(vb + AT_ROWOFF(t0) + mt * 32), lds_tr(vb + AT_ROWOFF(t1) + mt * 32));
            o = MFMA16(a, pf[kk], o); }
        v2u wv; wv.x = cvt_pk_bf16(o[0] * rden, o[1] * rden); wv.y = cvt_pk_bf16(o[2] * rden, o[3] * rden);
        *(v2u*)(op + 16 * mt) = wv; }
    if (g == 0) LSE[((size_t)cfg * M + rowq) * 8 + h] = mx + __builtin_log2f(den);
    __syncthreads();
    if (has_next) { AT_WRITEBLK(PAR ^ 1); LDS_WAIT(); __syncthreads(); }
#undef AT_ROWOFF
}
__device__ __forceinline__ void attn_run(LAS unsigned char* lds, const bf16* Z, bf16* OP, float* LSE, const float* BIAS, int item, int w, int lane_in) {
    int lane = lane_in; asm volatile("" : "+v"(lane)); const int tid = w * 64 + lane;
    const int cfg = item >> 8, b = (item >> 7) & 1, h = (item >> 4) & 7, run = item & 15;
    const int dsh = 2 * cfg, rr = run & ((1 << dsh) - 1), sb0 = 4 * (run >> dsh);
    const int fr = lane & 15, g = lane >> 4;
    LAS float* BL = (LAS float*)(lds + AT_BOFF);
    const bf16* zb = Z + (size_t)(b * T) * DIN + h * 128;
    v4u kreg[4], vreg[4];
    { const int pb = sb0 > 0 ? sb0 - 1 : 0; AT_LOADBLK(pb); AT_WRITEBLK(1); }
    AT_LOADBLK(sb0);
    if (tid < 160) { const int dl = tid - 15; BL[tid] = (dl >= 0 && dl <= 128) ? BIAS[(cfg * 8 + h) * 132 + 128 - dl] : -__builtin_inff(); }
    AT_WRITEBLK(0);
    LDS_WAIT(); __syncthreads();
#pragma unroll 1
    for (int up = 0; up < 2; ++up) {
        attn_unit<0>(lds, Z, zb, OP, LSE, kreg, vreg, cfg, b, h, dsh, rr, sb0 + 2 * up, true, w, tid, fr, g);
        attn_unit<1>(lds, Z, zb, OP, LSE, kreg, vreg, cfg, b, h, dsh, rr, sb0 + 2 * up + 1, up == 0, w, tid, fr, g);
    }
}
#undef AT_LOADBLK
#undef AT_WRITEBLK

constexpr int RO_KSTRIDE = 544, RO_VSTRIDE = 160, RO_VOFF = 64 * RO_KSTRIDE, RO_BUF = RO_VOFF + 128 * RO_VSTRIDE;
__device__ __forceinline__ void retout_unit(LAS unsigned char* lds, const bf16* Z, const bf16* RT, bf16* ACAT, int uid, int w, int lane_in) {
    int lane = lane_in; asm volatile("" : "+v"(lane)); const int tid = w * 64 + lane;
    const int b = uid >> 8, h = (uid >> 6) & 3, n = uid & 63, row0 = b * T + n * 128;
    const int fr = lane & 15, g = lane >> 4, rowq = row0 + 16 * w + fr;
    const float gamma = head_gamma(h);
    const bf16* vsrc = Z + (size_t)row0 * DIN + C_RV + h * 512;
    const bf16* rsrc = RT + (size_t)(((b * 4 + h) * 64 + n) * 512) * 256;
    v4u rreg[4], vreg[2];
#define RO_LOAD(c_) do { _Pragma("unroll") for (int it = 0; it < 4; ++it) { const int p = tid + 512 * it; rreg[it] = *(const v4u*)(rsrc + (size_t)((c_) * 64 + (p >> 5)) * 256 + (p & 31) * 8); } \
        _Pragma("unroll") for (int it = 0; it < 2; ++it) { const int p = tid + 512 * it; vreg[it] = *(const v4u*)(vsrc + (size_t)(p >> 3) * DIN + (c_) * 64 + (p & 7) * 8); } } while (0)
#define RO_WRITE(buf_) do { _Pragma("unroll") for (int it = 0; it < 4; ++it) { const int p = tid + 512 * it; *(LAS v4u*)(lds + (buf_) * RO_BUF + (p >> 5) * RO_KSTRIDE + (p & 31) * 16) = rreg[it]; } \
        _Pragma("unroll") for (int it = 0; it < 2; ++it) { const int p = tid + 512 * it; *(LAS v4u*)(lds + (buf_) * RO_BUF + RO_VOFF + (p >> 3) * RO_VSTRIDE + (p & 7) * 16) = vreg[it]; } } while (0)
    { v4u kreg[8];
#pragma unroll
      for (int it = 0; it < 8; ++it) { const int p = tid + 512 * it; kreg[it] = *(const v4u*)(Z + (size_t)(row0 + (p >> 5)) * DIN + C_RK + h * 256 + (p & 31) * 8); }
#pragma unroll
      for (int it = 0; it < 8; ++it) { const int p = tid + 512 * it; *(LAS v4u*)(lds + (p >> 5) * RO_KSTRIDE + (p & 31) * 16) = kreg[it]; } }
    bf16x8 qf[8];
#pragma unroll
    for (int ks = 0; ks < 8; ++ks) qf[ks] = ldg16(Z + (size_t)rowq * DIN + C_RQ + h * 256 + ks * 32 + 8 * g);
    LDS_WAIT(); __syncthreads();
    RO_LOAD(0);
    f32x4 st[8];
#pragma unroll
    for (int jt = 0; jt < 8; ++jt) { st[jt] = (f32x4){0.f, 0.f, 0.f, 0.f};
        if (jt <= w) { LAS unsigned char* kp = lds + (16 * jt + fr) * RO_KSTRIDE + g * 16; f32x4 a = (f32x4){0.f, 0.f, 0.f, 0.f};
#pragma unroll
            for (int ks = 0; ks < 8; ++ks) a = MFMA16(*(LAS bf16x8*)(kp + ks * 64), qf[ks], a);
            if (jt == w) {
#pragma unroll
                for (int r = 0; r < 4; ++r) if (4 * g + r > fr) a[r] = 0.f; }
            st[jt] = a; } }
    bf16x8 pf[4];
#pragma unroll
    for (int kk = 0; kk < 4; ++kk) pf[kk] = pack8(st[2 * kk], st[2 * kk + 1]);
    __syncthreads();
    RO_WRITE(0); LDS_WAIT(); __syncthreads();
    f32x4 o[32];
    LAS unsigned char* ra = lds + fr * RO_KSTRIDE + g * 16;
    LAS unsigned char* va = lds + RO_VOFF + (4 * g + (fr >> 2)) * RO_VSTRIDE + (fr & 3) * 8;
#pragma unroll
    for (int c = 0; c < 8; ++c) {
        if (c < 7) RO_LOAD(c + 1);
#pragma unroll
        for (int e4 = 0; e4 < 4; ++e4) { f32x4 a = (f32x4){0.f, 0.f, 0.f, 0.f};
#pragma unroll
            for (int ks = 0; ks < 8; ++ks) a = MFMA16(*(LAS bf16x8*)(ra + (c & 1) * RO_BUF + e4 * 16 * RO_KSTRIDE + ks * 64), qf[ks], a);
            a = a * gamma;
#pragma unroll
            for (int kk = 0; kk < 4; ++kk) if (2 * kk <= w) {
                const bf16x8 af = cat8(lds_tr(va + (c & 1) * RO_BUF + (32 * kk) * RO_VSTRIDE + e4 * 32), lds_tr(va + (c & 1) * RO_BUF + (32 * kk + 16) * RO_VSTRIDE + e4 * 32));
                a = MFMA16(af, pf[kk], a); }
            o[4 * c + e4] = a; }
        if (c < 7) RO_WRITE((c + 1) & 1);
        LDS_WAIT(); __syncthreads();
    }
    float ss = 0.f;
#pragma unroll
    for (int et = 0; et < 32; ++et) ss += (o[et][0] * o[et][0] + o[et][1] * o[et][1]) + (o[et][2] * o[et][2] + o[et][3] * o[et][3]);
    ss += __shfl_xor(ss, 16); ss += __shfl_xor(ss, 32);
    const float rn = 1.0f / sqrtf(ss * (1.0f / 512.0f) + EPS);
    const bf16* rgp = Z + (size_t)rowq * DIN + C_RG + h * 512 + 4 * g; bf16* op = ACAT + (size_t)rowq * KCAT + h * 512 + 4 * g;
#pragma unroll
    for (int et = 0; et < 32; ++et) { const v2u rg = *(const v2u*)(rgp + 16 * et);
        v2u ov; ov.x = cvt_pk_bf16(bf_lo(rg.x) * o[et][0] * rn, bf_hi(rg.x) * o[et][1] * rn); ov.y = cvt_pk_bf16(bf_lo(rg.y) * o[et][2] * rn, bf_hi(rg.y) * o[et][3] * rn);
        *(v2u*)(op + 16 * et) = ov; }
#undef RO_LOAD
#undef RO_WRITE
}
constexpr int AT1_VSTRIDE = 288;
__device__ __forceinline__ void attn_unit(LAS unsigned char* lds, const bf16* Z, bf16* OP, float* LSE, const float* BIAS, int uid, int w, int lane_in) {
    int lane = lane_in; asm volatile("" : "+v"(lane)); const int tid = w * 64 + lane;
    const int cfg = uid >> 10, b = (uid >> 9) & 1, h = (uid >> 6) & 7, u64 = uid & 63;
    const int dsh = 2 * cfg, dm = (1 << dsh) - 1, rr = u64 & dm, sb = u64 >> dsh;
    LAS unsigned char* VS = lds; LAS float* BL = (LAS float*)(lds + 256 * AT1_VSTRIDE);
    const int fr = lane & 15, g = lane >> 4;
#pragma unroll
    for (int it = 0; it < 8; ++it) { const int p = tid + 512 * it, row = p >> 4, c16 = p & 15; int s = (sb - 1) * 128 + row; s = s < 0 ? 0 : s;
        const v4u v = *(const v4u*)(Z + (size_t)(b * T + (s << dsh) + rr) * DIN + C_AV + h * 128 + c16 * 8);
        *(LAS v4u*)(VS + row * AT1_VSTRIDE + c16 * 16) = v; }
    if (tid < 132) BL[tid] = BIAS[(cfg * 8 + h) * 132 + tid];
    const int rowq = b * T + ((sb * 128 + 16 * w + fr) << dsh) + rr;
    bf16x8 qf[4];
#pragma unroll
    for (int ks = 0; ks < 4; ++ks) qf[ks] = ldg16(Z + (size_t)rowq * DIN + C_AQ + h * 128 + ks * 32 + 8 * g);
    f32x4 st[9];
#pragma unroll
    for (int kt = 0; kt < 9; ++kt) { int s = (sb - 1) * 128 + 16 * w + 16 * kt + fr; s = s < 0 ? 0 : s;
        const bf16* kp = Z + (size_t)(b * T + (s << dsh) + rr) * DIN + C_AK + h * 128 + 8 * g; f32x4 a = (f32x4){0.f, 0.f, 0.f, 0.f};
#pragma unroll
        for (int ks = 0; ks < 4; ++ks) a = MFMA16(ldg16(kp + ks * 32), qf[ks], a);
        st[kt] = a; }
    LDS_WAIT(); __syncthreads();
    float mx = (-__builtin_inff());
#pragma unroll
    for (int kt = 0; kt < 9; ++kt)
#pragma unroll
        for (int r = 0; r < 4; ++r) { const int delta = 16 * kt + 4 * g + r - fr, jj = 16 * w + 16 * kt + 4 * g + r;
            const bool ok = (delta >= 0) && (delta <= 128) && (sb > 0 || jj >= 128);
            const int steps = ok ? 128 - delta : 0;
            const float l = ok ? st[kt][r] + BL[steps] : (-__builtin_inff()); st[kt][r] = l; mx = fmaxf(mx, l); }
    mx = fmaxf(mx, __shfl_xor(mx, 16)); mx = fmaxf(mx, __shfl_xor(mx, 32));
    float den = 0.f;
#pragma unroll
    for (int kt = 0; kt < 9; ++kt)
#pragma unroll
        for (int r = 0; r < 4; ++r) { const float p = __builtin_amdgcn_exp2f(st[kt][r] - mx); st[kt][r] = p; den += p; }
    den += __shfl_xor(den, 16); den += __shfl_xor(den, 32);
    bf16x8 pf[5];
#pragma unroll
    for (int kk = 0; kk < 4; ++kk) pf[kk] = pack8(st[2 * kk], st[2 * kk + 1]);
    pf[4] = pack8(st[8], (f32x4){0.f, 0.f, 0.f, 0.f});
    const float rden = 1.0f / den;
    bf16* op = OP + ((size_t)cfg * M + rowq) * 1024 + h * 128 + 4 * g;
    LAS unsigned char* vb = VS + (16 * w + 4 * g + (fr >> 2)) * AT1_VSTRIDE + (fr & 3) * 8;
#pragma unroll
    for (int mt = 0; mt < 8; ++mt) { f32x4 o = (f32x4){0.f, 0.f, 0.f, 0.f};
#pragma unroll
        for (int kk = 0; kk < 5; ++kk) { const int t0 = 2 * kk, t1 = (2 * kk + 1 > 8) ? 8 : 2 * kk + 1;
            const bf16x8 a = cat8(lds_tr(vb + t0 * 16 * AT1_VSTRIDE + mt * 32), lds_tr(vb + t1 * 16 * AT1_VSTRIDE + mt * 32));
            o = MFMA16(a, pf[kk], o); }
        v2u wv; wv.x = cvt_pk_bf16(o[0] * rden, o[1] * rden); wv.y = cvt_pk_bf16(o[2] * rden, o[3] * rden);
        *(v2u*)(op + 16 * mt) = wv; }
    if (g == 0) LSE[((size_t)cfg * M + rowq) * 8 + h] = mx + __builtin_log2f(den);
    __syncthreads();
}

constexpr int SC_KSTRIDE = 544, SC_VSTRIDE = 160, SC_VOFF = 128 * SC_KSTRIDE;
__device__ __forceinline__ void scan_unit(LAS unsigned char* lds, const bf16* Z, bf16* RT, int uid, int w, int lane_in) {
    int lane = lane_in; asm volatile("" : "+v"(lane)); const int tid = w * 64 + lane;
    const int b = uid >> 5, h = (uid >> 3) & 3, es = uid & 7;
    const int fr = lane & 15, g = lane >> 4;
    const float l2g = __builtin_log2f(head_gamma(h)), g127 = __builtin_amdgcn_exp2f(127.f * l2g), g128 = __builtin_amdgcn_exp2f(128.f * l2g);
    LAS unsigned char* KC = lds; LAS unsigned char* VC = lds + SC_VOFF;
    v4u kreg[8], vreg[2];
    const bf16* kbase = Z + (size_t)(b * T) * DIN + C_RK + h * 256; const bf16* vbase = Z + (size_t)(b * T) * DIN + C_RV + h * 512 + es * 64;
#define SC_LOAD(n_) do { _Pragma("unroll") for (int it = 0; it < 8; ++it) { const int p = tid + 512 * it; kreg[it] = *(const v4u*)(kbase + (size_t)((n_) * 128 + (p >> 5)) * DIN + (p & 31) * 8); } \
        _Pragma("unroll") for (int it = 0; it < 2; ++it) { const int p = tid + 512 * it; vreg[it] = *(const v4u*)(vbase + (size_t)((n_) * 128 + (p >> 3)) * DIN + (p & 7) * 8); } } while (0)
    SC_LOAD(0);
    f32x4 R[2][4];
#pragma unroll
    for (int i = 0; i < 2; ++i)
#pragma unroll
        for (int j = 0; j < 4; ++j) R[i][j] = (f32x4){0.f, 0.f, 0.f, 0.f};
    bf16* rtb = RT + ((size_t)((b * 4 + h) * 64) * 512 + es * 64 + fr) * 256 + 32 * w + 4 * g;
    LAS unsigned char* ka = KC + (8 * g + (fr >> 2)) * SC_KSTRIDE + (32 * w) * 2 + (fr & 3) * 8;
    LAS unsigned char* va = VC + (8 * g + (fr >> 2)) * SC_VSTRIDE + (fr & 3) * 8;
    for (int n = 0; n < 64; ++n) {
#pragma unroll
        for (int it = 0; it < 8; ++it) { const int p = tid + 512 * it; *(LAS v4u*)(KC + (p >> 5) * SC_KSTRIDE + (p & 31) * 16) = kreg[it]; }
#pragma unroll
        for (int it = 0; it < 2; ++it) { const int p = tid + 512 * it; *(LAS v4u*)(VC + (p >> 3) * SC_VSTRIDE + (p & 7) * 16) = vreg[it]; }
        LDS_WAIT(); __syncthreads();
        if (n < 63) SC_LOAD(n + 1);
#pragma unroll
        for (int i = 0; i < 2; ++i)
#pragma unroll
            for (int j = 0; j < 4; ++j) { v2u o; o.x = cvt_pk_bf16(R[i][j][0], R[i][j][1]); o.y = cvt_pk_bf16(R[i][j][2], R[i][j][3]);
                *(v2u*)(rtb + (size_t)n * 512 * 256 + j * 16 * 256 + i * 16) = o; }
        if (n < 63) {
            f32x4 S[2][4];
#pragma unroll
            for (int i = 0; i < 2; ++i)
#pragma unroll
                for (int j = 0; j < 4; ++j) S[i][j] = (f32x4){0.f, 0.f, 0.f, 0.f};
#pragma unroll
            for (int ks = 0; ks < 4; ++ks) { bf16x8 af[2], bfv[4];
#pragma unroll
                for (int i = 0; i < 2; ++i) af[i] = cat8(lds_tr(ka + (32 * ks) * SC_KSTRIDE + i * 32), lds_tr(ka + (32 * ks + 4) * SC_KSTRIDE + i * 32));
#pragma unroll
                for (int j = 0; j < 4; ++j) bfv[j] = cat8(lds_tr(va + (32 * ks) * SC_VSTRIDE + j * 32), lds_tr(va + (32 * ks + 4) * SC_VSTRIDE + j * 32));
#pragma unroll
                for (int i = 0; i < 2; ++i)
#pragma unroll
                    for (int j = 0; j < 4; ++j) S[i][j] = MFMA16(af[i], bfv[j], S[i][j]); }
#pragma unroll
            for (int i = 0; i < 2; ++i)
#pragma unroll
                for (int j = 0; j < 4; ++j) R[i][j] = R[i][j] * g128 + S[i][j] * g127;
        }
        LDS_WAIT(); __syncthreads();
    }
#undef SC_LOAD
}

constexpr int RO1_VSTRIDE = 288, RO1_VBUF = 128 * RO1_VSTRIDE;
__device__ __forceinline__ void retout_old_unit(LAS unsigned char* lds, const bf16* Z, const bf16* RT, bf16* ACAT, int uid, int w, int lane_in) {
    int lane = lane_in; asm volatile("" : "+v"(lane)); const int tid = w * 64 + lane;
    const int b = uid >> 8, h = (uid >> 6) & 3, n = uid & 63, row0 = b * T + n * 128;
    const int fr = lane & 15, g = lane >> 4, rowq = row0 + 16 * w + fr;
    const float gamma = head_gamma(h);
    const bf16* vsrc = Z + (size_t)row0 * DIN + C_RV + h * 512;
    v4u vreg[4];
#define RO1_LOAD(ec_) do { _Pragma("unroll") for (int it = 0; it < 4; ++it) { const int p = tid + 512 * it; vreg[it] = *(const v4u*)(vsrc + (size_t)(p >> 4) * DIN + (ec_) * 128 + (p & 15) * 8); } } while (0)
#define RO1_WRITE(buf_) do { _Pragma("unroll") for (int it = 0; it < 4; ++it) { const int p = tid + 512 * it; *(LAS v4u*)(lds + (buf_) * RO1_VBUF + (p >> 4) * RO1_VSTRIDE + (p & 15) * 16) = vreg[it]; } } while (0)
    RO1_LOAD(0);
    bf16x8 qf[8];
#pragma unroll
    for (int ks = 0; ks < 8; ++ks) qf[ks] = ldg16(Z + (size_t)rowq * DIN + C_RQ + h * 256 + ks * 32 + 8 * g);
    f32x4 st[8];
#pragma unroll
    for (int jt = 0; jt < 8; ++jt) { st[jt] = (f32x4){0.f, 0.f, 0.f, 0.f};
        if (jt <= w) { const bf16* kp = Z + (size_t)(row0 + 16 * jt + fr) * DIN + C_RK + h * 256 + 8 * g; f32x4 a = (f32x4){0.f, 0.f, 0.f, 0.f};
#pragma unroll
            for (int ks = 0; ks < 8; ++ks) a = MFMA16(ldg16(kp + ks * 32), qf[ks], a);
            if (jt == w) {
#pragma unroll
                for (int r = 0; r < 4; ++r) if (4 * g + r > fr) a[r] = 0.f; }
            st[jt] = a; } }
    bf16x8 pf[4];
#pragma unroll
    for (int kk = 0; kk < 4; ++kk) pf[kk] = pack8(st[2 * kk], st[2 * kk + 1]);
    RO1_WRITE(0); LDS_WAIT(); __syncthreads();
    f32x4 o[32];
    const bf16* rtp = RT + ((size_t)(((b * 4 + h) * 64 + n) * 512) + fr) * 256 + 8 * g;
    LAS unsigned char* vb0 = lds + (4 * g + (fr >> 2)) * RO1_VSTRIDE + (fr & 3) * 8;
#pragma unroll
    for (int ec = 0; ec < 4; ++ec) {
        if (ec < 3) RO1_LOAD(ec + 1);
        LAS unsigned char* vb = vb0 + (ec & 1) * RO1_VBUF;
#pragma unroll
        for (int e8 = 0; e8 < 8; ++e8) { const int et = 8 * ec + e8; f32x4 a = (f32x4){0.f, 0.f, 0.f, 0.f};
#pragma unroll
            for (int ks = 0; ks < 8; ++ks) a = MFMA16(ldg16(rtp + (size_t)et * 16 * 256 + ks * 32), qf[ks], a);
            a = a * gamma;
#pragma unroll
            for (int kk = 0; kk < 4; ++kk) if (2 * kk <= w) {
                const bf16x8 af = cat8(lds_tr(vb + (32 * kk) * RO1_VSTRIDE + e8 * 32), lds_tr(vb + (32 * kk + 16) * RO1_VSTRIDE + e8 * 32));
                a = MFMA16(af, pf[kk], a); }
            o[et] = a; }
        if (ec < 3) RO1_WRITE((ec + 1) & 1);
        LDS_WAIT(); __syncthreads();
    }
    float ss = 0.f;
#pragma unroll
    for (int et = 0; et < 32; ++et) ss += (o[et][0] * o[et][0] + o[et][1] * o[et][1]) + (o[et][2] * o[et][2] + o[et][3] * o[et][3]);
    ss += __shfl_xor(ss, 16); ss += __shfl_xor(ss, 32);
    const float rn = 1.0f / sqrtf(ss * (1.0f / 512.0f) + EPS);
    const bf16* rgp = Z + (size_t)rowq * DIN + C_RG + h * 512 + 4 * g; bf16* op = ACAT + (size_t)rowq * KCAT + h * 512 + 4 * g;
#pragma unroll
    for (int et = 0; et < 32; ++et) { const v2u rg = *(const v2u*)(rgp + 16 * et);
        v2u ov; ov.x = cvt_pk_bf16(bf_lo(rg.x) * o[et][0] * rn, bf_hi(rg.x) * o[et][1] * rn); ov.y = cvt_pk_bf16(bf_lo(rg.y) * o[et][2] * rn, bf_hi(rg.y) * o[et][3] * rn);
        *(v2u*)(op + 16 * et) = ov; }
#undef RO1_LOAD
#undef RO1_WRITE
}
#ifndef NEW_RET
#define NEW_RET 1
#endif
#ifndef NEW_ATTN
#define NEW_ATTN 1
#endif
#ifndef NEW_RETOUT
#define NEW_RETOUT 1
#endif
#ifndef SUB_MASK
#define SUB_MASK 7
#endif
#ifndef DUP_MASK
#define DUP_MASK 0u
#endif
#define DUPN(k_) (1 + (int)((DUP_MASK >> (k_)) & 1u))
#ifndef SITE_MASK
#define SITE_MASK 0xFFFFFFFFu
#endif

struct Params { const float* in[22]; float* out; unsigned char* ws; int ph_lo, ph_hi; };
typedef __attribute__((address_space(4))) const unsigned char* kargp_t;
typedef GAS unsigned char* g_u8p; typedef GAS float* g_f32p; typedef const GAS float* g_cf32p;
typedef __attribute__((address_space(4))) const g_u8p* kslot_u8; typedef __attribute__((address_space(4))) const g_f32p* kslot_f32; typedef __attribute__((address_space(4))) const g_cf32p* kslot_cf32;

__global__ void __launch_bounds__(NWAVES * 64, 2) fwd_kernel(Params P) {
    extern __shared__ __attribute__((aligned(16))) unsigned char lds_raw[];
    LAS unsigned char* lds = (LAS unsigned char*)lds_raw;
    const int wave = __builtin_amdgcn_readfirstlane((int)threadIdx.x >> 6);
    for (int u = threadIdx.x; u < (LDS_BYTES - LDSCTL_OFF) / 4; u += NWAVES * 64) ((LAS unsigned*)(lds + LDSCTL_OFF))[u] = 0u;
    __syncthreads();
#if MK_PER_PHASE
    XcdBarrier bar; bar.bar = nullptr; bar.x = 0; bar.st = nullptr;
#else
    XcdBarrier bar = xcd_barrier_post((unsigned*)(P.ws + WS_CTL) + CW_BAR, (volatile LAS unsigned*)(lds + MISC_OFF) + 8);
#endif
    const int lo = P.ph_lo, hi = P.ph_hi;
    int ph = 0, site = 0;
#define IN_PH(k_) (((SITE_MASK >> (k_)) & 1u) && lo <= ph && ph < hi)
#define PH_IDS() int lanep; asm volatile("v_mbcnt_lo_u32_b32 %0, -1, 0\n\tv_mbcnt_hi_u32_b32 %0, -1, %0" : "=v"(lanep)); const int tidp = wave * 64 + lanep; (void)tidp; \
    kargp_t ka_ = (kargp_t)__builtin_amdgcn_kernarg_segment_ptr(); asm volatile("" : "+s"(ka_)); \
    unsigned char* const ws = (unsigned char*)*(kslot_u8)(ka_ + 184); (void)ws; \
    int G = gridDim.x, wg = blockIdx.x; asm volatile("" : "+s"(G), "+s"(wg)); const int gw = wg * NWAVES + wave, NGW = G * NWAVES; (void)gw; (void)NGW
#define KIN(i) ((const float*)*(kslot_cf32)(ka_ + 8 * (i)))
#define KOUT() ((float*)*(kslot_f32)(ka_ + 176))
#if MK_PER_PHASE
#define END_PH() do { ++ph; } while (0)
#else
#define END_PH() do { ++ph; xcd_barrier(bar, wave); } while (0)
#endif
#define WSP(T_, off_) ((T_*)(ws + (off_)))
    (void)site;

    for (int l = 0; l < DEPTH; ++l) {
        if (IN_PH(0)) for (int rep_ = 0; rep_ < DUPN(0); ++rep_) { PH_IDS();
            LAS float* scr = (LAS float*)(lds + RING_OFF + wave * 16384);
            unsigned char* wb = ws + WS_W;
            const size_t oGU = (size_t)l * D * FF, oD = (size_t)l * FF * D;
            { ConvMat c{KIN(2) + oGU, (bf16*)(wb + WO_GU1), D, FF, D, 0, 1, nullptr}; conv_matrix(c, scr, gw, NGW, lanep); }
            { ConvMat c{KIN(3) + oGU, (bf16*)(wb + WO_GU1), D, FF, D, 0, 2, nullptr}; conv_matrix(c, scr, gw, NGW, lanep); }
            { ConvMat c{KIN(4) + oD, (bf16*)(wb + WO_D1), FF, D, FF, 0, 0, nullptr}; conv_matrix(c, scr, gw, NGW, lanep); }
            { ConvMat c{KIN(6) + (size_t)l * D * DIN, (bf16*)(wb + WO_IN), D, DIN, D, 0, 0, nullptr}; conv_matrix(c, scr, gw, NGW, lanep); }
            { ConvMat c{KIN(13) + (size_t)l * 2048 * D, (bf16*)(wb + WO_CAT), 2048, D, KCAT, 0, 0, nullptr}; conv_matrix(c, scr, gw, NGW, lanep); }
            { ConvMat c{KIN(14) + (size_t)l * 1024 * D, (bf16*)(wb + WO_CAT), 1024, D, KCAT, 2048, 0, nullptr}; conv_matrix(c, scr, gw, NGW, lanep); }
            { ConvMat c{KIN(15) + (size_t)l * 1024 * D, (bf16*)(wb + WO_CAT), 1024, D, KCAT, 3072, 0, nullptr}; conv_matrix(c, scr, gw, NGW, lanep); }
            { ConvMat c{KIN(16) + (size_t)l * D * D, (bf16*)(wb + WO_OUT), D, D, D, 0, 0, nullptr}; conv_matrix(c, scr, gw, NGW, lanep); }
            { ConvMat c{KIN(18) + oGU, (bf16*)(wb + WO_GU2), D, FF, D, 0, 1, nullptr}; conv_matrix(c, scr, gw, NGW, lanep); }
            { ConvMat c{KIN(19) + oGU, (bf16*)(wb + WO_GU2), D, FF, D, 0, 2, nullptr}; conv_matrix(c, scr, gw, NGW, lanep); }
            { ConvMat c{KIN(20) + oD, (bf16*)(wb + WO_D2), FF, D, FF, 0, 0, nullptr}; conv_matrix(c, scr, gw, NGW, lanep); }
            const int gt = wg * (NWAVES * 64) + tidp, NGT = G * NWAVES * 64;
            { const float* sw = KIN(10) + (size_t)l * 4 * 128 * 128; bf16* WCb = WSP(bf16, WS_WC);
              for (int i = gt; i < 4 * 128 * 128; i += NGT) { const int s = i & 127, t = (i >> 7) & 127; WCb[i] = (bf16)(s <= t ? f2bf(sw[i]) : 0u); } }
            if (l == 0) {
                float* ROPEC = WSP(float, WS_ROPEC); float* ROPES = WSP(float, WS_ROPES); float* BIAS = WSP(float, WS_BIAS); const float* relb = KIN(12);
                for (int i = gt; i < T * 128; i += NGT) { const int pos = i >> 7, fi = i & 127;
                    double inv = 1.0;
                    if (fi & 1) inv *= 0.930572040929699; if (fi & 2) inv *= 0.8659643233600654; if (fi & 4) inv *= 0.7498942093324559; if (fi & 8) inv *= 0.5623413251903491;
                    if (fi & 16) inv *= 0.31622776601683794; if (fi & 32) inv *= 0.1; if (fi & 64) inv *= 0.01;
                    const double ang = (double)pos * inv; const double k = __builtin_rint(ang * 0.15915494309189535);
                    double red = __builtin_fma(-k, 6.283185307179586, ang); red = __builtin_fma(-k, 2.4492935982947064e-16, red);
                    const float rf = (float)red; ROPEC[i] = cosf(rf); ROPES[i] = sinf(rf); }
                for (int i = gt; i < 3 * 8 * 132; i += NGT) { const int st = i % 132, hh = (i / 132) % 8, cfg = i / (132 * 8); float v = 0.f;
                    if (st <= 128) { const int dist = st << (2 * cfg); int bk;
                        if (dist < 16) bk = dist; else { bk = 16 + (int)(logf((float)dist / 16.0f) / 4.852030263919617f * 16.0f); bk = bk > 31 ? 31 : bk; }
                        v = relb[bk * 8 + hh] * LOG2E; }
                    BIAS[i] = v; }
            }
        }
        END_PH();
        for (int half = 0; half < 2; ++half) {
            const bool first = (l == 0 && half == 0);
            if (IN_PH(1)) for (int rep_ = 0; rep_ < DUPN(1); ++rep_) { PH_IDS(); const float* gain = KIN(half ? 17 : 1) + (size_t)l * D; const float* xin = first ? KIN(0) : WSP(const float, WS_X); bf16* XB = WSP(bf16, WS_XB);
                for (int m = gw; m < M; m += NGW) rms_row<false>(xin + (size_t)m * D, gain, XB + (size_t)m * D, lanep); }
            END_PH();
            if (IN_PH(2)) for (int rep_ = 0; rep_ < DUPN(2); ++rep_) { PH_IDS(); pg8::Gemm g{WSP(const bf16, WS_XB), (const bf16*)(ws + WS_W + (half ? WO_GU2 : WO_GU1)), M, 2 * FF, D}; pg8::StaticOrder S; S.init(M, 2 * FF, G, wg);
                pg8::EpiGU E{WSP(bf16, WS_Z)}; pg8::gemm_phase<pg8::EpiGU, pg8::StaticOrder, true, true>(lds + RING_OFF, g, S, E, wave); }
            END_PH();
            if (IN_PH(3)) for (int rep_ = 0; rep_ < DUPN(3); ++rep_) { PH_IDS(); pg8::Gemm g{WSP(const bf16, WS_Z), (const bf16*)(ws + WS_W + (half ? WO_D2 : WO_D1)), M, D, FF}; pg8::StaticOrder S; S.init(M, D, G, wg, 4);
                const float* xin = first ? KIN(0) : WSP(const float, WS_X);
                pg8::EpiRes E{xin, WSP(float, WS_X), 0.5f}; pg8::gemm_phase<pg8::EpiRes, pg8::StaticOrder, true, true>(lds + RING_OFF, g, S, E, wave); }
            END_PH();
            if (half == 0) {
                if (IN_PH(4)) for (int rep_ = 0; rep_ < DUPN(4); ++rep_) { PH_IDS(); const float* gain = KIN(5) + (size_t)l * D; const float* X = WSP(const float, WS_X); bf16* XB = WSP(bf16, WS_XB);
                    for (int m = gw; m < M; m += NGW) rms_row<false>(X + (size_t)m * D, gain, XB + (size_t)m * D, lanep); }
                END_PH();
                if (IN_PH(5)) for (int rep_ = 0; rep_ < DUPN(5); ++rep_) { PH_IDS(); pg8::Gemm g{WSP(const bf16, WS_XB), (const bf16*)(ws + WS_W + WO_IN), M, DIN, D}; pg8::StaticOrder S; S.init(M, DIN, G, wg);
                    pg8::EpiWin E{WSP(bf16, WS_Z), KIN(7) + (size_t)l * 3 * D, WSP(const float, WS_ROPEC), WSP(const float, WS_ROPES)};
                    pg8::gemm_phase<pg8::EpiWin, pg8::StaticOrder, true, true>(lds + RING_OFF, g, S, E, wave); }
                END_PH();
                if (IN_PH(6)) for (int rep_ = 0; rep_ < DUPN(6); ++rep_) { PH_IDS();
#if NEW_RET == 2
                    { for (int it = wg; it < 64; it += G) scan_unit(lds, WSP(const bf16, WS_Z), WSP(bf16, WS_RT), it, wave, lanep); }
                    { PH_IDS(); cs_phase(lds, WSP(const bf16, WS_Z), WSP(bf16, WS_END), wg, G, wave, lanep); }
#if DBG_CMP == 2
                    { PH_IDS(); cs_phase(lds, WSP(const bf16, WS_Z), WSP(bf16, WS_END + 128 * MiB), wg, G, wave, lanep); }
#endif
#elif NEW_RET
                    if (SUB_MASK & 1) cs_phase(lds, WSP(const bf16, WS_Z), WSP(bf16, WS_RT), wg, G, wave, lanep);
#else
                    if (SUB_MASK & 1) { for (int it = wg; it < 64; it += G) scan_unit(lds, WSP(const bf16, WS_Z), WSP(bf16, WS_RT), it, wave, lanep); }
#endif
#if NEW_ATTN
                    if (SUB_MASK & 2) { PH_IDS(); for (int it = wg; it < 768; it += G) attn_run(lds, WSP(const bf16, WS_Z), WSP(bf16, WS_OPART), WSP(float, WS_LSE), WSP(const float, WS_BIAS), it, wave, lanep); }
#else
                    if (SUB_MASK & 2) { PH_IDS(); for (int it = wg; it < 3072; it += G) attn_unit(lds, WSP(const bf16, WS_Z), WSP(bf16, WS_OPART), WSP(float, WS_LSE), WSP(const float, WS_BIAS), it, wave, lanep); }
#endif
                    if (SUB_MASK & 4) { PH_IDS(); for (int it = wg; it < 512; it += G)
                        sgu_unit(lds, WSP(const bf16, WS_Z), WSP(bf16, WS_ACAT), WSP(const bf16, WS_WC), KIN(8) + (size_t)l * 1024, KIN(9) + (size_t)l * 1024, KIN(11) + (size_t)l * 512, it, wave, lanep); }
                }
                END_PH();
                if (IN_PH(11)) for (int rep_ = 0; rep_ < DUPN(11); ++rep_) { PH_IDS();
                    const int gt = wg * (NWAVES * 64) + tidp, NGT = G * NWAVES * 64;
#if NEW_RET == 2
#if DBG_CMP != 2
                    prefix_phase(WSP(bf16, WS_END), gt, NGT);
#endif
#elif NEW_RET
                    if (rep_ == 0) prefix_phase(WSP(bf16, WS_RT), gt, NGT);
#endif
                    const float* LSE = WSP(const float, WS_LSE); const bf16* OPART = WSP(const bf16, WS_OPART); bf16* ACAT = WSP(bf16, WS_ACAT);
                    for (int p = gt; p < M * 128; p += NGT) { const int row = p >> 7, hh = (p >> 4) & 7, c8 = (p & 15) * 8;
                        const float l0 = LSE[((size_t)0 * M + row) * 8 + hh], l1 = LSE[((size_t)1 * M + row) * 8 + hh], l2 = LSE[((size_t)2 * M + row) * 8 + hh];
                        const float mx = fmaxf(l0, fmaxf(l1, l2)); float w0 = __builtin_amdgcn_exp2f(l0 - mx), w1 = __builtin_amdgcn_exp2f(l1 - mx), w2 = __builtin_amdgcn_exp2f(l2 - mx);
                        const float rs = 1.0f / (w0 + w1 + w2); w0 *= rs; w1 *= rs; w2 *= rs;
                        const size_t o = (size_t)row * 1024 + hh * 128 + c8;
                        const v4u a = *(const v4u*)(OPART + o), b = *(const v4u*)(OPART + (size_t)M * 1024 + o), c = *(const v4u*)(OPART + (size_t)2 * M * 1024 + o);
                        v4u r;
                        r.x = cvt_pk_bf16(w0 * bf_lo(a.x) + w1 * bf_lo(b.x) + w2 * bf_lo(c.x), w0 * bf_hi(a.x) + w1 * bf_hi(b.x) + w2 * bf_hi(c.x));
                        r.y = cvt_pk_bf16(w0 * bf_lo(a.y) + w1 * bf_lo(b.y) + w2 * bf_lo(c.y), w0 * bf_hi(a.y) + w1 * bf_hi(b.y) + w2 * bf_hi(c.y));
                        r.z = cvt_pk_bf16(w0 * bf_lo(a.z) + w1 * bf_lo(b.z) + w2 * bf_lo(c.z), w0 * bf_hi(a.z) + w1 * bf_hi(b.z) + w2 * bf_hi(c.z));
                        r.w = cvt_pk_bf16(w0 * bf_lo(a.w) + w1 * bf_lo(b.w) + w2 * bf_lo(c.w), w0 * bf_hi(a.w) + w1 * bf_hi(b.w) + w2 * bf_hi(c.w));
                        *(v4u*)(ACAT + (size_t)row * KCAT + 3072 + hh * 128 + c8) = r; }
                }
                END_PH();
                if (IN_PH(7)) for (int rep_ = 0; rep_ < DUPN(7); ++rep_) { PH_IDS();
#if NEW_RET == 2 && defined(DBG_CMP)
                    { const bf16* A_ = (DBG_CMP == 2) ? WSP(const bf16, WS_END + 128 * MiB) : WSP(const bf16, WS_RT); const bf16* B_ = WSP(const bf16, WS_END); float dmx = 0.f;
                      for (size_t i = (size_t)wg * 512 + tidp; i < (size_t)8 * 64 * 512 * 256; i += (size_t)G * 512) { if (DBG_CMP == 2 && ((i >> 17) & 63) == 63) continue; const float d_ = fabsf(__uint_as_float((unsigned)A_[i] << 16) - __uint_as_float((unsigned)B_[i] << 16)); dmx = d_ > dmx ? d_ : dmx; }
                      atomicMax(WSP(unsigned, WS_CTL) + 64, __float_as_uint(dmx)); }
#endif
#if NEW_RETOUT
                    for (int it = wg; it < 512; it += G) retout_unit(lds, WSP(const bf16, WS_Z), WSP(const bf16, WS_RT), WSP(bf16, WS_ACAT), it, wave, lanep);
#else
                    for (int it = wg; it < 512; it += G) retout_old_unit(lds, WSP(const bf16, WS_Z), WSP(const bf16, WS_RT), WSP(bf16, WS_ACAT), it, wave, lanep);
#endif
                }
                END_PH();
                if (IN_PH(8)) for (int rep_ = 0; rep_ < DUPN(8); ++rep_) { PH_IDS(); pg8::Gemm g{WSP(const bf16, WS_ACAT), (const bf16*)(ws + WS_W + WO_CAT), M, D, KCAT}; pg8::StaticOrder S; S.init(M, D, G, wg, 4);
                    pg8::EpiProj E{WSP(const bf16, WS_Z), WSP(bf16, WS_MERGED)}; pg8::gemm_phase<pg8::EpiProj, pg8::StaticOrder, true, true>(lds + RING_OFF, g, S, E, wave); }
                END_PH();
                if (IN_PH(9)) for (int rep_ = 0; rep_ < DUPN(9); ++rep_) { PH_IDS(); pg8::Gemm g{WSP(const bf16, WS_MERGED), (const bf16*)(ws + WS_W + WO_OUT), M, D, D}; pg8::StaticOrder S; S.init(M, D, G, wg, 4);
                    pg8::EpiRes E{WSP(const float, WS_X), WSP(float, WS_X), 1.0f}; pg8::gemm_phase<pg8::EpiRes, pg8::StaticOrder, true, true>(lds + RING_OFF, g, S, E, wave); }
                END_PH();
            }
        }
    }
    if (IN_PH(10)) for (int rep_ = 0; rep_ < DUPN(10); ++rep_) { PH_IDS(); const float* X = WSP(const float, WS_X); const float* gain = KIN(21); float* out = KOUT();
        for (int m = gw; m < M; m += NGW) rms_row<true>(X + (size_t)m * D, gain, out + (size_t)m * D, lanep);
#if NEW_RET == 2 && defined(DBG_CMP)
        { asm volatile("s_waitcnt vmcnt(0)" ::: "memory"); const float dv = 1000.0f * __uint_as_float(__hip_atomic_load(WSP(unsigned, WS_CTL) + 64, __ATOMIC_RELAXED, __HIP_MEMORY_SCOPE_AGENT)); for (int m = gw; m < M; m += NGW) for (int c = lanep; c < D; c += 64) out[(size_t)m * D + c] = dv; }
#endif
    }
#undef IN_PH
#undef END_PH
}
constexpr int N_PHASES = DEPTH * (1 + 3 + 7 + 3) + 1;

extern "C" void kernel_launch(void* const* d_in, const int* in_sizes, int n_in, void* d_out, int out_size, void* d_ws, size_t ws_size, hipStream_t stream) {
    static int grid = 0;
    if (grid == 0) {
        if (n_in != 22 || ws_size < WS_END) { fprintf(stderr, "kernel_launch: unexpected n_in %d / ws %zu\n", n_in, ws_size); grid = -1; return; }
        int dev = 0, cus = 0, per_cu = 0;
        if (hipGetDevice(&dev) != hipSuccess || hipDeviceGetAttribute(&cus, hipDeviceAttributeMultiprocessorCount, dev) != hipSuccess) { grid = -1; return; }
        if (hipFuncSetAttribute((const void*)fwd_kernel, hipFuncAttributeMaxDynamicSharedMemorySize, LDS_BYTES) != hipSuccess) { fprintf(stderr, "kernel_launch: hipFuncSetAttribute failed\n"); grid = -1; return; }
        if (hipOccupancyMaxActiveBlocksPerMultiprocessor(&per_cu, (const void*)fwd_kernel, NWAVES * 64, LDS_BYTES) != hipSuccess || per_cu < 1)
            fprintf(stderr, "kernel_launch: occupancy query reports %d workgroups per CU\n", per_cu);
        (void)hipGetLastError();
        grid = cus;
    }
    if (grid < 0) return;
    (void)hipMemsetAsync((char*)d_ws + WS_CTL, 0, CTL_ZERO_BYTES, stream);
    Params p{};
    for (int i = 0; i < 22; ++i) p.in[i] = (const float*)d_in[i];
    p.out = (float*)d_out; p.ws = (unsigned char*)d_ws;
#if MK_PER_PHASE
    for (int k = 0; k < N_PHASES; ++k) { p.ph_lo = k; p.ph_hi = k + 1; hipLaunchKernelGGL(fwd_kernel, dim3(grid), dim3(NWAVES * 64), LDS_BYTES, stream, p); }
#else
    p.ph_lo = 0; p.ph_hi = N_PHASES;
    hipLaunchKernelGGL(fwd_kernel, dim3(grid), dim3(NWAVES * 64), LDS_BYTES, stream, p);
#endif
}
```

```cpp
#include <hip/hip_runtime.h>
#include <cstdio>
#include <cstdint>

#ifndef MK_PER_PHASE
#define MK_PER_PHASE 0
#endif

namespace pg8 {
#define PG8_LAS __attribute__((address_space(3)))
typedef unsigned short bf16_t;
typedef short bf16x8 __attribute__((ext_vector_type(8)));
typedef float f32x4 __attribute__((ext_vector_type(4)));
typedef unsigned u32x4 __attribute__((ext_vector_type(4)));
typedef unsigned u32x2 __attribute__((ext_vector_type(2)));
constexpr int BM = 256, BK = 64, HALF = 128, HTB = HALF * BK * 2  , STAGE_BYTES = 8 * HTB, NXCD = 8, WGM = 8;

__host__ __device__ __forceinline__ int lds_byte(int r, int c) { const int st = (r >> 4) * 2 + (c >> 5), rr = r & 15, cc = c & 31, ob = rr * 64 + cc * 2; return st * 1024 + (ob ^ (((ob >> 9) & 1) << 5)); }
__host__ __device__ __forceinline__ void stage_rc(int b, int& R, int& C) { const int st = b / 1024, sb = b % 1024, swz = sb ^ (((sb >> 9) & 1) << 5); R = (st >> 1) * 16 + swz / 64; C = (st & 1) * 32 + (swz % 64) / 2; }
__host__ __device__ __forceinline__ int perm32(int rho) { const int n = rho >> 4, i = rho & 15; return 8 * (i >> 2) + 4 * n + (i & 3); }

struct Unit { int pm, pn; };
struct Gemm { const bf16_t* A; const bf16_t* Bt; int M, N, K; };

struct StaticOrder {
    int nM, nN, nwg, G, c, wgm;
    __host__ __device__ void init(int M, int N, int G_, int c_, int wgm_ = WGM) { nM = M / BM; nN = N / BM; nwg = nM * nN; G = G_; c = c_; wgm = wgm_; }
    __host__ __device__ bool next(int i, Unit& u) const {
        const long L = (long)i * G + c; if (L >= nwg) return false;
        int wgid = (int)L; { const int q = nwg / NXCD, r = nwg % NXCD, xcd = wgid % NXCD, off = wgid / NXCD; wgid = (xcd < r ? xcd * (q + 1) : r * (q + 1) + (xcd - r) * q) + off; }
        const int nig = wgm * nN, gid = wgid / nig, fm = gid * wgm, gsz = (nM - fm) < wgm ? (nM - fm) : wgm;
        u.pm = fm + ((wgid % nig) % gsz); u.pn = (wgid % nig) / gsz; return true;
    }
    __device__ __forceinline__ void a_ready(const Unit&) const {}
    __device__ __forceinline__ void done(const Unit&) const {}
};

typedef float f32x2v_t __attribute__((ext_vector_type(2))); typedef __bf16 bf16x2v_t __attribute__((ext_vector_type(2)));
__device__ __forceinline__ unsigned cvt_pk_bf16(float lo, float hi) { const f32x2v_t v = {lo, hi}; const bf16x2v_t b = __builtin_convertvector(v, bf16x2v_t); return __builtin_bit_cast(unsigned, b); }
__device__ __forceinline__ float bf_lo(unsigned w) { return __uint_as_float(w << 16); }
__device__ __forceinline__ float bf_hi(unsigned w) { return __uint_as_float(w & 0xffff0000u); }
__device__ __forceinline__ float fast_sigmoid(float x) { return __builtin_amdgcn_rcpf(1.0f + __builtin_amdgcn_exp2f(-1.4426950408889634f * x)); }
__device__ __forceinline__ float silu_f(float x) { return x * fast_sigmoid(x); }
__device__ __forceinline__ float gelu_tanh_f(float x) { const float u = 0.7978845608028654f * (x + 0.044715f * x * x * x); return x * fast_sigmoid(2.0f * u); }

template <class Epi, class Sched, bool ALIGN_EPI = false, bool SP2 = false>
__device__ __forceinline__ void gemm_phase(PG8_LAS unsigned char* lds, const Gemm g, const Sched& S, const Epi& E, int wid) {
    int lane_; asm volatile("v_mbcnt_lo_u32_b32 %0, -1, 0\n\tv_mbcnt_hi_u32_b32 %0, -1, %0" : "=v"(lane_));
    const int lane = lane_, tid = wid * 64 + lane, wr = wid >> 2, wc = wid & 3, fr = lane & 15, fq = lane >> 4;
    const int K = g.K, nt = K / BK;
    unsigned voffA[2], voffB[2];
#pragma unroll
    for (int i = 0; i < 2; ++i) { int R, C; stage_rc(tid * 16 + i * 8192, R, C); const int Rb = Epi::PERM ? ((R & ~31) + perm32(R & 31)) : R;
        voffA[i] = (unsigned)(R * K + C) * 2u; voffB[i] = (unsigned)(Rb * K + C) * 2u; }
    const size_t kstep = (size_t)(BK * 2);
    const size_t hstep = (size_t)HALF * K * 2;
    const size_t tstep = 2 * hstep;
    const unsigned ldsw = (unsigned)wid * 1024u;
    const int aoff = lds_byte(wr * 64 + fr, fq * 8), boff = lds_byte(wc * 32 + fr, fq * 8);
#define PG8_SA(b, h) (((b) * 2 + (h)) * HTB)
#define PG8_SB(b, h) ((4 + (b) * 2 + (h)) * HTB)
#define PG8_STAGE(bufoff, gbase, voff) do { _Pragma("unroll") for (int _i = 0; _i < 2; ++_i) \
        __builtin_amdgcn_global_load_lds((const unsigned*)((const char*)(gbase) + (voff)[_i]), (PG8_LAS unsigned*)(lds + (bufoff) + ldsw + _i * 8192), 16, 0, 0); } while (0)
#define PG8_LDA(dst, b, h) do { _Pragma("unroll") for (int m = 0; m < 4; ++m) _Pragma("unroll") for (int k = 0; k < 2; ++k) dst[m][k] = *(const PG8_LAS bf16x8*)(lds + PG8_SA(b, h) + aoff + m * 2048 + k * 1024); } while (0)
#define PG8_LDB(dst, b, h) do { _Pragma("unroll") for (int n = 0; n < 2; ++n) _Pragma("unroll") for (int k = 0; k < 2; ++k) dst[n][k] = *(const PG8_LAS bf16x8*)(lds + PG8_SB(b, h) + boff + n * 2048 + k * 1024); } while (0)
#define PG8_MMA(ai, bj, At, Bt) do { __builtin_amdgcn_s_setprio(1); _Pragma("unroll") for (int m = 0; m < 4; ++m) _Pragma("unroll") for (int n = 0; n < 2; ++n) _Pragma("unroll") for (int k = 0; k < 2; ++k) \
        acc[ai][bj][m][n] = __builtin_amdgcn_mfma_f32_16x16x32_bf16(Bt[n][k], At[m][k], acc[ai][bj][m][n], 0, 0, 0); __builtin_amdgcn_s_setprio(0); } while (0)
#define PG8_WAIT_V(n) asm volatile("s_waitcnt vmcnt(" #n ")" ::: "memory")
#define PG8_WAIT_L(n) asm volatile("s_waitcnt lgkmcnt(" #n ")" ::: "memory")
#define PG8_BAR __builtin_amdgcn_s_barrier()
#define PG8_SCHED __builtin_amdgcn_sched_barrier(0)
    Unit cur, nxt; int ui = 0;
    if (!S.next(0, cur)) return;
    f32x4 acc[2][2][4][2];
#pragma unroll
    for (int a = 0; a < 2; ++a)
#pragma unroll
        for (int b = 0; b < 2; ++b)
#pragma unroll
            for (int m = 0; m < 4; ++m)
#pragma unroll
                for (int n = 0; n < 2; ++n) acc[a][b][m][n] = (f32x4){0.f, 0.f, 0.f, 0.f};
    bf16x8 At[4][2], B0[2][2], B1[2][2];
    const char* cA = (const char*)g.A + (size_t)cur.pm * tstep; const char* cB = (const char*)g.Bt + (size_t)cur.pn * tstep;
    S.a_ready(cur);
    if constexpr (SP2) {
        PG8_STAGE(PG8_SB(0, 0), cB, voffB); PG8_STAGE(PG8_SB(0, 1), cB + hstep, voffB); PG8_STAGE(PG8_SA(0, 0), cA, voffA); PG8_STAGE(PG8_SA(0, 1), cA + hstep, voffA);
        if (wr == 1) PG8_BAR;
        PG8_WAIT_V(2); PG8_BAR;
        PG8_STAGE(PG8_SB(1, 0), cB + kstep, voffB); PG8_STAGE(PG8_SA(1, 0), cA + kstep, voffA); PG8_STAGE(PG8_SB(1, 1), cB + hstep + kstep, voffB);
        PG8_WAIT_V(6); PG8_BAR;
    } else {
        PG8_STAGE(PG8_SB(0, 0), cB, voffB); PG8_STAGE(PG8_SA(0, 0), cA, voffA); PG8_STAGE(PG8_SB(0, 1), cB + hstep, voffB); PG8_STAGE(PG8_SA(0, 1), cA + hstep, voffA);
        if (wr == 1) PG8_BAR;
        PG8_WAIT_V(4); PG8_BAR;
        PG8_STAGE(PG8_SB(1, 0), cB + kstep, voffB); PG8_STAGE(PG8_SA(1, 0), cA + kstep, voffA); PG8_STAGE(PG8_SB(1, 1), cB + hstep + kstep, voffB);
        PG8_WAIT_V(6); PG8_BAR;
    }
    for (;;) {
        const bool has_next = S.next(ui + 1, nxt);
        const char* nA = has_next ? (const char*)g.A + (size_t)nxt.pm * tstep : cA; const char* nB = has_next ? (const char*)g.Bt + (size_t)nxt.pn * tstep : cB;
        for (int t = 0; t < nt; t += 2) {
            const bool last = (t == nt - 2);
            const char* a1 = cA + (size_t)(t + 1) * kstep;
            const char* a2 = last ? nA : cA + (size_t)(t + 2) * kstep; const char* b2 = last ? nB : cB + (size_t)(t + 2) * kstep;
            const char* a3 = a2 + kstep; const char* b3 = b2 + kstep;
            if (last && has_next) S.a_ready(nxt);
            if constexpr (Epi::MID) { if (t == Epi::MID_T0 || t == Epi::MID_T1) E.mid(acc, cur, t, wr, wc, fr, fq); }
            if constexpr (SP2) {
            PG8_LDB(B0, 0, 0); PG8_LDB(B1, 0, 1); PG8_SCHED; PG8_LDA(At, 0, 0); PG8_STAGE(PG8_SA(1, 1), a1 + hstep, voffA);
            PG8_WAIT_V(8); PG8_WAIT_L(0); PG8_BAR; PG8_MMA(0, 0, At, B0); PG8_MMA(0, 1, At, B1); PG8_BAR; PG8_SCHED;
            PG8_LDA(At, 0, 1); PG8_STAGE(PG8_SB(0, 0), b2, voffB); PG8_STAGE(PG8_SB(0, 1), b2 + hstep, voffB); PG8_STAGE(PG8_SA(0, 0), a2, voffA);
            PG8_WAIT_V(8); PG8_WAIT_L(0); PG8_BAR; PG8_MMA(1, 0, At, B0); PG8_MMA(1, 1, At, B1); PG8_BAR; PG8_SCHED;
            PG8_LDB(B0, 1, 0); PG8_LDB(B1, 1, 1); PG8_SCHED; PG8_LDA(At, 1, 0); PG8_STAGE(PG8_SA(0, 1), a2 + hstep, voffA);
            PG8_WAIT_V(8); PG8_WAIT_L(0); PG8_BAR; PG8_MMA(0, 0, At, B0); PG8_MMA(0, 1, At, B1); PG8_BAR; PG8_SCHED;
            PG8_LDA(At, 1, 1); PG8_STAGE(PG8_SB(1, 0), b3, voffB); PG8_STAGE(PG8_SB(1, 1), b3 + hstep, voffB); PG8_STAGE(PG8_SA(1, 0), a3, voffA);
            PG8_WAIT_V(8); PG8_WAIT_L(0); PG8_BAR; PG8_MMA(1, 0, At, B0); PG8_MMA(1, 1, At, B1); PG8_BAR; PG8_SCHED;
            } else {
            PG8_LDB(B0, 0, 0); PG8_SCHED; PG8_LDA(At, 0, 0); PG8_STAGE(PG8_SA(1, 1), a1 + hstep, voffA);
            PG8_WAIT_L(8); PG8_BAR; PG8_WAIT_L(0); PG8_MMA(0, 0, At, B0); PG8_BAR; PG8_SCHED;
            PG8_LDB(B1, 0, 1); PG8_STAGE(PG8_SB(0, 0), b2, voffB);
            PG8_BAR; PG8_WAIT_L(0); PG8_MMA(0, 1, At, B1); PG8_BAR;
            PG8_LDA(At, 0, 1); PG8_STAGE(PG8_SA(0, 0), a2, voffA);
            PG8_BAR; PG8_WAIT_L(0); PG8_MMA(1, 0, At, B0); PG8_BAR; PG8_SCHED;
            PG8_STAGE(PG8_SB(0, 1), b2 + hstep, voffB);
            PG8_WAIT_V(6); PG8_BAR; PG8_MMA(1, 1, At, B1); PG8_BAR;
            PG8_LDB(B0, 1, 0); PG8_SCHED; PG8_LDA(At, 1, 0); PG8_STAGE(PG8_SA(0, 1), a2 + hstep, voffA);
            PG8_WAIT_L(8); PG8_BAR; PG8_WAIT_L(0); PG8_MMA(0, 0, At, B0); PG8_BAR; PG8_SCHED;
            PG8_LDB(B1, 1, 1); PG8_STAGE(PG8_SB(1, 0), b3, voffB);
            PG8_BAR; PG8_WAIT_L(0); PG8_MMA(0, 1, At, B1); PG8_BAR;
            PG8_LDA(At, 1, 1); PG8_STAGE(PG8_SA(1, 0), a3, voffA);
            PG8_BAR; PG8_WAIT_L(0); PG8_MMA(1, 0, At, B0); PG8_BAR; PG8_SCHED;
            PG8_STAGE(PG8_SB(1, 1), b3 + hstep, voffB);
            PG8_WAIT_V(6); PG8_BAR; PG8_MMA(1, 1, At, B1); PG8_BAR;
            }
        }
        if constexpr (ALIGN_EPI) { if (wr == 0) PG8_BAR; }
        E(acc, cur, wr, wc, fr, fq); S.done(cur);
        if (!has_next) break;
#pragma unroll
        for (int a = 0; a < 2; ++a)
#pragma unroll
            for (int b = 0; b < 2; ++b)
#pragma unroll
                for (int m = 0; m < 4; ++m)
#pragma unroll
                    for (int n = 0; n < 2; ++n) acc[a][b][m][n] = (f32x4){0.f, 0.f, 0.f, 0.f};
        cur = nxt; cA = nA; cB = nB; ++ui;
        if constexpr (ALIGN_EPI) { if (wr == 1) PG8_BAR; }
    }
    PG8_WAIT_V(0);
    if constexpr (!ALIGN_EPI) { if (wr == 0) PG8_BAR; }
    PG8_BAR;
#undef PG8_SA
#undef PG8_SB
#undef PG8_STAGE
#undef PG8_LDA
#undef PG8_LDB
#undef PG8_MMA
#undef PG8_WAIT_V
#undef PG8_WAIT_L
#undef PG8_BAR
#undef PG8_SCHED
}
}

constexpr int BATCH = 2, T = 8192, M = BATCH * T, D = 2048, FF = 5632, DIN = 17408, DEPTH = 4;
constexpr int C_RQ = 0, C_RK = 1024, C_RV = 2048, C_RG = 4096, C_SU = 6144, C_SV = 7168, C_AQ = 8192, C_AK = 9216, C_AV = 10240, C_GL = 11264;
constexpr int KCAT = 4096;
constexpr float EPS = 1e-6f, LOG2E = 1.4426950408889634f;
constexpr int NWAVES = 8;

constexpr size_t MiB = 1u << 20;
constexpr size_t WS_CTL = 0, CTL_ZERO_BYTES = 2 * MiB;
constexpr size_t WS_SVSTAT = 1 * MiB;
constexpr size_t WS_BIAS = 2 * MiB;
constexpr size_t WS_WC = 3 * MiB;
constexpr size_t WS_LSE = 4 * MiB;
constexpr size_t WS_ROPEC = 8 * MiB, WS_ROPES = 12 * MiB;
constexpr size_t WS_W = 16 * MiB;
constexpr size_t WO_GU1 = 0, WO_D1 = 44 * MiB, WO_IN = 66 * MiB, WO_CAT = 134 * MiB, WO_OUT = 150 * MiB, WO_GU2 = 158 * MiB, WO_D2 = 202 * MiB, W_BYTES = 224 * MiB;
constexpr size_t WS_X = 240 * MiB;
constexpr size_t WS_XB = 368 * MiB;
constexpr size_t WS_Z = 432 * MiB;
constexpr size_t WS_RT = 976 * MiB;
constexpr size_t WS_ACAT = 1104 * MiB;
constexpr size_t WS_OPART = 1232 * MiB;
constexpr size_t WS_MERGED = 1328 * MiB;
constexpr size_t WS_END = 1392 * MiB;
constexpr size_t WS_PART = 6 * MiB;
static_assert((size_t)11264 * 2048 * 2 == 44 * MiB && (size_t)2048 * 5632 * 2 == 22 * MiB && (size_t)17408 * 2048 * 2 == 68 * MiB && (size_t)2048 * 4096 * 2 == 16 * MiB, "weight map");
static_assert((size_t)M * DIN * 2 == 544 * MiB && (size_t)M * D * 4 == 128 * MiB, "activation map");
constexpr int CW_TMO = 0, CW_BAR = 4096;

constexpr int RING_OFF = 0, RING_BYTES = 155648;
constexpr int RSTD_OFF = 131072;
constexpr int LDSCTL_OFF = RING_BYTES, MISC_OFF = LDSCTL_OFF + 320;
constexpr int LDS_BYTES = 157696;

#define GAS __attribute__((address_space(1)))
#define LAS __attribute__((address_space(3)))
typedef unsigned short bf16;
typedef unsigned v4u __attribute__((ext_vector_type(4)));
typedef unsigned v2u __attribute__((ext_vector_type(2)));
typedef float f32x4 __attribute__((ext_vector_type(4)));
typedef short bf16x8 __attribute__((ext_vector_type(8)));
typedef short s16x4 __attribute__((ext_vector_type(4)));
typedef GAS unsigned gu32;
#define RLX_AGENT __ATOMIC_RELAXED, __HIP_MEMORY_SCOPE_AGENT
#define LDS_WAIT() asm volatile("s_waitcnt lgkmcnt(0)" ::: "memory")
#define VM_WAIT() asm volatile("s_waitcnt vmcnt(0)" ::: "memory")
__device__ __forceinline__ unsigned f2bf(float f) { unsigned u = __builtin_bit_cast(unsigned, f); return (u + 0x7fffu + ((u >> 16) & 1u)) >> 16; }
__device__ __forceinline__ unsigned pk2(float lo, float hi) { return f2bf(lo) | (f2bf(hi) << 16); }
using pg8::cvt_pk_bf16; using pg8::bf_lo; using pg8::bf_hi;

#define XB_TMO      128
#define XB_XCNT(j)  (256  + 64 * (j))
#define XB_XSUB(j)  (1280 + 64 * (j))
#define XB_XGEN(j)  (2304 + 64 * (j))
#define XB_TOP      3328
#define XB_TOPGEN   3392
#define XCD_BAR_WORDS 3456
#define XB_SPIN_CAP (1u << 20)

__device__ __forceinline__ unsigned xb_ld(unsigned* p)              { return __hip_atomic_load(p, __ATOMIC_RELAXED, __HIP_MEMORY_SCOPE_AGENT); }
__device__ __forceinline__ unsigned xb_add(unsigned* p, unsigned v) { return __hip_atomic_fetch_add(p, v, __ATOMIC_RELAXED, __HIP_MEMORY_SCOPE_AGENT); }
__device__ __forceinline__ unsigned xb_xcc_id() { return (unsigned)__builtin_amdgcn_s_getreg((3 << 11) | 20) & 0xFu; }
#define XB_SPIN(cond, bar) do { unsigned _sp = 0; while (cond) { __builtin_amdgcn_s_sleep(1); \
    if ((++_sp & 255u) == 0u) { if (xb_ld(&(bar)[XB_TMO])) break; if (_sp > XB_SPIN_CAP) { atomicAdd(&(bar)[XB_TMO], 1u); break; } } } } while (0)

struct XcdBarrier { unsigned* bar; unsigned x; volatile LAS unsigned* st; };

__device__ __forceinline__ XcdBarrier xcd_barrier_post(unsigned* bar, volatile LAS unsigned* st) {
    XcdBarrier b; b.bar = bar; b.x = xb_xcc_id(); b.st = st;
    if (threadIdx.x == 0) (void)xb_add(&bar[XB_XCNT(b.x)], 1u);
    return b;
}
__device__ __forceinline__ void xcd_barrier_complete(unsigned* bar, unsigned x, unsigned& nloc, unsigned& nx) {
    const unsigned G = gridDim.x * gridDim.y * gridDim.z;
    unsigned sum, cnt, mine, sp = 0u;
    for (;;) {
        sum = 0u; cnt = 0u; mine = 0u;
#pragma unroll
        for (unsigned j = 0; j < 16; ++j) { const unsigned c = xb_ld(&bar[XB_XCNT(j)]); sum += c; cnt += (c > 0u) ? 1u : 0u; mine = (j == x) ? c : mine; }
        if (sum == G) break;
        __builtin_amdgcn_s_sleep(1);
        if ((++sp & 255u) == 0u) { if (xb_ld(&bar[XB_TMO])) break; if (sp > XB_SPIN_CAP) { atomicAdd(&bar[XB_TMO], 1u); break; } }
    }
    nloc = mine > 0u ? mine : 1u; nx = cnt > 0u ? cnt : 1u;
}
__device__ __forceinline__ void xcd_barrier(const XcdBarrier& b, int wave) {
    asm volatile("s_waitcnt vmcnt(0)" ::: "memory");
    __syncthreads();
    int lane0_; asm volatile("v_mbcnt_lo_u32_b32 %0, -1, 0\n\tv_mbcnt_hi_u32_b32 %0, -1, %0" : "=v"(lane0_));
    if (wave == 0 && lane0_ == 0) {
        unsigned* bar = b.bar;
        __builtin_amdgcn_s_waitcnt(0);
        unsigned nloc = b.st[0], nx = b.st[1];
        if (nloc == 0u) { xcd_barrier_complete(bar, b.x, nloc, nx); b.st[0] = nloc; b.st[1] = nx; }
        const unsigned old = xb_add(&bar[XB_XSUB(b.x)], 1u);
        const unsigned gen = old / nloc;
        if (old + 1u == (gen + 1u) * nloc) {
            __builtin_amdgcn_fence(__ATOMIC_RELEASE, "agent");
            asm volatile("s_waitcnt vmcnt(0)" ::: "memory");
            const unsigned og = xb_add(&bar[XB_TOP], 1u);
            const unsigned tg = og / nx;
            if (og + 1u == (tg + 1u) * nx) xb_add(&bar[XB_TOPGEN], 1u);
            else XB_SPIN(xb_ld(&bar[XB_TOPGEN]) == tg, bar);
            __builtin_amdgcn_fence(__ATOMIC_ACQUIRE, "agent");
            xb_add(&bar[XB_XGEN(b.x)], 1u);
            asm volatile("s_waitcnt vmcnt(0)" ::: "memory");
        } else {
            XB_SPIN(xb_ld(&bar[XB_XGEN(b.x)]) == gen, bar);
            __builtin_amdgcn_fence(__ATOMIC_ACQUIRE, "agent");
            asm volatile("s_waitcnt vmcnt(0)" ::: "memory");
        }
    }
    __syncthreads();
}

namespace pg8 {

__device__ __forceinline__ float row_rstd(const float* part, int row, int fq) {
    const f32x4 a = *(const f32x4*)(part + (size_t)row * 32 + 8 * fq), b = *(const f32x4*)(part + (size_t)row * 32 + 8 * fq + 4);
    float s = ((a[0] + a[1]) + (a[2] + a[3])) + ((b[0] + b[1]) + (b[2] + b[3]));
    s += __shfl_xor(s, 16); s += __shfl_xor(s, 32);
    return 1.0f / sqrtf(s * (1.0f / 2048.0f) + 1e-6f);
}
struct EpiGU {
    static constexpr bool PERM = true, MID = false; static constexpr int MID_T0 = -1, MID_T1 = -1;
    bf16_t* O; const PG8_LAS float* rstd;
    __device__ __forceinline__ void operator()(const f32x4 (&acc)[2][2][4][2], const Unit& u, int wr, int wc, int fr_, int fq_) const {
        int fr = fr_, fq = fq_; asm volatile("" : "+v"(fr), "+v"(fq));
        const int row0 = u.pm * BM + wr * 64 + fr, col0 = u.pn * HALF + wc * 32 + 8 * fq;
#pragma unroll
        for (int ai = 0; ai < 2; ++ai)
#pragma unroll
            for (int m = 0; m < 4; ++m) { bf16_t* rowp = O + (size_t)(row0 + ai * HALF + m * 16) * FF + col0; const float r = rstd[ai * HALF + wr * 64 + m * 16 + fr];
                const f32x4 g0 = acc[ai][0][m][0] * r, g1 = acc[ai][0][m][1] * r, u0 = acc[ai][1][m][0] * r, u1 = acc[ai][1][m][1] * r;
                u32x4 w; w.x = cvt_pk_bf16(silu_f(g0[0]) * u0[0], silu_f(g0[1]) * u0[1]); w.y = cvt_pk_bf16(silu_f(g0[2]) * u0[2], silu_f(g0[3]) * u0[3]);
                w.z = cvt_pk_bf16(silu_f(g1[0]) * u1[0], silu_f(g1[1]) * u1[1]); w.w = cvt_pk_bf16(silu_f(g1[2]) * u1[2], silu_f(g1[3]) * u1[3]);
                *(u32x4*)rowp = w; }
    }
};
struct EpiRes {
    static constexpr bool PERM = true, MID = false; static constexpr int MID_T0 = -1, MID_T1 = -1;
    const bf16_t* Xin; bf16_t* Xout; float* part; float scale;
    __device__ __forceinline__ void operator()(const f32x4 (&acc)[2][2][4][2], const Unit& u, int wr, int wc, int fr_, int fq_) const {
        int fr = fr_, fq = fq_; asm volatile("" : "+v"(fr), "+v"(fq));
        const int row0 = u.pm * BM + wr * 64 + fr, col0 = u.pn * BM + wc * 32 + 8 * fq;
        u32x4 bs[2][4][2];
#pragma unroll
        for (int ai = 0; ai < 2; ++ai)
#pragma unroll
            for (int m = 0; m < 4; ++m) { const size_t off = (size_t)(row0 + ai * HALF + m * 16) * D + col0;
#pragma unroll
                for (int bj = 0; bj < 2; ++bj) bs[ai][m][bj] = *(const u32x4*)(Xin + off + bj * HALF); }
        asm volatile("" ::: "memory");
#pragma unroll
        for (int ai = 0; ai < 2; ++ai)
#pragma unroll
            for (int m = 0; m < 4; ++m) { const int row = row0 + ai * HALF + m * 16; const size_t off = (size_t)row * D + col0; float ss = 0.f;
#pragma unroll
                for (int bj = 0; bj < 2; ++bj) { const u32x4 x = bs[ai][m][bj]; const f32x4 a0 = acc[ai][bj][m][0] * scale, a1 = acc[ai][bj][m][1] * scale;
                    u32x4 w; w.x = cvt_pk_bf16(bf_lo(x.x) + a0[0], bf_hi(x.x) + a0[1]); w.y = cvt_pk_bf16(bf_lo(x.y) + a0[2], bf_hi(x.y) + a0[3]);
                    w.z = cvt_pk_bf16(bf_lo(x.z) + a1[0], bf_hi(x.z) + a1[1]); w.w = cvt_pk_bf16(bf_lo(x.w) + a1[2], bf_hi(x.w) + a1[3]);
                    *(u32x4*)(Xout + off + bj * HALF) = w;
                    { const float a0 = bf_lo(w.x), a1 = bf_hi(w.x), a2 = bf_lo(w.y), a3 = bf_hi(w.y), a4 = bf_lo(w.z), a5 = bf_hi(w.z), a6 = bf_lo(w.w), a7 = bf_hi(w.w);
                      ss += ((a0 * a0 + a1 * a1) + (a2 * a2 + a3 * a3)) + ((a4 * a4 + a5 * a5) + (a6 * a6 + a7 * a7)); } }
                ss += __shfl_xor(ss, 16); ss += __shfl_xor(ss, 32);
                if (fq == 0) part[(size_t)row * 32 + u.pn * 4 + wc] = ss; }
    }
};
struct EpiProj {
    static constexpr bool PERM = true, MID = true; static constexpr int MID_T0 = 32, MID_T1 = 48;
    const bf16_t* Z; bf16_t* O;
    __device__ __forceinline__ void mid(f32x4 (&acc)[2][2][4][2], const Unit& u, int t, int wr, int wc, int fr_, int fq_) const {
        int fr = fr_, fq = fq_; asm volatile("" : "+v"(fr), "+v"(fq));
        const int row0 = u.pm * BM + wr * 64 + fr, col0 = u.pn * BM + wc * 32 + 8 * fq; const int cn = (t == MID_T0) ? C_GL : C_GL + D;
#pragma unroll
        for (int ai = 0; ai < 2; ++ai) { u32x4 ga[4][2], gb[4][2];
#pragma unroll
            for (int m = 0; m < 4; ++m) { const bf16_t* zp = Z + (size_t)(row0 + ai * HALF + m * 16) * DIN + col0 + cn;
#pragma unroll
                for (int bj = 0; bj < 2; ++bj) { ga[m][bj] = *(const u32x4*)(zp + bj * HALF); gb[m][bj] = *(const u32x4*)(zp + D + bj * HALF); } }
            asm volatile("" ::: "memory");
#pragma unroll
            for (int m = 0; m < 4; ++m)
#pragma unroll
                for (int bj = 0; bj < 2; ++bj) { const u32x4 a = ga[m][bj], b = gb[m][bj]; f32x4& v0 = acc[ai][bj][m][0]; f32x4& v1 = acc[ai][bj][m][1];
                    v0[0] *= bf_lo(a.x) * __builtin_amdgcn_rcpf(bf_lo(b.x)); v0[1] *= bf_hi(a.x) * __builtin_amdgcn_rcpf(bf_hi(b.x)); v0[2] *= bf_lo(a.y) * __builtin_amdgcn_rcpf(bf_lo(b.y)); v0[3] *= bf_hi(a.y) * __builtin_amdgcn_rcpf(bf_hi(b.y));
                    v1[0] *= bf_lo(a.z) * __builtin_amdgcn_rcpf(bf_lo(b.z)); v1[1] *= bf_hi(a.z) * __builtin_amdgcn_rcpf(bf_hi(b.z)); v1[2] *= bf_lo(a.w) * __builtin_amdgcn_rcpf(bf_lo(b.w)); v1[3] *= bf_hi(a.w) * __builtin_amdgcn_rcpf(bf_hi(b.w)); }
            asm volatile("" ::: "memory"); }
    }
    __device__ __forceinline__ void operator()(const f32x4 (&acc)[2][2][4][2], const Unit& u, int wr, int wc, int fr_, int fq_) const {
        int fr = fr_, fq = fq_; asm volatile("" : "+v"(fr), "+v"(fq));
        const int row0 = u.pm * BM + wr * 64 + fr, col0 = u.pn * BM + wc * 32 + 8 * fq;
#pragma unroll
        for (int ai = 0; ai < 2; ++ai)
#pragma unroll
            for (int m = 0; m < 4; ++m) { const int row = row0 + ai * HALF + m * 16; const bf16_t* zp = Z + (size_t)row * DIN + C_GL + 2 * D + col0; bf16_t* op = O + (size_t)row * D + col0;
#pragma unroll
                for (int bj = 0; bj < 2; ++bj) { const u32x4 a = *(const u32x4*)(zp + bj * HALF); const f32x4 v0 = acc[ai][bj][m][0], v1 = acc[ai][bj][m][1];
                    u32x4 w; w.x = cvt_pk_bf16(v0[0] * bf_lo(a.x), v0[1] * bf_hi(a.x)); w.y = cvt_pk_bf16(v0[2] * bf_lo(a.y), v0[3] * bf_hi(a.y));
                    w.z = cvt_pk_bf16(v1[0] * bf_lo(a.z), v1[1] * bf_hi(a.z)); w.w = cvt_pk_bf16(v1[2] * bf_lo(a.w), v1[3] * bf_hi(a.w));
                    *(u32x4*)(op + bj * HALF) = w; } }
    }
};
struct EpiWin {
    static constexpr bool PERM = true, MID = false; static constexpr int MID_T0 = -1, MID_T1 = -1;
    bf16_t* Z; const float* bgate; const float* ropeC; const float* ropeS; const PG8_LAS float* rstd;
    __device__ __forceinline__ void operator()(const f32x4 (&acc)[2][2][4][2], const Unit& u, int wr, int wc, int fr_, int fq_) const {
        int fr = fr_, fq = fq_; asm volatile("" : "+v"(fr), "+v"(fq));
        const int pn = u.pn, row0 = u.pm * BM + wr * 64 + fr, cl = wc * 32 + 8 * fq;
        if (pn < 8) {
            const int h = pn & 3; const bool isk = pn >= 4;
            const float l2g = __builtin_log2f(1.0f - __builtin_amdgcn_exp2f(-5.0f - (float)h));
#pragma unroll
            for (int ai = 0; ai < 2; ++ai)
#pragma unroll
                for (int m = 0; m < 4; ++m) { const int row = row0 + ai * HALF + m * 16, pos = row & (T - 1), ci = row & 127;
                    const float sc = (isk ? __builtin_amdgcn_exp2f(-(float)ci * l2g) * 0.0625f : __builtin_amdgcn_exp2f((float)ci * l2g)) * rstd[ai * HALF + wr * 64 + m * 16 + fr];
                    const float* cp = ropeC + (size_t)pos * 128 + cl; const float* sp = ropeS + (size_t)pos * 128 + cl;
                    const f32x4 c0 = *(const f32x4*)cp, c1 = *(const f32x4*)(cp + 4), s0 = *(const f32x4*)sp, s1 = *(const f32x4*)(sp + 4);
                    const f32x4 t1a = acc[ai][0][m][0], t1b = acc[ai][0][m][1], t2a = acc[ai][1][m][0], t2b = acc[ai][1][m][1];
                    const f32x4 o1a = (t1a * c0 - t2a * s0) * sc, o1b = (t1b * c1 - t2b * s1) * sc, o2a = (t1a * s0 + t2a * c0) * sc, o2b = (t1b * s1 + t2b * c1) * sc;
                    bf16_t* zp = Z + (size_t)row * DIN + pn * BM + cl;
                    u32x4 w; w.x = cvt_pk_bf16(o1a[0], o1a[1]); w.y = cvt_pk_bf16(o1a[2], o1a[3]); w.z = cvt_pk_bf16(o1b[0], o1b[1]); w.w = cvt_pk_bf16(o1b[2], o1b[3]); *(u32x4*)zp = w;
                    w.x = cvt_pk_bf16(o2a[0], o2a[1]); w.y = cvt_pk_bf16(o2a[2], o2a[3]); w.z = cvt_pk_bf16(o2b[0], o2b[1]); w.w = cvt_pk_bf16(o2b[2], o2b[3]); *(u32x4*)(zp + HALF) = w; }
            return;
        }
        const int mode = pn < 16 ? 0 : pn < 24 ? 1 : pn < 28 ? 2 : pn < 32 ? 3 : pn < 36 ? 4 : pn < 44 ? 0 : 5;
        const float qs = 0.08838834764831845f * LOG2E;
#pragma unroll
        for (int ai = 0; ai < 2; ++ai)
#pragma unroll
            for (int m = 0; m < 4; ++m) { const int row = row0 + ai * HALF + m * 16; bf16_t* zp = Z + (size_t)row * DIN + pn * BM + cl; const float rs = rstd[ai * HALF + wr * 64 + m * 16 + fr];
#pragma unroll
                for (int bj = 0; bj < 2; ++bj) { f32x4 v0 = acc[ai][bj][m][0] * rs, v1 = acc[ai][bj][m][1] * rs;
                    if (mode == 1) {
#pragma unroll
                        for (int j = 0; j < 4; ++j) { v0[j] = silu_f(v0[j]); v1[j] = silu_f(v1[j]); } }
                    else if (mode == 2 || mode == 3) {
#pragma unroll
                        for (int j = 0; j < 4; ++j) { v0[j] = gelu_tanh_f(v0[j]); v1[j] = gelu_tanh_f(v1[j]); } }
                    else if (mode == 4) { v0 = v0 * qs; v1 = v1 * qs; }
                    else if (mode == 5) { const float* bp = bgate + (pn * BM - C_GL) + bj * HALF + cl; const f32x4 b0 = *(const f32x4*)bp, b1 = *(const f32x4*)(bp + 4);
#pragma unroll
                        for (int j = 0; j < 4; ++j) { v0[j] = fast_sigmoid(v0[j] + b0[j]); v1[j] = fast_sigmoid(v1[j] + b1[j]); } }
                    u32x4 w; w.x = cvt_pk_bf16(v0[0], v0[1]); w.y = cvt_pk_bf16(v0[2], v0[3]); w.z = cvt_pk_bf16(v1[0], v1[1]); w.w = cvt_pk_bf16(v1[2], v1[3]);
                    *(u32x4*)(zp + bj * HALF) = w;
                     }
 }
    }
};
}

__device__ __forceinline__ float wave_sum(float v) {
#pragma unroll
    for (int o = 1; o < 64; o <<= 1) v += __shfl_xor(v, o);
    return v;
}
__device__ __forceinline__ void transpose_item(const float* W, int N, bf16* WT, int ldk, int koff, int drow0, LAS float* scr, int k0, int n0, int lane, const float* gain) {
#pragma unroll 8
    for (int i = 0; i < 32; ++i) { const int kk = 2 * i + (lane >> 5); scr[kk * 33 + (lane & 31)] = W[(size_t)(k0 + kk) * N + n0 + (lane & 31)]; }
    const int c = lane & 7;
    f32x4 g0 = (f32x4){1.f, 1.f, 1.f, 1.f}, g1 = g0;
    if (gain) { g0 = *(const f32x4*)(gain + k0 + 8 * c); g1 = *(const f32x4*)(gain + k0 + 8 * c + 4); }
    LDS_WAIT(); asm volatile("" ::: "memory");
#pragma unroll
    for (int j = 0; j < 4; ++j) { const int n = (lane >> 3) + 8 * j; const LAS float* s = scr + (8 * c) * 33 + n;
        v4u o; o.x = pk2(s[0 * 33] * g0[0], s[1 * 33] * g0[1]); o.y = pk2(s[2 * 33] * g0[2], s[3 * 33] * g0[3]); o.z = pk2(s[4 * 33] * g1[0], s[5 * 33] * g1[1]); o.w = pk2(s[6 * 33] * g1[2], s[7 * 33] * g1[3]);
        *(v4u*)(WT + (size_t)(drow0 + n) * ldk + koff + k0 + 8 * c) = o; }
    LDS_WAIT(); asm volatile("" ::: "memory");
}
struct ConvMat { const float* W; bf16* WT; int K, N, ldk, koff, gu; const float* gain; };
__device__ __forceinline__ void conv_matrix(const ConvMat& c, LAS float* scr, int gw, int NGW, int lane) {
    const int nn = c.N / 32, items = (c.K / 64) * nn;
    for (int it = gw; it < items; it += NGW) { const int kb = it / nn, nb = it - kb * nn, n0 = 32 * nb;
        const int drow0 = c.gu ? ((n0 >> 7) * 256 + (n0 & 127) + (c.gu - 1) * 128) : n0;
        transpose_item(c.W, c.N, c.WT, c.ldk, c.koff, drow0, scr, 64 * kb, n0, lane, c.gain); }
}
template <bool F32OUT>
__device__ __forceinline__ void rms_row(const bf16* xrow, const float* gain, void* orow, int lane) {
    const v4u* xr = (const v4u*)xrow + lane;
    v4u v[4]; float s = 0.f;
#pragma unroll
    for (int j = 0; j < 4; ++j) { v[j] = xr[64 * j];
        const float a0 = bf_lo(v[j].x), a1 = bf_hi(v[j].x), a2 = bf_lo(v[j].y), a3 = bf_hi(v[j].y), a4 = bf_lo(v[j].z), a5 = bf_hi(v[j].z), a6 = bf_lo(v[j].w), a7 = bf_hi(v[j].w);
        s += ((a0 * a0 + a1 * a1) + (a2 * a2 + a3 * a3)) + ((a4 * a4 + a5 * a5) + (a6 * a6 + a7 * a7)); }
    const float rstd = 1.0f / sqrtf(wave_sum(s) * (1.0f / D) + EPS);
#pragma unroll
    for (int j = 0; j < 4; ++j) { const float* gp = gain + (64 * j + lane) * 8; const f32x4 g0 = *(const f32x4*)gp, g1 = *(const f32x4*)(gp + 4);
        const f32x4 o0 = (f32x4){bf_lo(v[j].x), bf_hi(v[j].x), bf_lo(v[j].y), bf_hi(v[j].y)} * rstd * g0, o1 = (f32x4){bf_lo(v[j].z), bf_hi(v[j].z), bf_lo(v[j].w), bf_hi(v[j].w)} * rstd * g1;
        if (F32OUT) { float* op = (float*)orow + (64 * j + lane) * 8; *(f32x4*)op = o0; *(f32x4*)(op + 4) = o1; }
        else { v4u w; w.x = cvt_pk_bf16(o0[0], o0[1]); w.y = cvt_pk_bf16(o0[2], o0[3]); w.z = cvt_pk_bf16(o1[0], o1[1]); w.w = cvt_pk_bf16(o1[2], o1[3]); ((v4u*)orow + lane)[64 * j] = w; } }
}
__device__ __forceinline__ void x_row_prep(const float* xrow, bf16* orow, float* prow, int lane) {
    const f32x4* xr = (const f32x4*)xrow + lane; float s = 0.f;
#pragma unroll
    for (int j = 0; j < 8; ++j) { const f32x4 v = xr[64 * j]; v2u w; w.x = cvt_pk_bf16(v.x, v.y); w.y = cvt_pk_bf16(v.z, v.w); ((v2u*)orow + lane)[64 * j] = w;
        const float a0 = bf_lo(w.x), a1 = bf_hi(w.x), a2 = bf_lo(w.y), a3 = bf_hi(w.y); s += (a0 * a0 + a1 * a1) + (a2 * a2 + a3 * a3); }
    s = wave_sum(s);
    if (lane < 32) prow[lane] = lane == 0 ? s : 0.f;
}
__device__ __forceinline__ void panel_rstd(LAS float* tab, const float* part, int pm, int tid) {
    const int row = tid >> 1, hf = tid & 1; const float* p = part + (size_t)(pm * 256 + row) * 32 + hf * 16;
    const f32x4 a = *(const f32x4*)p, b = *(const f32x4*)(p + 4), c = *(const f32x4*)(p + 8), d = *(const f32x4*)(p + 12);
    float s = (((a[0] + a[1]) + (a[2] + a[3])) + ((b[0] + b[1]) + (b[2] + b[3]))) + (((c[0] + c[1]) + (c[2] + c[3])) + ((d[0] + d[1]) + (d[2] + d[3])));
    s += __shfl_xor(s, 1);
    if (hf == 0) tab[row] = 1.0f / sqrtf(s * (1.0f / 2048.0f) + EPS);
}

#define MFMA16(a, b, c) __builtin_amdgcn_mfma_f32_16x16x32_bf16(a, b, c, 0, 0, 0)
__device__ __forceinline__ bf16x8 ldg16(const bf16* p) { return *(const bf16x8*)p; }
__device__ __forceinline__ s16x4 lds_tr(LAS unsigned char* p) { return __builtin_amdgcn_ds_read_tr16_b64_v4i16((LAS s16x4*)p); }
__device__ __forceinline__ bf16x8 cat8(s16x4 a, s16x4 b) { return (bf16x8){a[0], a[1], a[2], a[3], b[0], b[1], b[2], b[3]}; }
__device__ __forceinline__ bf16x8 pack8(f32x4 a, f32x4 b) { v4u w; w.x = cvt_pk_bf16(a[0], a[1]); w.y = cvt_pk_bf16(a[2], a[3]); w.z = cvt_pk_bf16(b[0], b[1]); w.w = cvt_pk_bf16(b[2], b[3]); return __builtin_bit_cast(bf16x8, w); }
__device__ __forceinline__ float head_gamma(int h) { return 1.0f - __builtin_amdgcn_exp2f(-5.0f - (float)h); }

constexpr int SG_VSTRIDE = 544;
__device__ __forceinline__ void sgu_unit(LAS unsigned char* lds, const bf16* Z, bf16* ACAT, const bf16* WC, const float* lng, const float* lnb, const float* sgb, int uid, int w, int lane_in) {
    int lane = lane_in; asm volatile("" : "+v"(lane)); const int tid = w * 64 + lane;
    const int b = uid >> 8, n = (uid >> 2) & 63, gq = uid & 3, row0 = b * T + n * 128;
    const int fr = lane & 15, g = lane >> 4;
    LAS unsigned char* VN = lds; LAS float* ST = (LAS float*)(lds + 128 * SG_VSTRIDE);
    { float s1[16], s2[16];
#pragma unroll
      for (int r = 0; r < 16; ++r) { const v4u* p = (const v4u*)(Z + (size_t)(row0 + 16 * w + r) * DIN + C_SV) + lane;
        const v4u a = p[0], b = p[64];
        const float a0 = bf_lo(a.x), a1 = bf_hi(a.x), a2 = bf_lo(a.y), a3 = bf_hi(a.y), a4 = bf_lo(a.z), a5 = bf_hi(a.z), a6 = bf_lo(a.w), a7 = bf_hi(a.w);
        const float b0 = bf_lo(b.x), b1 = bf_hi(b.x), b2 = bf_lo(b.y), b3 = bf_hi(b.y), b4 = bf_lo(b.z), b5 = bf_hi(b.z), b6 = bf_lo(b.w), b7 = bf_hi(b.w);
        s1[r] = (((a0 + a1) + (a2 + a3)) + ((a4 + a5) + (a6 + a7))) + (((b0 + b1) + (b2 + b3)) + ((b4 + b5) + (b6 + b7)));
        s2[r] = (((a0 * a0 + a1 * a1) + (a2 * a2 + a3 * a3)) + ((a4 * a4 + a5 * a5) + (a6 * a6 + a7 * a7))) + (((b0 * b0 + b1 * b1) + (b2 * b2 + b3 * b3)) + ((b4 * b4 + b5 * b5) + (b6 * b6 + b7 * b7))); }
#define SG_HALVE(n_, bit_) do { const bool hi_ = (lane >> (bit_)) & 1; _Pragma("unroll") for (int i = 0; i < (n_); ++i) {         const float k1 = hi_ ? s1[(n_) + i] : s1[i], o1 = hi_ ? s1[i] : s1[(n_) + i], k2 = hi_ ? s2[(n_) + i] : s2[i], o2 = hi_ ? s2[i] : s2[(n_) + i];         s1[i] = k1 + __shfl_xor(o1, 1 << (bit_)); s2[i] = k2 + __shfl_xor(o2, 1 << (bit_)); } } while (0)
      SG_HALVE(8, 5); SG_HALVE(4, 4); SG_HALVE(2, 3); SG_HALVE(1, 2);
#undef SG_HALVE
      float t1 = s1[0], t2 = s2[0];
      t1 += __shfl_xor(t1, 2); t2 += __shfl_xor(t2, 2); t1 += __shfl_xor(t1, 1); t2 += __shfl_xor(t2, 1);
      if ((lane & 3) == 0) { const int r = ((lane >> 5) & 1) * 8 + ((lane >> 4) & 1) * 4 + ((lane >> 3) & 1) * 2 + ((lane >> 2) & 1), row = 16 * w + r;
          const float mean = t1 * (1.0f / 1024.0f), var = fmaxf(t2 * (1.0f / 1024.0f) - mean * mean, 0.f); ST[row * 2] = mean; ST[row * 2 + 1] = 1.0f / sqrtf(var + EPS); } }
    LDS_WAIT(); __syncthreads();
#pragma unroll
    for (int it = 0; it < 8; ++it) { const int p = tid + 512 * it, row = p >> 5, c8 = (p & 31) * 8;
        const v4u x = *(const v4u*)(Z + (size_t)(row0 + row) * DIN + C_SV + gq * 256 + c8);
        const float mean = ST[row * 2], rstd = ST[row * 2 + 1];
        const f32x4 g0 = *(const f32x4*)(lng + gq * 256 + c8), g1 = *(const f32x4*)(lng + gq * 256 + c8 + 4), b0 = *(const f32x4*)(lnb + gq * 256 + c8), b1 = *(const f32x4*)(lnb + gq * 256 + c8 + 4);
        v4u o;
        o.x = cvt_pk_bf16((bf_lo(x.x) - mean) * rstd * g0[0] + b0[0], (bf_hi(x.x) - mean) * rstd * g0[1] + b0[1]);
        o.y = cvt_pk_bf16((bf_lo(x.y) - mean) * rstd * g0[2] + b0[2], (bf_hi(x.y) - mean) * rstd * g0[3] + b0[3]);
        o.z = cvt_pk_bf16((bf_lo(x.z) - mean) * rstd * g1[0] + b1[0], (bf_hi(x.z) - mean) * rstd * g1[1] + b1[1]);
        o.w = cvt_pk_bf16((bf_lo(x.w) - mean) * rstd * g1[2] + b1[2], (bf_hi(x.w) - mean) * rstd * g1[3] + b1[3]);
        *(LAS v4u*)(VN + row * SG_VSTRIDE + c8 * 2) = o; }
    bf16x8 wf[4];
#pragma unroll
    for (int ks = 0; ks < 4; ++ks) wf[ks] = ldg16(WC + (size_t)(gq * 128 + 16 * w + fr) * 128 + ks * 32 + 8 * g);
    LDS_WAIT(); __syncthreads();
    const int row = row0 + 16 * w + fr; const float bias = sgb[gq * 128 + 16 * w + fr];
    const bf16* sup = Z + (size_t)row * DIN + C_SU + gq * 256 + 4 * g; bf16* op = ACAT + (size_t)row * KCAT + 2048 + gq * 256 + 4 * g;
    LAS unsigned char* vb = VN + (8 * g + (fr >> 2)) * SG_VSTRIDE + (fr & 3) * 8;
#pragma unroll
    for (int ct = 0; ct < 16; ++ct) { f32x4 a = (f32x4){0.f, 0.f, 0.f, 0.f};
#pragma unroll
        for (int ks = 0; ks < 4; ++ks) { const bf16x8 af = cat8(lds_tr(vb + (32 * ks) * SG_VSTRIDE + ct * 32), lds_tr(vb + (32 * ks + 4) * SG_VSTRIDE + ct * 32)); a = MFMA16(af, wf[ks], a); }
        const v2u su = *(const v2u*)(sup + 16 * ct);
        v2u o; o.x = cvt_pk_bf16(bf_lo(su.x) * (a[0] + bias), bf_hi(su.x) * (a[1] + bias)); o.y = cvt_pk_bf16(bf_lo(su.y) * (a[2] + bias), bf_hi(su.y) * (a[3] + bias));
        *(v2u*)(op + 16 * ct) = o; }
    __syncthreads();
}


constexpr int CS_KSTRIDE = 544, CS_VSTRIDE = 288, CS_VOFF = 128 * CS_KSTRIDE;
constexpr int CS_UNITS = 2 * 4 * 63 * 4;
__device__ __forceinline__ void cs_phase(LAS unsigned char* lds, const bf16* Z, bf16* SB, int first, int stride, int w, int lane_in) {
    int lane = lane_in; asm volatile("" : "+v"(lane)); const int tid = w * 64 + lane;
    const int fr = lane & 15, g = lane >> 4;
    LAS unsigned char* KC = lds; LAS unsigned char* VC = lds + CS_VOFF;
    v4u kreg[8], vreg[4];
#define CS_DECODE(u_, eq_, n_, bh_) const int eq_ = (u_) & 3, n_ = ((u_) >> 2) % 63, bh_ = ((u_) >> 2) / 63
#define CS_LOAD(u_) do { CS_DECODE(u_, eq_, n_, bh_); const bf16* zr = Z + (size_t)((bh_ >> 2) * T + n_ * 128) * DIN; \
        _Pragma("unroll") for (int it = 0; it < 8; ++it) { const int p = tid + 512 * it; kreg[it] = *(const v4u*)(zr + (size_t)(p >> 5) * DIN + C_RK + (bh_ & 3) * 256 + (p & 31) * 8); } \
        _Pragma("unroll") for (int it = 0; it < 4; ++it) { const int p = tid + 512 * it; vreg[it] = *(const v4u*)(zr + (size_t)(p >> 4) * DIN + C_RV + (bh_ & 3) * 512 + eq_ * 128 + (p & 15) * 8); } } while (0)
    if (first < CS_UNITS) CS_LOAD(first);
    LAS unsigned char* ka = KC + (4 * g + (fr >> 2)) * CS_KSTRIDE + (32 * w) * 2 + (fr & 3) * 8;
    LAS unsigned char* va = VC + (4 * g + (fr >> 2)) * CS_VSTRIDE + (fr & 3) * 8;
    v2u pend[2][8]; bf16* pend_sp = SB; bool have_pend = false;
#define CS_FLUSH() do { _Pragma("unroll") for (int i = 0; i < 2; ++i) _Pragma("unroll") for (int j = 0; j < 8; ++j) *(v2u*)(pend_sp + j * 16 * 256 + i * 16) = pend[i][j]; } while (0)
    for (int u = first; u < CS_UNITS; u += stride) {
#pragma unroll
        for (int it = 0; it < 8; ++it) { const int p = tid + 512 * it; *(LAS v4u*)(KC + (p >> 5) * CS_KSTRIDE + (p & 31) * 16) = kreg[it]; }
#pragma unroll
        for (int it = 0; it < 4; ++it) { const int p = tid + 512 * it; *(LAS v4u*)(VC + (p >> 4) * CS_VSTRIDE + (p & 15) * 16) = vreg[it]; }
        LDS_WAIT(); __syncthreads();
        if (have_pend) CS_FLUSH();
        if (u + stride < CS_UNITS) CS_LOAD(u + stride);
        f32x4 S[2][8];
#pragma unroll
        for (int i = 0; i < 2; ++i)
#pragma unroll
            for (int j = 0; j < 8; ++j) S[i][j] = (f32x4){0.f, 0.f, 0.f, 0.f};
#pragma unroll
        for (int ks = 0; ks < 4; ++ks) { bf16x8 af[2], bfv[8];
#pragma unroll
            for (int i = 0; i < 2; ++i) af[i] = cat8(lds_tr(ka + (32 * ks) * CS_KSTRIDE + i * 32), lds_tr(ka + (32 * ks + 16) * CS_KSTRIDE + i * 32));
#pragma unroll
            for (int j = 0; j < 8; ++j) bfv[j] = cat8(lds_tr(va + (32 * ks) * CS_VSTRIDE + j * 32), lds_tr(va + (32 * ks + 16) * CS_VSTRIDE + j * 32));
#pragma unroll
            for (int i = 0; i < 2; ++i)
#pragma unroll
                for (int j = 0; j < 8; ++j) S[i][j] = MFMA16(af[i], bfv[j], S[i][j]); }
        { CS_DECODE(u, eq, n, bh);
          pend_sp = SB + ((size_t)((bh * 64 + n) * 512) + eq * 128 + fr) * 256 + 32 * w + 4 * g;
#pragma unroll
          for (int i = 0; i < 2; ++i)
#pragma unroll
              for (int j = 0; j < 8; ++j) { pend[i][j].x = cvt_pk_bf16(S[i][j][0], S[i][j][1]); pend[i][j].y = cvt_pk_bf16(S[i][j][2], S[i][j][3]); } }
        have_pend = true;
        __syncthreads();
    }
    if (have_pend) CS_FLUSH();
#undef CS_FLUSH
#undef CS_LOAD
#undef CS_DECODE
}

__device__ __forceinline__ void prefix_phase(bf16* SB, int gt, int NGT) {
    for (int idx = gt; idx < 8 * 512 * 32; idx += NGT) {
        const int bh = idx >> 14, h = bh & 3; const float l2g = __builtin_log2f(head_gamma(h)), g127 = __builtin_amdgcn_exp2f(127.f * l2g), g128 = __builtin_amdgcn_exp2f(128.f * l2g);
        bf16* p = SB + (size_t)bh * 64 * 512 * 256 + (size_t)(idx & 16383) * 8;
        float r[8];
#pragma unroll
        for (int k = 0; k < 8; ++k) r[k] = 0.f;
        for (int n0 = 0; n0 < 64; n0 += 8) { v4u s[8];
#pragma unroll
            for (int k = 0; k < 8; ++k) s[k] = (n0 + k < 63) ? *(const v4u*)(p + (size_t)(n0 + k) * 512 * 256) : (v4u){0u, 0u, 0u, 0u};
#pragma unroll
            for (int k = 0; k < 8; ++k) { v4u o; o.x = cvt_pk_bf16(r[0], r[1]); o.y = cvt_pk_bf16(r[2], r[3]); o.z = cvt_pk_bf16(r[4], r[5]); o.w = cvt_pk_bf16(r[6], r[7]);
                *(v4u*)(p + (size_t)(n0 + k) * 512 * 256) = o;
                r[0] = r[0] * g128 + bf_lo(s[k].x) * g127; r[1] = r[1] * g128 + bf_hi(s[k].x) * g127; r[2] = r[2] * g128 + bf_lo(s[k].y) * g127; r[3] = r[3] * g128 + bf_hi(s[k].y) * g127;
                r[4] = r[4] * g128 + bf_lo(s[k].z) * g127; r[5] = r[5] * g128 + bf_hi(s[k].z) * g127; r[6] = r[6] * g128 + bf_lo(s[k].w) * g127; r[7] = r[7] * g128 + bf_hi(s[k].w) * g127; } }
    }
}

constexpr int AT_STRIDE = 288, AT_SLOT = 128 * AT_STRIDE, AT_VOFF = 2 * AT_SLOT, AT_BOFF = 4 * AT_SLOT;
#define AT_LOADBLK(sbk_) do { _Pragma("unroll") for (int it = 0; it < 4; ++it) { const int p = tid + 512 * it; const bf16* zr = zb + (size_t)(((((sbk_) * 128) + (p >> 4)) << dsh) + rr) * DIN + (p & 15) * 8; \
        kreg[it] = *(const v4u*)(zr + C_AK); vreg[it] = *(const v4u*)(zr + C_AV); } } while (0)
#define AT_WRITEBLK(slot_) do { _Pragma("unroll") for (int it = 0; it < 4; ++it) { const int p = tid + 512 * it; const int o = (slot_) * AT_SLOT + (p >> 4) * AT_STRIDE + (p & 15) * 16; \
        *(LAS v4u*)(lds + o) = kreg[it]; *(LAS v4u*)(lds + AT_VOFF + o) = vreg[it]; } } while (0)
struct AtPend { v2u o[8]; float lse; int rowq; };
#define AT_FLUSH(P_) do { bf16* op_ = OP + ((size_t)cfg * M + (P_).rowq) * 1024 + h * 128 + 4 * g; _Pragma("unroll") for (int mt = 0; mt < 8; ++mt) *(v2u*)(op_ + 16 * mt) = (P_).o[mt]; \
        if (g == 0) LSE[((size_t)cfg * M + (P_).rowq) * 8 + h] = (P_).lse; } while (0)
template <int PAR>
__device__ __forceinline__ void attn_unit(LAS unsigned char* lds, const bf16* Z, const bf16* zb, bf16* OP, float* LSE, v4u (&kreg)[4], v4u (&vreg)[4], AtPend& pend, bool have_pend, int cfg, int b, int h, int dsh, int rr, int sb, bool has_next, int w, int tid, int fr, int g) {
    LAS float* BL = (LAS float*)(lds + AT_BOFF);
    if (have_pend) AT_FLUSH(pend);
    const int rowq = b * T + ((sb * 128 + 16 * w + fr) << dsh) + rr;
    bf16x8 qf[4];
#pragma unroll
    for (int ks = 0; ks < 4; ++ks) qf[ks] = ldg16(Z + (size_t)rowq * DIN + C_AQ + h * 128 + ks * 32 + 8 * g);
    if (has_next) AT_LOADBLK(sb + 1);
    int wv = 16 * w; asm volatile("" : "+v"(wv));
#define AT_ROWOFF(kt_) (((((wv + 16 * (kt_)) >> 7) ^ PAR ^ 1) & 1) * AT_SLOT + ((wv + 16 * (kt_)) & 127) * AT_STRIDE)
    f32x4 st[9];
#pragma unroll
    for (int kt = 0; kt < 9; ++kt) { LAS unsigned char* kp = lds + AT_ROWOFF(kt) + fr * AT_STRIDE + g * 16; f32x4 a = (f32x4){0.f, 0.f, 0.f, 0.f};
#pragma unroll
        for (int ks = 0; ks < 4; ++ks) a = MFMA16(*(LAS bf16x8*)(kp + ks * 64), qf[ks], a);
        st[kt] = a; }
    LAS float* blp = BL + (15 + 4 * g - fr);
#pragma unroll
    for (int kt = 0; kt < 9; ++kt)
#pragma unroll
        for (int r = 0; r < 4; ++r) st[kt][r] += blp[16 * kt + r];
    if (sb == 0) {
#pragma unroll
        for (int kt = 0; kt < 9; ++kt)
#pragma unroll
            for (int r = 0; r < 4; ++r) if (wv + 16 * kt + 4 * g + r < 128) st[kt][r] = -__builtin_inff(); }
    float mx = -__builtin_inff();
#pragma unroll
    for (int kt = 0; kt < 9; ++kt)
#pragma unroll
        for (int r = 0; r < 4; ++r) mx = fmaxf(mx, st[kt][r]);
    mx = fmaxf(mx, __shfl_xor(mx, 16)); mx = fmaxf(mx, __shfl_xor(mx, 32));
    float den = 0.f;
#pragma unroll
    for (int kt = 0; kt < 9; ++kt)
#pragma unroll
        for (int r = 0; r < 4; ++r) { const float p = __builtin_amdgcn_exp2f(st[kt][r] - mx); st[kt][r] = p; den += p; }
    den += __shfl_xor(den, 16); den += __shfl_xor(den, 32);
    bf16x8 pf[5];
#pragma unroll
    for (int kk = 0; kk < 4; ++kk) pf[kk] = pack8(st[2 * kk], st[2 * kk + 1]);
    pf[4] = pack8(st[8], (f32x4){0.f, 0.f, 0.f, 0.f});
    const float rden = 1.0f / den;
    LAS unsigned char* vb = lds + AT_VOFF + (4 * g + (fr >> 2)) * AT_STRIDE + (fr & 3) * 8;
#pragma unroll
    for (int mt = 0; mt < 8; ++mt) { f32x4 o = (f32x4){0.f, 0.f, 0.f, 0.f};
#pragma unroll
        for (int kk = 0; kk < 5; ++kk) { const int t0 = 2 * kk, t1 = (2 * kk + 1 > 8) ? 8 : 2 * kk + 1;
            const bf16x8 a = cat8(lds_tr(vb + AT_ROWOFF(t0) + mt * 32), lds_tr(vb + AT_ROWOFF(t1) + mt * 32));
            o = MFMA16(a, pf[kk], o); }
        pend.o[mt].x = cvt_pk_bf16(o[0] * rden, o[1] * rden); pend.o[mt].y = cvt_pk_bf16(o[2] * rden, o[3] * rden); }
    pend.lse = mx + __builtin_log2f(den); pend.rowq = rowq;
    __syncthreads();
    if (has_next) { AT_WRITEBLK(PAR ^ 1); LDS_WAIT(); __syncthreads(); }
#undef AT_ROWOFF
}
__device__ __forceinline__ void attn_run(LAS unsigned char* lds, const bf16* Z, bf16* OP, float* LSE, const float* BIAS, int item, int w, int lane_in) {
    int lane = lane_in; asm volatile("" : "+v"(lane)); const int tid = w * 64 + lane;
    const int cfg = item >> 8, b = (item >> 7) & 1, h = (item >> 4) & 7, run = item & 15;
    const int dsh = 2 * cfg, rr = run & ((1 << dsh) - 1), sb0 = 4 * (run >> dsh);
    const int fr = lane & 15, g = lane >> 4;
    LAS float* BL = (LAS float*)(lds + AT_BOFF);
    const bf16* zb = Z + (size_t)(b * T) * DIN + h * 128;
    v4u kreg[4], vreg[4]; AtPend pend;
    { const int pb = sb0 > 0 ? sb0 - 1 : 0; AT_LOADBLK(pb); AT_WRITEBLK(1); }
    AT_LOADBLK(sb0);
    if (tid < 160) { const int dl = tid - 15; BL[tid] = (dl >= 0 && dl <= 128) ? BIAS[(cfg * 8 + h) * 132 + 128 - dl] : -__builtin_inff(); }
    AT_WRITEBLK(0);
    LDS_WAIT(); __syncthreads();
#pragma unroll 1
    for (int up = 0; up < 2; ++up) {
        attn_unit<0>(lds, Z, zb, OP, LSE, kreg, vreg, pend, up != 0, cfg, b, h, dsh, rr, sb0 + 2 * up, true, w, tid, fr, g);
        attn_unit<1>(lds, Z, zb, OP, LSE, kreg, vreg, pend, true, cfg, b, h, dsh, rr, sb0 + 2 * up + 1, up == 0, w, tid, fr, g);
    }
    AT_FLUSH(pend);
}
#undef AT_LOADBLK
#undef AT_WRITEBLK
#undef AT_FLUSH

constexpr int RO_KSTRIDE = 544, RO_VSTRIDE = 160, RO_VOFF = 64 * RO_KSTRIDE, RO_BUF = RO_VOFF + 128 * RO_VSTRIDE;
__device__ __forceinline__ void retout_unit(LAS unsigned char* lds, const bf16* Z, const bf16* RT, bf16* ACAT, int uid, int w, int lane_in) {
    int lane = lane_in; asm volatile("" : "+v"(lane)); const int tid = w * 64 + lane;
    const int b = uid >> 8, h = (uid >> 6) & 3, n = uid & 63, row0 = b * T + n * 128;
    const int fr = lane & 15, g = lane >> 4, rowq = row0 + 16 * w + fr;
    const float gamma = head_gamma(h);
    const bf16* vsrc = Z + (size_t)row0 * DIN + C_RV + h * 512;
    const bf16* rsrc = RT + (size_t)(((b * 4 + h) * 64 + n) * 512) * 256;
    v4u rreg[4], vreg[2];
#define RO_LOAD(c_) do { _Pragma("unroll") for (int it = 0; it < 4; ++it) { const int p = tid + 512 * it; rreg[it] = *(const v4u*)(rsrc + (size_t)((c_) * 64 + (p >> 5)) * 256 + (p & 31) * 8); } \
        _Pragma("unroll") for (int it = 0; it < 2; ++it) { const int p = tid + 512 * it; vreg[it] = *(const v4u*)(vsrc + (size_t)(p >> 3) * DIN + (c_) * 64 + (p & 7) * 8); } } while (0)
#define RO_WRITE(buf_) do { _Pragma("unroll") for (int it = 0; it < 4; ++it) { const int p = tid + 512 * it; *(LAS v4u*)(lds + (buf_) * RO_BUF + (p >> 5) * RO_KSTRIDE + (p & 31) * 16) = rreg[it]; } \
        _Pragma("unroll") for (int it = 0; it < 2; ++it) { const int p = tid + 512 * it; *(LAS v4u*)(lds + (buf_) * RO_BUF + RO_VOFF + (p >> 3) * RO_VSTRIDE + (p & 7) * 16) = vreg[it]; } } while (0)
    { v4u kreg[8];
#pragma unroll
      for (int it = 0; it < 8; ++it) { const int p = tid + 512 * it; kreg[it] = *(const v4u*)(Z + (size_t)(row0 + (p >> 5)) * DIN + C_RK + h * 256 + (p & 31) * 8); }
#pragma unroll
      for (int it = 0; it < 8; ++it) { const int p = tid + 512 * it; *(LAS v4u*)(lds + (p >> 5) * RO_KSTRIDE + (p & 31) * 16) = kreg[it]; } }
    bf16x8 qf[8];
#pragma unroll
    for (int ks = 0; ks < 8; ++ks) qf[ks] = ldg16(Z + (size_t)rowq * DIN + C_RQ + h * 256 + ks * 32 + 8 * g);
    LDS_WAIT(); __syncthreads();
    RO_LOAD(0);
    f32x4 st[8];
#pragma unroll
    for (int jt = 0; jt < 8; ++jt) { st[jt] = (f32x4){0.f, 0.f, 0.f, 0.f};
        if (jt <= w) { LAS unsigned char* kp = lds + (16 * jt + fr) * RO_KSTRIDE + g * 16; f32x4 a = (f32x4){0.f, 0.f, 0.f, 0.f};
#pragma unroll
            for (int ks = 0; ks < 8; ++ks) a = MFMA16(*(LAS bf16x8*)(kp + ks * 64), qf[ks], a);
            if (jt == w) {
#pragma unroll
                for (int r = 0; r < 4; ++r) if (4 * g + r > fr) a[r] = 0.f; }
            st[jt] = a; } }
    bf16x8 pf[4];
#pragma unroll
    for (int kk = 0; kk < 4; ++kk) pf[kk] = pack8(st[2 * kk], st[2 * kk + 1]);
    __syncthreads();
    RO_WRITE(0); LDS_WAIT(); __syncthreads();
    f32x4 o[32];
    LAS unsigned char* ra = lds + fr * RO_KSTRIDE + g * 16;
    LAS unsigned char* va = lds + RO_VOFF + (4 * g + (fr >> 2)) * RO_VSTRIDE + (fr & 3) * 8;
#pragma unroll
    for (int c = 0; c < 8; ++c) {
        if (c < 7) RO_LOAD(c + 1);
#pragma unroll
        for (int e4 = 0; e4 < 4; ++e4) { f32x4 a = (f32x4){0.f, 0.f, 0.f, 0.f};
#pragma unroll
            for (int ks = 0; ks < 8; ++ks) a = MFMA16(*(LAS bf16x8*)(ra + (c & 1) * RO_BUF + e4 * 16 * RO_KSTRIDE + ks * 64), qf[ks], a);
            a = a * gamma;
#pragma unroll
            for (int kk = 0; kk < 4; ++kk) if (2 * kk <= w) {
                const bf16x8 af = cat8(lds_tr(va + (c & 1) * RO_BUF + (32 * kk) * RO_VSTRIDE + e4 * 32), lds_tr(va + (c & 1) * RO_BUF + (32 * kk + 16) * RO_VSTRIDE + e4 * 32));
                a = MFMA16(af, pf[kk], a); }
            o[4 * c + e4] = a; }
        if (c < 7) RO_WRITE((c + 1) & 1);
        LDS_WAIT(); __syncthreads();
    }
    float ss = 0.f;
#pragma unroll
    for (int et = 0; et < 32; ++et) ss += (o[et][0] * o[et][0] + o[et][1] * o[et][1]) + (o[et][2] * o[et][2] + o[et][3] * o[et][3]);
    ss += __shfl_xor(ss, 16); ss += __shfl_xor(ss, 32);
    const float rn = 1.0f / sqrtf(ss * (1.0f / 512.0f) + EPS);
    const bf16* rgp = Z + (size_t)rowq * DIN + C_RG + h * 512 + 4 * g; bf16* op = ACAT + (size_t)rowq * KCAT + h * 512 + 4 * g;
#pragma unroll
    for (int et = 0; et < 32; ++et) { const v2u rg = *(const v2u*)(rgp + 16 * et);
        v2u ov; ov.x = cvt_pk_bf16(bf_lo(rg.x) * o[et][0] * rn, bf_hi(rg.x) * o[et][1] * rn); ov.y = cvt_pk_bf16(bf_lo(rg.y) * o[et][2] * rn, bf_hi(rg.y) * o[et][3] * rn);
        *(v2u*)(op + 16 * et) = ov; }
#undef RO_LOAD
#undef RO_WRITE
}
constexpr int AT1_VSTRIDE = 288;
__device__ __forceinline__ void attn_unit(LAS unsigned char* lds, const bf16* Z, bf16* OP, float* LSE, const float* BIAS, int uid, int w, int lane_in) {
    int lane = lane_in; asm volatile("" : "+v"(lane)); const int tid = w * 64 + lane;
    const int cfg = uid >> 10, b = (uid >> 9) & 1, h = (uid >> 6) & 7, u64 = uid & 63;
    const int dsh = 2 * cfg, dm = (1 << dsh) - 1, rr = u64 & dm, sb = u64 >> dsh;
    LAS unsigned char* VS = lds; LAS float* BL = (LAS float*)(lds + 256 * AT1_VSTRIDE);
    const int fr = lane & 15, g = lane >> 4;
#pragma unroll
    for (int it = 0; it < 8; ++it) { const int p = tid + 512 * it, row = p >> 4, c16 = p & 15; int s = (sb - 1) * 128 + row; s = s < 0 ? 0 : s;
        const v4u v = *(const v4u*)(Z + (size_t)(b * T + (s << dsh) + rr) * DIN + C_AV + h * 128 + c16 * 8);
        *(LAS v4u*)(VS + row * AT1_VSTRIDE + c16 * 16) = v; }
    if (tid < 132) BL[tid] = BIAS[(cfg * 8 + h) * 132 + tid];
    const int rowq = b * T + ((sb * 128 + 16 * w + fr) << dsh) + rr;
    bf16x8 qf[4];
#pragma unroll
    for (int ks = 0; ks < 4; ++ks) qf[ks] = ldg16(Z + (size_t)rowq * DIN + C_AQ + h * 128 + ks * 32 + 8 * g);
    f32x4 st[9];
#pragma unroll
    for (int kt = 0; kt < 9; ++kt) { int s = (sb - 1) * 128 + 16 * w + 16 * kt + fr; s = s < 0 ? 0 : s;
        const bf16* kp = Z + (size_t)(b * T + (s << dsh) + rr) * DIN + C_AK + h * 128 + 8 * g; f32x4 a = (f32x4){0.f, 0.f, 0.f, 0.f};
#pragma unroll
        for (int ks = 0; ks < 4; ++ks) a = MFMA16(ldg16(kp + ks * 32), qf[ks], a);
        st[kt] = a; }
    LDS_WAIT(); __syncthreads();
    float mx = (-__builtin_inff());
#pragma unroll
    for (int kt = 0; kt < 9; ++kt)
#pragma unroll
        for (int r = 0; r < 4; ++r) { const int delta = 16 * kt + 4 * g + r - fr, jj = 16 * w + 16 * kt + 4 * g + r;
            const bool ok = (delta >= 0) && (delta <= 128) && (sb > 0 || jj >= 128);
            const int steps = ok ? 128 - delta : 0;
            const float l = ok ? st[kt][r] + BL[steps] : (-__builtin_inff()); st[kt][r] = l; mx = fmaxf(mx, l); }
    mx = fmaxf(mx, __shfl_xor(mx, 16)); mx = fmaxf(mx, __shfl_xor(mx, 32));
    float den = 0.f;
#pragma unroll
    for (int kt = 0; kt < 9; ++kt)
#pragma unroll
        for (int r = 0; r < 4; ++r) { const float p = __builtin_amdgcn_exp2f(st[kt][r] - mx); st[kt][r] = p; den += p; }
    den += __shfl_xor(den, 16); den += __shfl_xor(den, 32);
    bf16x8 pf[5];
#pragma unroll
    for (int kk = 0; kk < 4; ++kk) pf[kk] = pack8(st[2 * kk], st[2 * kk + 1]);
    pf[4] = pack8(st[8], (f32x4){0.f, 0.f, 0.f, 0.f});
    const float rden = 1.0f / den;
    bf16* op = OP + ((size_t)cfg * M + rowq) * 1024 + h * 128 + 4 * g;
    LAS unsigned char* vb = VS + (16 * w + 4 * g + (fr >> 2)) * AT1_VSTRIDE + (fr & 3) * 8;
#pragma unroll
    for (int mt = 0; mt < 8; ++mt) { f32x4 o = (f32x4){0.f, 0.f, 0.f, 0.f};
#pragma unroll
        for (int kk = 0; kk < 5; ++kk) { const int t0 = 2 * kk, t1 = (2 * kk + 1 > 8) ? 8 : 2 * kk + 1;
            const bf16x8 a = cat8(lds_tr(vb + t0 * 16 * AT1_VSTRIDE + mt * 32), lds_tr(vb + t1 * 16 * AT1_VSTRIDE + mt * 32));
            o = MFMA16(a, pf[kk], o); }
        v2u wv; wv.x = cvt_pk_bf16(o[0] * rden, o[1] * rden); wv.y = cvt_pk_bf16(o[2] * rden, o[3] * rden);
        *(v2u*)(op + 16 * mt) = wv; }
    if (g == 0) LSE[((size_t)cfg * M + rowq) * 8 + h] = mx + __builtin_log2f(den);
    __syncthreads();
}

constexpr int SC_KSTRIDE = 544, SC_VSTRIDE = 160, SC_VOFF = 128 * SC_KSTRIDE;
__device__ __forceinline__ void scan_unit(LAS unsigned char* lds, const bf16* Z, bf16* RT, int uid, int w, int lane_in) {
    int lane = lane_in; asm volatile("" : "+v"(lane)); const int tid = w * 64 + lane;
    const int b = uid >> 5, h = (uid >> 3) & 3, es = uid & 7;
    const int fr = lane & 15, g = lane >> 4;
    const float l2g = __builtin_log2f(head_gamma(h)), g127 = __builtin_amdgcn_exp2f(127.f * l2g), g128 = __builtin_amdgcn_exp2f(128.f * l2g);
    LAS unsigned char* KC = lds; LAS unsigned char* VC = lds + SC_VOFF;
    v4u kreg[8], vreg[2];
    const bf16* kbase = Z + (size_t)(b * T) * DIN + C_RK + h * 256; const bf16* vbase = Z + (size_t)(b * T) * DIN + C_RV + h * 512 + es * 64;
#define SC_LOAD(n_) do { _Pragma("unroll") for (int it = 0; it < 8; ++it) { const int p = tid + 512 * it; kreg[it] = *(const v4u*)(kbase + (size_t)((n_) * 128 + (p >> 5)) * DIN + (p & 31) * 8); } \
        _Pragma("unroll") for (int it = 0; it < 2; ++it) { const int p = tid + 512 * it; vreg[it] = *(const v4u*)(vbase + (size_t)((n_) * 128 + (p >> 3)) * DIN + (p & 7) * 8); } } while (0)
    SC_LOAD(0);
    f32x4 R[2][4];
#pragma unroll
    for (int i = 0; i < 2; ++i)
#pragma unroll
        for (int j = 0; j < 4; ++j) R[i][j] = (f32x4){0.f, 0.f, 0.f, 0.f};
    bf16* rtb = RT + ((size_t)((b * 4 + h) * 64) * 512 + es * 64 + fr) * 256 + 32 * w + 4 * g;
    LAS unsigned char* ka = KC + (8 * g + (fr >> 2)) * SC_KSTRIDE + (32 * w) * 2 + (fr & 3) * 8;
    LAS unsigned char* va = VC + (8 * g + (fr >> 2)) * SC_VSTRIDE + (fr & 3) * 8;
    for (int n = 0; n < 64; ++n) {
#pragma unroll
        for (int it = 0; it < 8; ++it) { const int p = tid + 512 * it; *(LAS v4u*)(KC + (p >> 5) * SC_KSTRIDE + (p & 31) * 16) = kreg[it]; }
#pragma unroll
        for (int it = 0; it < 2; ++it) { const int p = tid + 512 * it; *(LAS v4u*)(VC + (p >> 3) * SC_VSTRIDE + (p & 7) * 16) = vreg[it]; }
        LDS_WAIT(); __syncthreads();
        if (n < 63) SC_LOAD(n + 1);
#pragma unroll
        for (int i = 0; i < 2; ++i)
#pragma unroll
            for (int j = 0; j < 4; ++j) { v2u o; o.x = cvt_pk_bf16(R[i][j][0], R[i][j][1]); o.y = cvt_pk_bf16(R[i][j][2], R[i][j][3]);
                *(v2u*)(rtb + (size_t)n * 512 * 256 + j * 16 * 256 + i * 16) = o; }
        if (n < 63) {
            f32x4 S[2][4];
#pragma unroll
            for (int i = 0; i < 2; ++i)
#pragma unroll
                for (int j = 0; j < 4; ++j) S[i][j] = (f32x4){0.f, 0.f, 0.f, 0.f};
#pragma unroll
            for (int ks = 0; ks < 4; ++ks) { bf16x8 af[2], bfv[4];
#pragma unroll
                for (int i = 0; i < 2; ++i) af[i] = cat8(lds_tr(ka + (32 * ks) * SC_KSTRIDE + i * 32), lds_tr(ka + (32 * ks + 4) * SC_KSTRIDE + i * 32));
#pragma unroll
                for (int j = 0; j < 4; ++j) bfv[j] = cat8(lds_tr(va + (32 * ks) * SC_VSTRIDE + j * 32), lds_tr(va + (32 * ks + 4) * SC_VSTRIDE + j * 32));
#pragma unroll
                for (int i = 0; i < 2; ++i)
#pragma unroll
                    for (int j = 0; j < 4; ++j) S[i][j] = MFMA16(af[i], bfv[j], S[i][j]); }
#pragma unroll
            for (int i = 0; i < 2; ++i)
#pragma unroll
                for (int j = 0; j < 4; ++j) R[i][j] = R[i][j] * g128 + S[i][j] * g127;
        }
        LDS_WAIT(); __syncthreads();
    }
#undef SC_LOAD
}

constexpr int RO1_VSTRIDE = 288, RO1_VBUF = 128 * RO1_VSTRIDE;
__device__ __forceinline__ void retout_old_unit(LAS unsigned char* lds, const bf16* Z, const bf16* RT, bf16* ACAT, int uid, int w, int lane_in) {
    int lane = lane_in; asm volatile("" : "+v"(lane)); const int tid = w * 64 + lane;
    const int b = uid >> 8, h = (uid >> 6) & 3, n = uid & 63, row0 = b * T + n * 128;
    const int fr = lane & 15, g = lane >> 4, rowq = row0 + 16 * w + fr;
    const float gamma = head_gamma(h);
    const bf16* vsrc = Z + (size_t)row0 * DIN + C_RV + h * 512;
    v4u vreg[4];
#define RO1_LOAD(ec_) do { _Pragma("unroll") for (int it = 0; it < 4; ++it) { const int p = tid + 512 * it; vreg[it] = *(const v4u*)(vsrc + (size_t)(p >> 4) * DIN + (ec_) * 128 + (p & 15) * 8); } } while (0)
#define RO1_WRITE(buf_) do { _Pragma("unroll") for (int it = 0; it < 4; ++it) { const int p = tid + 512 * it; *(LAS v4u*)(lds + (buf_) * RO1_VBUF + (p >> 4) * RO1_VSTRIDE + (p & 15) * 16) = vreg[it]; } } while (0)
    RO1_LOAD(0);
    bf16x8 qf[8];
#pragma unroll
    for (int ks = 0; ks < 8; ++ks) qf[ks] = ldg16(Z + (size_t)rowq * DIN + C_RQ + h * 256 + ks * 32 + 8 * g);
    f32x4 st[8];
#pragma unroll
    for (int jt = 0; jt < 8; ++jt) { st[jt] = (f32x4){0.f, 0.f, 0.f, 0.f};
        if (jt <= w) { const bf16* kp = Z + (size_t)(row0 + 16 * jt + fr) * DIN + C_RK + h * 256 + 8 * g; f32x4 a = (f32x4){0.f, 0.f, 0.f, 0.f};
#pragma unroll
            for (int ks = 0; ks < 8; ++ks) a = MFMA16(ldg16(kp + ks * 32), qf[ks], a);
            if (jt == w) {
#pragma unroll
                for (int r = 0; r < 4; ++r) if (4 * g + r > fr) a[r] = 0.f; }
            st[jt] = a; } }
    bf16x8 pf[4];
#pragma unroll
    for (int kk = 0; kk < 4; ++kk) pf[kk] = pack8(st[2 * kk], st[2 * kk + 1]);
    RO1_WRITE(0); LDS_WAIT(); __syncthreads();
    f32x4 o[32];
    const bf16* rtp = RT + ((size_t)(((b * 4 + h) * 64 + n) * 512) + fr) * 256 + 8 * g;
    LAS unsigned char* vb0 = lds + (4 * g + (fr >> 2)) * RO1_VSTRIDE + (fr & 3) * 8;
#pragma unroll
    for (int ec = 0; ec < 4; ++ec) {
        if (ec < 3) RO1_LOAD(ec + 1);
        LAS unsigned char* vb = vb0 + (ec & 1) * RO1_VBUF;
#pragma unroll
        for (int e8 = 0; e8 < 8; ++e8) { const int et = 8 * ec + e8; f32x4 a = (f32x4){0.f, 0.f, 0.f, 0.f};
#pragma unroll
            for (int ks = 0; ks < 8; ++ks) a = MFMA16(ldg16(rtp + (size_t)et * 16 * 256 + ks * 32), qf[ks], a);
            a = a * gamma;
#pragma unroll
            for (int kk = 0; kk < 4; ++kk) if (2 * kk <= w) {
                const bf16x8 af = cat8(lds_tr(vb + (32 * kk) * RO1_VSTRIDE + e8 * 32), lds_tr(vb + (32 * kk + 16) * RO1_VSTRIDE + e8 * 32));
                a = MFMA16(af, pf[kk], a); }
            o[et] = a; }
        if (ec < 3) RO1_WRITE((ec + 1) & 1);
        LDS_WAIT(); __syncthreads();
    }
    float ss = 0.f;
#pragma unroll
    for (int et = 0; et < 32; ++et) ss += (o[et][0] * o[et][0] + o[et][1] * o[et][1]) + (o[et][2] * o[et][2] + o[et][3] * o[et][3]);
    ss += __shfl_xor(ss, 16); ss += __shfl_xor(ss, 32);
    const float rn = 1.0f / sqrtf(ss * (1.0f / 512.0f) + EPS);
    const bf16* rgp = Z + (size_t)rowq * DIN + C_RG + h * 512 + 4 * g; bf16* op = ACAT + (size_t)rowq * KCAT + h * 512 + 4 * g;
#pragma unroll
    for (int et = 0; et < 32; ++et) { const v2u rg = *(const v2u*)(rgp + 16 * et);
        v2u ov; ov.x = cvt_pk_bf16(bf_lo(rg.x) * o[et][0] * rn, bf_hi(rg.x) * o[et][1] * rn); ov.y = cvt_pk_bf16(bf_lo(rg.y) * o[et][2] * rn, bf_hi(rg.y) * o[et][3] * rn);
        *(v2u*)(op + 16 * et) = ov; }
#undef RO1_LOAD
#undef RO1_WRITE
}
#ifndef NEW_RET
#define NEW_RET 1
#endif
#ifndef NEW_ATTN
#define NEW_ATTN 1
#endif
#ifndef NEW_RETOUT
#define NEW_RETOUT 1
#endif
#ifndef SUBDUP
#define SUBDUP 0
#endif
#ifndef SUB_MASK
#define SUB_MASK 7
#endif
#ifndef DUP_MASK
#define DUP_MASK 0u
#endif
#define DUPN(k_) (1 + (int)((DUP_MASK >> (k_)) & 1u))
#ifndef SITE_MASK
#define SITE_MASK 0xFFFFFFFFu
#endif

struct Params { const float* in[22]; float* out; unsigned char* ws; int ph_lo, ph_hi; };
typedef __attribute__((address_space(4))) const unsigned char* kargp_t;
typedef GAS unsigned char* g_u8p; typedef GAS float* g_f32p; typedef const GAS float* g_cf32p;
typedef __attribute__((address_space(4))) const g_u8p* kslot_u8; typedef __attribute__((address_space(4))) const g_f32p* kslot_f32; typedef __attribute__((address_space(4))) const g_cf32p* kslot_cf32;

__global__ void __launch_bounds__(NWAVES * 64, 2) fwd_kernel(Params P) {
    extern __shared__ __attribute__((aligned(16))) unsigned char lds_raw[];
    LAS unsigned char* lds = (LAS unsigned char*)lds_raw;
    const int wave = __builtin_amdgcn_readfirstlane((int)threadIdx.x >> 6);
    for (int u = threadIdx.x; u < (LDS_BYTES - LDSCTL_OFF) / 4; u += NWAVES * 64) ((LAS unsigned*)(lds + LDSCTL_OFF))[u] = 0u;
    __syncthreads();
#if MK_PER_PHASE
    XcdBarrier bar; bar.bar = nullptr; bar.x = 0; bar.st = nullptr;
#else
    XcdBarrier bar = xcd_barrier_post((unsigned*)(P.ws + WS_CTL) + CW_BAR, (volatile LAS unsigned*)(lds + MISC_OFF) + 8);
#endif
    const int lo = P.ph_lo, hi = P.ph_hi;
    int ph = 0, site = 0;
#define IN_PH(k_) (((SITE_MASK >> (k_)) & 1u) && lo <= ph && ph < hi)
#define PH_IDS() int lanep; asm volatile("v_mbcnt_lo_u32_b32 %0, -1, 0\n\tv_mbcnt_hi_u32_b32 %0, -1, %0" : "=v"(lanep)); const int tidp = wave * 64 + lanep; (void)tidp; \
    kargp_t ka_ = (kargp_t)__builtin_amdgcn_kernarg_segment_ptr(); asm volatile("" : "+s"(ka_)); \
    unsigned char* const ws = (unsigned char*)*(kslot_u8)(ka_ + 184); (void)ws; \
    int G = gridDim.x, wg = blockIdx.x; asm volatile("" : "+s"(G), "+s"(wg)); const int gw = wg * NWAVES + wave, NGW = G * NWAVES; (void)gw; (void)NGW
#define KIN(i) ((const float*)*(kslot_cf32)(ka_ + 8 * (i)))
#define KOUT() ((float*)*(kslot_f32)(ka_ + 176))
#if MK_PER_PHASE
#define END_PH() do { ++ph; } while (0)
#else
#define END_PH() do { ++ph; xcd_barrier(bar, wave); } while (0)
#endif
#define WSP(T_, off_) ((T_*)(ws + (off_)))
    (void)site;

    for (int l = 0; l < DEPTH; ++l) {
        if (IN_PH(0)) for (int rep_ = 0; rep_ < DUPN(0); ++rep_) { PH_IDS();
            LAS float* scr = (LAS float*)(lds + RING_OFF + wave * 16384);
            unsigned char* wb = ws + WS_W;
            const size_t oGU = (size_t)l * D * FF, oD = (size_t)l * FF * D;
            { ConvMat c{KIN(2) + oGU, (bf16*)(wb + WO_GU1), D, FF, D, 0, 1, KIN(1) + (size_t)l * D}; conv_matrix(c, scr, gw, NGW, lanep); }
            { ConvMat c{KIN(3) + oGU, (bf16*)(wb + WO_GU1), D, FF, D, 0, 2, KIN(1) + (size_t)l * D}; conv_matrix(c, scr, gw, NGW, lanep); }
            { ConvMat c{KIN(4) + oD, (bf16*)(wb + WO_D1), FF, D, FF, 0, 0, nullptr}; conv_matrix(c, scr, gw, NGW, lanep); }
            { ConvMat c{KIN(6) + (size_t)l * D * DIN, (bf16*)(wb + WO_IN), D, DIN, D, 0, 0, KIN(5) + (size_t)l * D}; conv_matrix(c, scr, gw, NGW, lanep); }
            { ConvMat c{KIN(13) + (size_t)l * 2048 * D, (bf16*)(wb + WO_CAT), 2048, D, KCAT, 0, 0, nullptr}; conv_matrix(c, scr, gw, NGW, lanep); }
            { ConvMat c{KIN(14) + (size_t)l * 1024 * D, (bf16*)(wb + WO_CAT), 1024, D, KCAT, 2048, 0, nullptr}; conv_matrix(c, scr, gw, NGW, lanep); }
            { ConvMat c{KIN(15) + (size_t)l * 1024 * D, (bf16*)(wb + WO_CAT), 1024, D, KCAT, 3072, 0, nullptr}; conv_matrix(c, scr, gw, NGW, lanep); }
            { ConvMat c{KIN(16) + (size_t)l * D * D, (bf16*)(wb + WO_OUT), D, D, D, 0, 0, nullptr}; conv_matrix(c, scr, gw, NGW, lanep); }
            { ConvMat c{KIN(18) + oGU, (bf16*)(wb + WO_GU2), D, FF, D, 0, 1, KIN(17) + (size_t)l * D}; conv_matrix(c, scr, gw, NGW, lanep); }
            { ConvMat c{KIN(19) + oGU, (bf16*)(wb + WO_GU2), D, FF, D, 0, 2, KIN(17) + (size_t)l * D}; conv_matrix(c, scr, gw, NGW, lanep); }
            { ConvMat c{KIN(20) + oD, (bf16*)(wb + WO_D2), FF, D, FF, 0, 0, nullptr}; conv_matrix(c, scr, gw, NGW, lanep); }
            const int gt = wg * (NWAVES * 64) + tidp, NGT = G * NWAVES * 64;
            { const float* sw = KIN(10) + (size_t)l * 4 * 128 * 128; bf16* WCb = WSP(bf16, WS_WC);
              for (int i = gt; i < 4 * 128 * 128; i += NGT) { const int s = i & 127, t = (i >> 7) & 127; WCb[i] = (bf16)(s <= t ? f2bf(sw[i]) : 0u); } }
            if (l == 0) {
                { const float* xin0 = KIN(0); bf16* XR = WSP(bf16, WS_X); float* PART = WSP(float, WS_PART); for (int m = gw; m < M; m += NGW) x_row_prep(xin0 + (size_t)m * D, XR + (size_t)m * D, PART + (size_t)m * 32, lanep); }
                float* ROPEC = WSP(float, WS_ROPEC); float* ROPES = WSP(float, WS_ROPES); float* BIAS = WSP(float, WS_BIAS); const float* relb = KIN(12);
                for (int i = gt; i < T * 128; i += NGT) { const int pos = i >> 7, fi = i & 127;
                    double inv = 1.0;
                    if (fi & 1) inv *= 0.930572040929699; if (fi & 2) inv *= 0.8659643233600654; if (fi & 4) inv *= 0.7498942093324559; if (fi & 8) inv *= 0.5623413251903491;
                    if (fi & 16) inv *= 0.31622776601683794; if (fi & 32) inv *= 0.1; if (fi & 64) inv *= 0.01;
                    const double ang = (double)pos * inv; const double k = __builtin_rint(ang * 0.15915494309189535);
                    double red = __builtin_fma(-k, 6.283185307179586, ang); red = __builtin_fma(-k, 2.4492935982947064e-16, red);
                    const float rf = (float)red; ROPEC[i] = cosf(rf); ROPES[i] = sinf(rf); }
                for (int i = gt; i < 3 * 8 * 132; i += NGT) { const int st = i % 132, hh = (i / 132) % 8, cfg = i / (132 * 8); float v = 0.f;
                    if (st <= 128) { const int dist = st << (2 * cfg); int bk;
                        if (dist < 16) bk = dist; else { bk = 16 + (int)(logf((float)dist / 16.0f) / 4.852030263919617f * 16.0f); bk = bk > 31 ? 31 : bk; }
                        v = relb[bk * 8 + hh] * LOG2E; }
                    BIAS[i] = v; }
            }
        }
        END_PH();
        for (int half = 0; half < 2; ++half) {
            if (IN_PH(2)) for (int rep_ = 0; rep_ < DUPN(2); ++rep_) { PH_IDS(); pg8::Gemm g{WSP(const bf16, WS_X), (const bf16*)(ws + WS_W + (half ? WO_GU2 : WO_GU1)), M, 2 * FF, D}; pg8::StaticOrder S; S.init(M, 2 * FF, G, wg);
                { pg8::Unit u0; if (S.next(0, u0)) panel_rstd((LAS float*)(lds + RSTD_OFF), WSP(const float, WS_PART), u0.pm, tidp); LDS_WAIT(); __syncthreads(); }
                pg8::EpiGU E{WSP(bf16, WS_Z), (const LAS float*)(lds + RSTD_OFF)}; pg8::gemm_phase<pg8::EpiGU, pg8::StaticOrder, true, true>(lds + RING_OFF, g, S, E, wave); }
            END_PH();
            if (IN_PH(3)) for (int rep_ = 0; rep_ < DUPN(3); ++rep_) { PH_IDS(); pg8::Gemm g{WSP(const bf16, WS_Z), (const bf16*)(ws + WS_W + (half ? WO_D2 : WO_D1)), M, D, FF}; pg8::StaticOrder S; S.init(M, D, G, wg, 4);
                pg8::EpiRes E{WSP(const bf16, WS_X), WSP(bf16, WS_X), WSP(float, WS_PART), 0.5f}; pg8::gemm_phase<pg8::EpiRes, pg8::StaticOrder, true, true>(lds + RING_OFF, g, S, E, wave); }
            END_PH();
            if (half == 0) {
                if (IN_PH(5)) for (int rep_ = 0; rep_ < DUPN(5); ++rep_) { PH_IDS(); pg8::Gemm g{WSP(const bf16, WS_X), (const bf16*)(ws + WS_W + WO_IN), M, DIN, D}; pg8::StaticOrder S; S.init(M, DIN, G, wg);
                    { pg8::Unit u0; if (S.next(0, u0)) panel_rstd((LAS float*)(lds + RSTD_OFF), WSP(const float, WS_PART), u0.pm, tidp); LDS_WAIT(); __syncthreads(); }
                    pg8::EpiWin E{WSP(bf16, WS_Z), KIN(7) + (size_t)l * 3 * D, WSP(const float, WS_ROPEC), WSP(const float, WS_ROPES), (const LAS float*)(lds + RSTD_OFF)};
                    pg8::gemm_phase<pg8::EpiWin, pg8::StaticOrder, true, true>(lds + RING_OFF, g, S, E, wave); }
                END_PH();
                if (IN_PH(6)) for (int rep_ = 0; rep_ < DUPN(6); ++rep_) { PH_IDS();
#if NEW_RET == 2
                    { for (int it = wg; it < 64; it += G) scan_unit(lds, WSP(const bf16, WS_Z), WSP(bf16, WS_RT), it, wave, lanep); }
                    { PH_IDS(); cs_phase(lds, WSP(const bf16, WS_Z), WSP(bf16, WS_END), wg, G, wave, lanep); }
#if DBG_CMP == 2
                    { PH_IDS(); cs_phase(lds, WSP(const bf16, WS_Z), WSP(bf16, WS_END + 128 * MiB), wg, G, wave, lanep); }
#endif
#elif NEW_RET
                    if (SUB_MASK & 1) for (int r2_ = 0; r2_ < 1 + (SUBDUP & 1); ++r2_) cs_phase(lds, WSP(const bf16, WS_Z), WSP(bf16, WS_RT), wg, G, wave, lanep);
#else
                    if (SUB_MASK & 1) { for (int it = wg; it < 64; it += G) scan_unit(lds, WSP(const bf16, WS_Z), WSP(bf16, WS_RT), it, wave, lanep); }
#endif
#if NEW_ATTN
                    if (SUB_MASK & 2) for (int r2_ = 0; r2_ < 1 + ((SUBDUP >> 1) & 1); ++r2_) { PH_IDS(); for (int it = wg; it < 768; it += G) attn_run(lds, WSP(const bf16, WS_Z), WSP(bf16, WS_OPART), WSP(float, WS_LSE), WSP(const float, WS_BIAS), it, wave, lanep); }
#else
                    if (SUB_MASK & 2) { PH_IDS(); for (int it = wg; it < 3072; it += G) attn_unit(lds, WSP(const bf16, WS_Z), WSP(bf16, WS_OPART), WSP(float, WS_LSE), WSP(const float, WS_BIAS), it, wave, lanep); }
#endif
                    if (SUB_MASK & 4) for (int r2_ = 0; r2_ < 1 + ((SUBDUP >> 2) & 1); ++r2_) { PH_IDS(); for (int it = wg; it < 512; it += G)
                        sgu_unit(lds, WSP(const bf16, WS_Z), WSP(bf16, WS_ACAT), WSP(const bf16, WS_WC), KIN(8) + (size_t)l * 1024, KIN(9) + (size_t)l * 1024, KIN(11) + (size_t)l * 512, it, wave, lanep); }
                }
                END_PH();
                if (IN_PH(11)) for (int rep_ = 0; rep_ < DUPN(11); ++rep_) { PH_IDS();
                    const int gt = wg * (NWAVES * 64) + tidp, NGT = G * NWAVES * 64;
#if NEW_RET == 2
#if DBG_CMP != 2
                    prefix_phase(WSP(bf16, WS_END), gt, NGT);
#endif
#elif NEW_RET
                    if (rep_ == 0) prefix_phase(WSP(bf16, WS_RT), gt, NGT); else prefix_phase(WSP(bf16, WS_END), gt, NGT);
#endif
                    const float* LSE = WSP(const float, WS_LSE); const bf16* OPART = WSP(const bf16, WS_OPART); bf16* ACAT = WSP(bf16, WS_ACAT);
                    for (int p = gt; p < M * 128; p += NGT) { const int row = p >> 7, hh = (p >> 4) & 7, c8 = (p & 15) * 8;
                        const float l0 = LSE[((size_t)0 * M + row) * 8 + hh], l1 = LSE[((size_t)1 * M + row) * 8 + hh], l2 = LSE[((size_t)2 * M + row) * 8 + hh];
                        const float mx = fmaxf(l0, fmaxf(l1, l2)); float w0 = __builtin_amdgcn_exp2f(l0 - mx), w1 = __builtin_amdgcn_exp2f(l1 - mx), w2 = __builtin_amdgcn_exp2f(l2 - mx);
                        const float rs = 1.0f / (w0 + w1 + w2); w0 *= rs; w1 *= rs; w2 *= rs;
                        const size_t o = (size_t)row * 1024 + hh * 128 + c8;
                        const v4u a = *(const v4u*)(OPART + o), b = *(const v4u*)(OPART + (size_t)M * 1024 + o), c = *(const v4u*)(OPART + (size_t)2 * M * 1024 + o);
                        v4u r;
                        r.x = cvt_pk_bf16(w0 * bf_lo(a.x) + w1 * bf_lo(b.x) + w2 * bf_lo(c.x), w0 * bf_hi(a.x) + w1 * bf_hi(b.x) + w2 * bf_hi(c.x));
                        r.y = cvt_pk_bf16(w0 * bf_lo(a.y) + w1 * bf_lo(b.y) + w2 * bf_lo(c.y), w0 * bf_hi(a.y) + w1 * bf_hi(b.y) + w2 * bf_hi(c.y));
                        r.z = cvt_pk_bf16(w0 * bf_lo(a.z) + w1 * bf_lo(b.z) + w2 * bf_lo(c.z), w0 * bf_hi(a.z) + w1 * bf_hi(b.z) + w2 * bf_hi(c.z));
                        r.w = cvt_pk_bf16(w0 * bf_lo(a.w) + w1 * bf_lo(b.w) + w2 * bf_lo(c.w), w0 * bf_hi(a.w) + w1 * bf_hi(b.w) + w2 * bf_hi(c.w));
                        *(v4u*)(ACAT + (size_t)row * KCAT + 3072 + hh * 128 + c8) = r; }
                }
                END_PH();
                if (IN_PH(7)) for (int rep_ = 0; rep_ < DUPN(7); ++rep_) { PH_IDS();
#if NEW_RET == 2 && defined(DBG_CMP)
                    { const bf16* A_ = (DBG_CMP == 2) ? WSP(const bf16, WS_END + 128 * MiB) : WSP(const bf16, WS_RT); const bf16* B_ = WSP(const bf16, WS_END); float dmx = 0.f;
                      for (size_t i = (size_t)wg * 512 + tidp; i < (size_t)8 * 64 * 512 * 256; i += (size_t)G * 512) { if (DBG_CMP == 2 && ((i >> 17) & 63) == 63) continue; const float d_ = fabsf(__uint_as_float((unsigned)A_[i] << 16) - __uint_as_float((unsigned)B_[i] << 16)); dmx = d_ > dmx ? d_ : dmx; }
                      atomicMax(WSP(unsigned, WS_CTL) + 64, __float_as_uint(dmx)); }
#endif
#if NEW_RETOUT
                    for (int it = wg; it < 512; it += G) retout_unit(lds, WSP(const bf16, WS_Z), WSP(const bf16, WS_RT), WSP(bf16, WS_ACAT), it, wave, lanep);
#else
                    for (int it = wg; it < 512; it += G) retout_old_unit(lds, WSP(const bf16, WS_Z), WSP(const bf16, WS_RT), WSP(bf16, WS_ACAT), it, wave, lanep);
#endif
                }
                END_PH();
                if (IN_PH(8)) for (int rep_ = 0; rep_ < DUPN(8); ++rep_) { PH_IDS(); pg8::Gemm g{WSP(const bf16, WS_ACAT), (const bf16*)(ws + WS_W + WO_CAT), M, D, KCAT}; pg8::StaticOrder S; S.init(M, D, G, wg, 4);
                    pg8::EpiProj E{WSP(const bf16, WS_Z), WSP(bf16, WS_MERGED)}; pg8::gemm_phase<pg8::EpiProj, pg8::StaticOrder, true, true>(lds + RING_OFF, g, S, E, wave); }
                END_PH();
                if (IN_PH(9)) for (int rep_ = 0; rep_ < DUPN(9); ++rep_) { PH_IDS(); pg8::Gemm g{WSP(const bf16, WS_MERGED), (const bf16*)(ws + WS_W + WO_OUT), M, D, D}; pg8::StaticOrder S; S.init(M, D, G, wg, 4);
                    pg8::EpiRes E{WSP(const bf16, WS_X), WSP(bf16, WS_X), WSP(float, WS_PART), 1.0f}; pg8::gemm_phase<pg8::EpiRes, pg8::StaticOrder, true, true>(lds + RING_OFF, g, S, E, wave); }
                END_PH();
            }
        }
    }
    if (IN_PH(10)) for (int rep_ = 0; rep_ < DUPN(10); ++rep_) { PH_IDS(); const bf16* X = WSP(const bf16, WS_X); const float* gain = KIN(21); float* out = KOUT();
        for (int m = gw; m < M; m += NGW) rms_row<true>(X + (size_t)m * D, gain, out + (size_t)m * D, lanep);
#if NEW_RET == 2 && defined(DBG_CMP)
        { asm volatile("s_waitcnt vmcnt(0)" ::: "memory"); const float dv = 1000.0f * __uint_as_float(__hip_atomic_load(WSP(unsigned, WS_CTL) + 64, __ATOMIC_RELAXED, __HIP_MEMORY_SCOPE_AGENT)); for (int m = gw; m < M; m += NGW) for (int c = lanep; c < D; c += 64) out[(size_t)m * D + c] = dv; }
#endif
    }
#undef IN_PH
#undef END_PH
}
constexpr int N_PHASES = DEPTH * (1 + 2 + 6 + 2) + 1;

extern "C" void kernel_launch(void* const* d_in, const int* in_sizes, int n_in, void* d_out, int out_size, void* d_ws, size_t ws_size, hipStream_t stream) {
    static int grid = 0;
    if (grid == 0) {
        if (n_in != 22 || ws_size < WS_END) { fprintf(stderr, "kernel_launch: unexpected n_in %d / ws %zu\n", n_in, ws_size); grid = -1; return; }
        int dev = 0, cus = 0, per_cu = 0;
        if (hipGetDevice(&dev) != hipSuccess || hipDeviceGetAttribute(&cus, hipDeviceAttributeMultiprocessorCount, dev) != hipSuccess) { grid = -1; return; }
        if (hipFuncSetAttribute((const void*)fwd_kernel, hipFuncAttributeMaxDynamicSharedMemorySize, LDS_BYTES) != hipSuccess) { fprintf(stderr, "kernel_launch: hipFuncSetAttribute failed\n"); grid = -1; return; }
        if (hipOccupancyMaxActiveBlocksPerMultiprocessor(&per_cu, (const void*)fwd_kernel, NWAVES * 64, LDS_BYTES) != hipSuccess || per_cu < 1)
            fprintf(stderr, "kernel_launch: occupancy query reports %d workgroups per CU\n", per_cu);
        (void)hipGetLastError();
        grid = cus;
    }
    if (grid < 0) return;
    (void)hipMemsetAsync((char*)d_ws + WS_CTL, 0, CTL_ZERO_BYTES, stream);
    Params p{};
    for (int i = 0; i < 22; ++i) p.in[i] = (const float*)d_in[i];
    p.out = (float*)d_out; p.ws = (unsigned char*)d_ws;
#if MK_PER_PHASE
    for (int k = 0; k < N_PHASES; ++k) { p.ph_lo = k; p.ph_hi = k + 1; hipLaunchKernelGGL(fwd_kernel, dim3(grid), dim3(NWAVES * 64), LDS_BYTES, stream, p); }
#else
    p.ph_lo = 0; p.ph_hi = N_PHASES;
    hipLaunchKernelGGL(fwd_kernel, dim3(grid), dim3(NWAVES * 64), LDS_BYTES, stream, p);
#endif
}
```

```cpp
#include <hip/hip_runtime.h>
#include <cstdio>
#include <cstdint>

#ifndef MK_PER_PHASE
#define MK_PER_PHASE 0
#endif

namespace pg8 {
#define PG8_LAS __attribute__((address_space(3)))
typedef unsigned short bf16_t;
typedef short bf16x8 __attribute__((ext_vector_type(8)));
typedef float f32x4 __attribute__((ext_vector_type(4)));
typedef unsigned u32x4 __attribute__((ext_vector_type(4)));
typedef unsigned u32x2 __attribute__((ext_vector_type(2)));
constexpr int BM = 256, BK = 64, HALF = 128, HTB = HALF * BK * 2  , STAGE_BYTES = 8 * HTB, NXCD = 8, WGM = 8;

__host__ __device__ __forceinline__ int lds_byte(int r, int c) { const int st = (r >> 4) * 2 + (c >> 5), rr = r & 15, cc = c & 31, ob = rr * 64 + cc * 2; return st * 1024 + (ob ^ (((ob >> 9) & 1) << 5)); }
__host__ __device__ __forceinline__ void stage_rc(int b, int& R, int& C) { const int st = b / 1024, sb = b % 1024, swz = sb ^ (((sb >> 9) & 1) << 5); R = (st >> 1) * 16 + swz / 64; C = (st & 1) * 32 + (swz % 64) / 2; }
__host__ __device__ __forceinline__ int perm32(int rho) { const int n = rho >> 4, i = rho & 15; return 8 * (i >> 2) + 4 * n + (i & 3); }

struct Unit { int pm, pn; };
struct Gemm { const bf16_t* A; const bf16_t* Bt; int M, N, K; };

struct StaticOrder {
    int nM, nN, nwg, G, c, wgm;
    __host__ __device__ void init(int M, int N, int G_, int c_, int wgm_ = WGM) { nM = M / BM; nN = N / BM; nwg = nM * nN; G = G_; c = c_; wgm = wgm_; }
    __host__ __device__ bool next(int i, Unit& u) const {
        const long L = (long)i * G + c; if (L >= nwg) return false;
        int wgid = (int)L; { const int q = nwg / NXCD, r = nwg % NXCD, xcd = wgid % NXCD, off = wgid / NXCD; wgid = (xcd < r ? xcd * (q + 1) : r * (q + 1) + (xcd - r) * q) + off; }
        const int nig = wgm * nN, gid = wgid / nig, fm = gid * wgm, gsz = (nM - fm) < wgm ? (nM - fm) : wgm;
        u.pm = fm + ((wgid % nig) % gsz); u.pn = (wgid % nig) / gsz; return true;
    }
    __device__ __forceinline__ void a_ready(const Unit&) const {}
    __device__ __forceinline__ void done(const Unit&) const {}
};

typedef float f32x2v_t __attribute__((ext_vector_type(2))); typedef __bf16 bf16x2v_t __attribute__((ext_vector_type(2)));
__device__ __forceinline__ unsigned cvt_pk_bf16(float lo, float hi) { const f32x2v_t v = {lo, hi}; const bf16x2v_t b = __builtin_convertvector(v, bf16x2v_t); return __builtin_bit_cast(unsigned, b); }
__device__ __forceinline__ float bf_lo(unsigned w) { return __uint_as_float(w << 16); }
__device__ __forceinline__ float bf_hi(unsigned w) { return __uint_as_float(w & 0xffff0000u); }
__device__ __forceinline__ float fast_sigmoid(float x) { return __builtin_amdgcn_rcpf(1.0f + __builtin_amdgcn_exp2f(-1.4426950408889634f * x)); }
__device__ __forceinline__ float silu_f(float x) { return x * fast_sigmoid(x); }
__device__ __forceinline__ float gelu_tanh_f(float x) { const float u = 0.7978845608028654f * (x + 0.044715f * x * x * x); return x * fast_sigmoid(2.0f * u); }

template <class Epi, class Sched, bool ALIGN_EPI = false, bool SP2 = false>
__device__ __forceinline__ void gemm_phase(PG8_LAS unsigned char* lds, const Gemm g, const Sched& S, const Epi& E, int wid) {
    int lane_; asm volatile("v_mbcnt_lo_u32_b32 %0, -1, 0\n\tv_mbcnt_hi_u32_b32 %0, -1, %0" : "=v"(lane_));
    const int lane = lane_, tid = wid * 64 + lane, wr = wid >> 2, wc = wid & 3, fr = lane & 15, fq = lane >> 4;
    const int K = g.K, nt = K / BK;
    unsigned voffA[2], voffB[2];
#pragma unroll
    for (int i = 0; i < 2; ++i) { int R, C; stage_rc(tid * 16 + i * 8192, R, C); const int Rb = Epi::PERM ? ((R & ~31) + perm32(R & 31)) : R;
        voffA[i] = (unsigned)(R * K + C) * 2u; voffB[i] = (unsigned)(Rb * K + C) * 2u; }
    const size_t kstep = (size_t)(BK * 2);
    const size_t hstep = (size_t)HALF * K * 2;
    const size_t tstep = 2 * hstep;
    const unsigned ldsw = (unsigned)wid * 1024u;
    const int aoff = lds_byte(wr * 64 + fr, fq * 8), boff = lds_byte(wc * 32 + fr, fq * 8);
#define PG8_SA(b, h) (((b) * 2 + (h)) * HTB)
#define PG8_SB(b, h) ((4 + (b) * 2 + (h)) * HTB)
#define PG8_STAGE(bufoff, gbase, voff) do { _Pragma("unroll") for (int _i = 0; _i < 2; ++_i) \
        __builtin_amdgcn_global_load_lds((const unsigned*)((const char*)(gbase) + (voff)[_i]), (PG8_LAS unsigned*)(lds + (bufoff) + ldsw + _i * 8192), 16, 0, 0); } while (0)
#define PG8_LDA(dst, b, h) do { _Pragma("unroll") for (int m = 0; m < 4; ++m) _Pragma("unroll") for (int k = 0; k < 2; ++k) dst[m][k] = *(const PG8_LAS bf16x8*)(lds + PG8_SA(b, h) + aoff + m * 2048 + k * 1024); } while (0)
#define PG8_LDB(dst, b, h) do { _Pragma("unroll") for (int n = 0; n < 2; ++n) _Pragma("unroll") for (int k = 0; k < 2; ++k) dst[n][k] = *(const PG8_LAS bf16x8*)(lds + PG8_SB(b, h) + boff + n * 2048 + k * 1024); } while (0)
#define PG8_MMA(ai, bj, At, Bt) do { __builtin_amdgcn_s_setprio(1); _Pragma("unroll") for (int m = 0; m < 4; ++m) _Pragma("unroll") for (int n = 0; n < 2; ++n) _Pragma("unroll") for (int k = 0; k < 2; ++k) \
        acc[ai][bj][m][n] = __builtin_amdgcn_mfma_f32_16x16x32_bf16(Bt[n][k], At[m][k], acc[ai][bj][m][n], 0, 0, 0); __builtin_amdgcn_s_setprio(0); } while (0)
#define PG8_WAIT_V(n) asm volatile("s_waitcnt vmcnt(" #n ")" ::: "memory")
#define PG8_WAIT_L(n) asm volatile("s_waitcnt lgkmcnt(" #n ")" ::: "memory")
#define PG8_BAR __builtin_amdgcn_s_barrier()
#define PG8_SCHED __builtin_amdgcn_sched_barrier(0)
    Unit cur, nxt; int ui = 0;
    if (!S.next(0, cur)) return;
    f32x4 acc[2][2][4][2];
#pragma unroll
    for (int a = 0; a < 2; ++a)
#pragma unroll
        for (int b = 0; b < 2; ++b)
#pragma unroll
            for (int m = 0; m < 4; ++m)
#pragma unroll
                for (int n = 0; n < 2; ++n) acc[a][b][m][n] = (f32x4){0.f, 0.f, 0.f, 0.f};
    bf16x8 At[4][2], B0[2][2], B1[2][2];
    const char* cA = (const char*)g.A + (size_t)cur.pm * tstep; const char* cB = (const char*)g.Bt + (size_t)cur.pn * tstep;
    S.a_ready(cur);
    if constexpr (SP2) {
        PG8_STAGE(PG8_SB(0, 0), cB, voffB); PG8_STAGE(PG8_SB(0, 1), cB + hstep, voffB); PG8_STAGE(PG8_SA(0, 0), cA, voffA); PG8_STAGE(PG8_SA(0, 1), cA + hstep, voffA);
        if (wr == 1) PG8_BAR;
        PG8_WAIT_V(2); PG8_BAR;
        PG8_STAGE(PG8_SB(1, 0), cB + kstep, voffB); PG8_STAGE(PG8_SA(1, 0), cA + kstep, voffA); PG8_STAGE(PG8_SB(1, 1), cB + hstep + kstep, voffB);
        PG8_WAIT_V(6); PG8_BAR;
    } else {
        PG8_STAGE(PG8_SB(0, 0), cB, voffB); PG8_STAGE(PG8_SA(0, 0), cA, voffA); PG8_STAGE(PG8_SB(0, 1), cB + hstep, voffB); PG8_STAGE(PG8_SA(0, 1), cA + hstep, voffA);
        if (wr == 1) PG8_BAR;
        PG8_WAIT_V(4); PG8_BAR;
        PG8_STAGE(PG8_SB(1, 0), cB + kstep, voffB); PG8_STAGE(PG8_SA(1, 0), cA + kstep, voffA); PG8_STAGE(PG8_SB(1, 1), cB + hstep + kstep, voffB);
        PG8_WAIT_V(6); PG8_BAR;
    }
    for (;;) {
        const bool has_next = S.next(ui + 1, nxt);
        const char* nA = has_next ? (const char*)g.A + (size_t)nxt.pm * tstep : cA; const char* nB = has_next ? (const char*)g.Bt + (size_t)nxt.pn * tstep : cB;
        for (int t = 0; t < nt; t += 2) {
            const bool last = (t == nt - 2);
            const char* a1 = cA + (size_t)(t + 1) * kstep;
            const char* a2 = last ? nA : cA + (size_t)(t + 2) * kstep; const char* b2 = last ? nB : cB + (size_t)(t + 2) * kstep;
            const char* a3 = a2 + kstep; const char* b3 = b2 + kstep;
            if (last && has_next) S.a_ready(nxt);
            if constexpr (Epi::MID) { if (t == Epi::MID_T0 || t == Epi::MID_T1) E.mid(acc, cur, t, wr, wc, fr, fq); }
            if constexpr (SP2) {
            PG8_LDB(B0, 0, 0); PG8_LDB(B1, 0, 1); PG8_SCHED; PG8_LDA(At, 0, 0); PG8_STAGE(PG8_SA(1, 1), a1 + hstep, voffA);
            PG8_WAIT_V(8); PG8_WAIT_L(0); PG8_BAR; PG8_MMA(0, 0, At, B0); PG8_MMA(0, 1, At, B1); PG8_BAR; PG8_SCHED;
            PG8_LDA(At, 0, 1); PG8_STAGE(PG8_SB(0, 0), b2, voffB); PG8_STAGE(PG8_SB(0, 1), b2 + hstep, voffB); PG8_STAGE(PG8_SA(0, 0), a2, voffA);
            PG8_WAIT_V(8); PG8_WAIT_L(0); PG8_BAR; PG8_MMA(1, 0, At, B0); PG8_MMA(1, 1, At, B1); PG8_BAR; PG8_SCHED;
            PG8_LDB(B0, 1, 0); PG8_LDB(B1, 1, 1); PG8_SCHED; PG8_LDA(At, 1, 0); PG8_STAGE(PG8_SA(0, 1), a2 + hstep, voffA);
            PG8_WAIT_V(8); PG8_WAIT_L(0); PG8_BAR; PG8_MMA(0, 0, At, B0); PG8_MMA(0, 1, At, B1); PG8_BAR; PG8_SCHED;
            PG8_LDA(At, 1, 1); PG8_STAGE(PG8_SB(1, 0), b3, voffB); PG8_STAGE(PG8_SB(1, 1), b3 + hstep, voffB); PG8_STAGE(PG8_SA(1, 0), a3, voffA);
            PG8_WAIT_V(8); PG8_WAIT_L(0); PG8_BAR; PG8_MMA(1, 0, At, B0); PG8_MMA(1, 1, At, B1); PG8_BAR; PG8_SCHED;
            } else {
            PG8_LDB(B0, 0, 0); PG8_SCHED; PG8_LDA(At, 0, 0); PG8_STAGE(PG8_SA(1, 1), a1 + hstep, voffA);
            PG8_WAIT_L(8); PG8_BAR; PG8_WAIT_L(0); PG8_MMA(0, 0, At, B0); PG8_BAR; PG8_SCHED;
            PG8_LDB(B1, 0, 1); PG8_STAGE(PG8_SB(0, 0), b2, voffB);
            PG8_BAR; PG8_WAIT_L(0); PG8_MMA(0, 1, At, B1); PG8_BAR;
            PG8_LDA(At, 0, 1); PG8_STAGE(PG8_SA(0, 0), a2, voffA);
            PG8_BAR; PG8_WAIT_L(0); PG8_MMA(1, 0, At, B0); PG8_BAR; PG8_SCHED;
            PG8_STAGE(PG8_SB(0, 1), b2 + hstep, voffB);
            PG8_WAIT_V(6); PG8_BAR; PG8_MMA(1, 1, At, B1); PG8_BAR;
            PG8_LDB(B0, 1, 0); PG8_SCHED; PG8_LDA(At, 1, 0); PG8_STAGE(PG8_SA(0, 1), a2 + hstep, voffA);
            PG8_WAIT_L(8); PG8_BAR; PG8_WAIT_L(0); PG8_MMA(0, 0, At, B0); PG8_BAR; PG8_SCHED;
            PG8_LDB(B1, 1, 1); PG8_STAGE(PG8_SB(1, 0), b3, voffB);
            PG8_BAR; PG8_WAIT_L(0); PG8_MMA(0, 1, At, B1); PG8_BAR;
            PG8_LDA(At, 1, 1); PG8_STAGE(PG8_SA(1, 0), a3, voffA);
            PG8_BAR; PG8_WAIT_L(0); PG8_MMA(1, 0, At, B0); PG8_BAR; PG8_SCHED;
            PG8_STAGE(PG8_SB(1, 1), b3 + hstep, voffB);
            PG8_WAIT_V(6); PG8_BAR; PG8_MMA(1, 1, At, B1); PG8_BAR;
            }
        }
        if constexpr (ALIGN_EPI) { if (wr == 0) PG8_BAR; }
        E(acc, cur, wr, wc, fr, fq); S.done(cur);
        if (!has_next) break;
#pragma unroll
        for (int a = 0; a < 2; ++a)
#pragma unroll
            for (int b = 0; b < 2; ++b)
#pragma unroll
                for (int m = 0; m < 4; ++m)
#pragma unroll
                    for (int n = 0; n < 2; ++n) acc[a][b][m][n] = (f32x4){0.f, 0.f, 0.f, 0.f};
        cur = nxt; cA = nA; cB = nB; ++ui;
        if constexpr (ALIGN_EPI) { if (wr == 1) PG8_BAR; }
    }
    PG8_WAIT_V(0);
    if constexpr (!ALIGN_EPI) { if (wr == 0) PG8_BAR; }
    PG8_BAR;
#undef PG8_SA
#undef PG8_SB
#undef PG8_STAGE
#undef PG8_LDA
#undef PG8_LDB
#undef PG8_MMA
#undef PG8_WAIT_V
#undef PG8_WAIT_L
#undef PG8_BAR
#undef PG8_SCHED
}
}

constexpr int BATCH = 2, T = 8192, M = BATCH * T, D = 2048, FF = 5632, DIN = 17408, DEPTH = 4;
constexpr int C_RQ = 0, C_RK = 1024, C_RV = 2048, C_RG = 4096, C_SU = 6144, C_SV = 7168, C_AQ = 8192, C_AK = 9216, C_AV = 10240, C_GL = 11264;
constexpr int KCAT = 4096;
constexpr float EPS = 1e-6f, LOG2E = 1.4426950408889634f;
constexpr int NWAVES = 8;

constexpr size_t MiB = 1u << 20;
constexpr size_t WS_CTL = 0, CTL_ZERO_BYTES = 2 * MiB;
constexpr size_t WS_SVSTAT = 1 * MiB;
constexpr size_t WS_BIAS = 2 * MiB;
constexpr size_t WS_WC = 3 * MiB;
constexpr size_t WS_LSE = 4 * MiB;
constexpr size_t WS_ROPEC = 8 * MiB, WS_ROPES = 12 * MiB;
constexpr size_t WS_W = 16 * MiB;
constexpr size_t WO_GU1 = 0, WO_D1 = 44 * MiB, WO_IN = 66 * MiB, WO_CAT = 134 * MiB, WO_OUT = 150 * MiB, WO_GU2 = 158 * MiB, WO_D2 = 202 * MiB, W_BYTES = 224 * MiB;
constexpr size_t WS_X = 240 * MiB;
constexpr size_t WS_XB = 368 * MiB;
constexpr size_t WS_Z = 432 * MiB;
constexpr size_t WS_RT = 976 * MiB;
constexpr size_t WS_ACAT = 1104 * MiB;
constexpr size_t WS_OPART = 1232 * MiB;
constexpr size_t WS_MERGED = 1328 * MiB;
constexpr size_t WS_END = 1392 * MiB;
constexpr size_t WS_PART = 6 * MiB;
static_assert((size_t)11264 * 2048 * 2 == 44 * MiB && (size_t)2048 * 5632 * 2 == 22 * MiB && (size_t)17408 * 2048 * 2 == 68 * MiB && (size_t)2048 * 4096 * 2 == 16 * MiB, "weight map");
static_assert((size_t)M * DIN * 2 == 544 * MiB && (size_t)M * D * 4 == 128 * MiB, "activation map");
constexpr int CW_TMO = 0, CW_BAR = 4096;

constexpr int RING_OFF = 0, RING_BYTES = 155648;
constexpr int RSTD_OFF = 131072;
constexpr int LDSCTL_OFF = RING_BYTES, MISC_OFF = LDSCTL_OFF + 320;
constexpr int LDS_BYTES = 157696;

#define GAS __attribute__((address_space(1)))
#define LAS __attribute__((address_space(3)))
typedef unsigned short bf16;
typedef unsigned v4u __attribute__((ext_vector_type(4)));
typedef unsigned v2u __attribute__((ext_vector_type(2)));
typedef float f32x4 __attribute__((ext_vector_type(4)));
typedef short bf16x8 __attribute__((ext_vector_type(8)));
typedef short s16x4 __attribute__((ext_vector_type(4)));
typedef GAS unsigned gu32;
#define RLX_AGENT __ATOMIC_RELAXED, __HIP_MEMORY_SCOPE_AGENT
#define LDS_WAIT() asm volatile("s_waitcnt lgkmcnt(0)" ::: "memory")
#define VM_WAIT() asm volatile("s_waitcnt vmcnt(0)" ::: "memory")
__device__ __forceinline__ unsigned f2bf(float f) { unsigned u = __builtin_bit_cast(unsigned, f); return (u + 0x7fffu + ((u >> 16) & 1u)) >> 16; }
__device__ __forceinline__ unsigned pk2(float lo, float hi) { return f2bf(lo) | (f2bf(hi) << 16); }
using pg8::cvt_pk_bf16; using pg8::bf_lo; using pg8::bf_hi;

#define XB_TMO      128
#define XB_XCNT(j)  (256  + 64 * (j))
#define XB_XSUB(j)  (1280 + 64 * (j))
#define XB_XGEN(j)  (2304 + 64 * (j))
#define XB_TOP      3328
#define XB_TOPGEN   3392
#define XCD_BAR_WORDS 3456
#define XB_SPIN_CAP (1u << 20)

__device__ __forceinline__ unsigned xb_ld(unsigned* p)              { return __hip_atomic_load(p, __ATOMIC_RELAXED, __HIP_MEMORY_SCOPE_AGENT); }
__device__ __forceinline__ unsigned xb_add(unsigned* p, unsigned v) { return __hip_atomic_fetch_add(p, v, __ATOMIC_RELAXED, __HIP_MEMORY_SCOPE_AGENT); }
__device__ __forceinline__ unsigned xb_xcc_id() { return (unsigned)__builtin_amdgcn_s_getreg((3 << 11) | 20) & 0xFu; }
#define XB_SPIN(cond, bar) do { unsigned _sp = 0; while (cond) { __builtin_amdgcn_s_sleep(1); \
    if ((++_sp & 255u) == 0u) { if (xb_ld(&(bar)[XB_TMO])) break; if (_sp > XB_SPIN_CAP) { atomicAdd(&(bar)[XB_TMO], 1u); break; } } } } while (0)

struct XcdBarrier { unsigned* bar; unsigned x; volatile LAS unsigned* st; };

__device__ __forceinline__ XcdBarrier xcd_barrier_post(unsigned* bar, volatile LAS unsigned* st) {
    XcdBarrier b; b.bar = bar; b.x = xb_xcc_id(); b.st = st;
    if (threadIdx.x == 0) (void)xb_add(&bar[XB_XCNT(b.x)], 1u);
    return b;
}
__device__ __forceinline__ void xcd_barrier_complete(unsigned* bar, unsigned x, unsigned& nloc, unsigned& nx) {
    const unsigned G = gridDim.x * gridDim.y * gridDim.z;
    unsigned sum, cnt, mine, sp = 0u;
    for (;;) {
        sum = 0u; cnt = 0u; mine = 0u;
#pragma unroll
        for (unsigned j = 0; j < 16; ++j) { const unsigned c = xb_ld(&bar[XB_XCNT(j)]); sum += c; cnt += (c > 0u) ? 1u : 0u; mine = (j == x) ? c : mine; }
        if (sum == G) break;
        __builtin_amdgcn_s_sleep(1);
        if ((++sp & 255u) == 0u) { if (xb_ld(&bar[XB_TMO])) break; if (sp > XB_SPIN_CAP) { atomicAdd(&bar[XB_TMO], 1u); break; } }
    }
    nloc = mine > 0u ? mine : 1u; nx = cnt > 0u ? cnt : 1u;
}
__device__ __forceinline__ void xcd_barrier(const XcdBarrier& b, int wave) {
    asm volatile("s_waitcnt vmcnt(0)" ::: "memory");
    __syncthreads();
    int lane0_; asm volatile("v_mbcnt_lo_u32_b32 %0, -1, 0\n\tv_mbcnt_hi_u32_b32 %0, -1, %0" : "=v"(lane0_));
    if (wave == 0 && lane0_ == 0) {
        unsigned* bar = b.bar;
        __builtin_amdgcn_s_waitcnt(0);
        unsigned nloc = b.st[0], nx = b.st[1];
        if (nloc == 0u) { xcd_barrier_complete(bar, b.x, nloc, nx); b.st[0] = nloc; b.st[1] = nx; }
        const unsigned old = xb_add(&bar[XB_XSUB(b.x)], 1u);
        const unsigned gen = old / nloc;
        if (old + 1u == (gen + 1u) * nloc) {
            __builtin_amdgcn_fence(__ATOMIC_RELEASE, "agent");
            asm volatile("s_waitcnt vmcnt(0)" ::: "memory");
            const unsigned og = xb_add(&bar[XB_TOP], 1u);
            const unsigned tg = og / nx;
            if (og + 1u == (tg + 1u) * nx) xb_add(&bar[XB_TOPGEN], 1u);
            else XB_SPIN(xb_ld(&bar[XB_TOPGEN]) == tg, bar);
            __builtin_amdgcn_fence(__ATOMIC_ACQUIRE, "agent");
            xb_add(&bar[XB_XGEN(b.x)], 1u);
            asm volatile("s_waitcnt vmcnt(0)" ::: "memory");
        } else {
            XB_SPIN(xb_ld(&bar[XB_XGEN(b.x)]) == gen, bar);
            __builtin_amdgcn_fence(__ATOMIC_ACQUIRE, "agent");
            asm volatile("s_waitcnt vmcnt(0)" ::: "memory");
        }
    }
    __syncthreads();
}

namespace pg8 {

struct EpiGU {
    static constexpr bool PERM = true, MID = false; static constexpr int MID_T0 = -1, MID_T1 = -1;
    bf16_t* O; const PG8_LAS float* rstd;
    __device__ __forceinline__ void operator()(const f32x4 (&acc)[2][2][4][2], const Unit& u, int wr, int wc, int fr_, int fq_) const {
        int fr = fr_, fq = fq_; asm volatile("" : "+v"(fr), "+v"(fq));
        const int row0 = u.pm * BM + wr * 64 + fr, col0 = u.pn * HALF + wc * 32 + 8 * fq;
#pragma unroll
        for (int ai = 0; ai < 2; ++ai)
#pragma unroll
            for (int m = 0; m < 4; ++m) { bf16_t* rowp = O + (size_t)(row0 + ai * HALF + m * 16) * FF + col0; const float r = rstd[ai * HALF + wr * 64 + m * 16 + fr];
                const f32x4 g0 = acc[ai][0][m][0] * r, g1 = acc[ai][0][m][1] * r, u0 = acc[ai][1][m][0] * r, u1 = acc[ai][1][m][1] * r;
                u32x4 w; w.x = cvt_pk_bf16(silu_f(g0[0]) * u0[0], silu_f(g0[1]) * u0[1]); w.y = cvt_pk_bf16(silu_f(g0[2]) * u0[2], silu_f(g0[3]) * u0[3]);
                w.z = cvt_pk_bf16(silu_f(g1[0]) * u1[0], silu_f(g1[1]) * u1[1]); w.w = cvt_pk_bf16(silu_f(g1[2]) * u1[2], silu_f(g1[3]) * u1[3]);
                *(u32x4*)rowp = w; }
    }
};
struct EpiRes {
    static constexpr bool PERM = true, MID = false; static constexpr int MID_T0 = -1, MID_T1 = -1;
    const bf16_t* Xin; bf16_t* Xout; float* part; float scale;
    __device__ __forceinline__ void operator()(const f32x4 (&acc)[2][2][4][2], const Unit& u, int wr, int wc, int fr_, int fq_) const {
        int fr = fr_, fq = fq_; asm volatile("" : "+v"(fr), "+v"(fq));
        const int row0 = u.pm * BM + wr * 64 + fr, col0 = u.pn * BM + wc * 32 + 8 * fq;
        u32x4 bs[2][4][2];
#pragma unroll
        for (int ai = 0; ai < 2; ++ai)
#pragma unroll
            for (int m = 0; m < 4; ++m) { const size_t off = (size_t)(row0 + ai * HALF + m * 16) * D + col0;
#pragma unroll
                for (int bj = 0; bj < 2; ++bj) bs[ai][m][bj] = *(const u32x4*)(Xin + off + bj * HALF); }
        asm volatile("" ::: "memory");
#pragma unroll
        for (int ai = 0; ai < 2; ++ai)
#pragma unroll
            for (int m = 0; m < 4; ++m) { const int row = row0 + ai * HALF + m * 16; const size_t off = (size_t)row * D + col0; float ss = 0.f;
#pragma unroll
                for (int bj = 0; bj < 2; ++bj) { const u32x4 x = bs[ai][m][bj]; const f32x4 a0 = acc[ai][bj][m][0] * scale, a1 = acc[ai][bj][m][1] * scale;
                    u32x4 w; w.x = cvt_pk_bf16(bf_lo(x.x) + a0[0], bf_hi(x.x) + a0[1]); w.y = cvt_pk_bf16(bf_lo(x.y) + a0[2], bf_hi(x.y) + a0[3]);
                    w.z = cvt_pk_bf16(bf_lo(x.z) + a1[0], bf_hi(x.z) + a1[1]); w.w = cvt_pk_bf16(bf_lo(x.w) + a1[2], bf_hi(x.w) + a1[3]);
                    *(u32x4*)(Xout + off + bj * HALF) = w;
                    { const float a0 = bf_lo(w.x), a1 = bf_hi(w.x), a2 = bf_lo(w.y), a3 = bf_hi(w.y), a4 = bf_lo(w.z), a5 = bf_hi(w.z), a6 = bf_lo(w.w), a7 = bf_hi(w.w);
                      ss += ((a0 * a0 + a1 * a1) + (a2 * a2 + a3 * a3)) + ((a4 * a4 + a5 * a5) + (a6 * a6 + a7 * a7)); } }
                ss += __shfl_xor(ss, 16); ss += __shfl_xor(ss, 32);
                if (fq == 0) part[(size_t)row * 32 + u.pn * 4 + wc] = ss; }
    }
};
struct EpiProj {
    static constexpr bool PERM = true, MID = true; static constexpr int MID_T0 = 32, MID_T1 = 48;
    const bf16_t* Z; bf16_t* O;
    __device__ __forceinline__ void mid(f32x4 (&acc)[2][2][4][2], const Unit& u, int t, int wr, int wc, int fr_, int fq_) const {
        int fr = fr_, fq = fq_; asm volatile("" : "+v"(fr), "+v"(fq));
        const int row0 = u.pm * BM + wr * 64 + fr, col0 = u.pn * BM + wc * 32 + 8 * fq; const int cn = (t == MID_T0) ? C_GL : C_GL + D;
#pragma unroll
        for (int ai = 0; ai < 2; ++ai) { u32x4 ga[4][2], gb[4][2];
#pragma unroll
            for (int m = 0; m < 4; ++m) { const bf16_t* zp = Z + (size_t)(row0 + ai * HALF + m * 16) * DIN + col0 + cn;
#pragma unroll
                for (int bj = 0; bj < 2; ++bj) { ga[m][bj] = *(const u32x4*)(zp + bj * HALF); gb[m][bj] = *(const u32x4*)(zp + D + bj * HALF); } }
            asm volatile("" ::: "memory");
#pragma unroll
            for (int m = 0; m < 4; ++m)
#pragma unroll
                for (int bj = 0; bj < 2; ++bj) { const u32x4 a = ga[m][bj], b = gb[m][bj]; f32x4& v0 = acc[ai][bj][m][0]; f32x4& v1 = acc[ai][bj][m][1];
                    v0[0] *= bf_lo(a.x) * __builtin_amdgcn_rcpf(bf_lo(b.x)); v0[1] *= bf_hi(a.x) * __builtin_amdgcn_rcpf(bf_hi(b.x)); v0[2] *= bf_lo(a.y) * __builtin_amdgcn_rcpf(bf_lo(b.y)); v0[3] *= bf_hi(a.y) * __builtin_amdgcn_rcpf(bf_hi(b.y));
                    v1[0] *= bf_lo(a.z) * __builtin_amdgcn_rcpf(bf_lo(b.z)); v1[1] *= bf_hi(a.z) * __builtin_amdgcn_rcpf(bf_hi(b.z)); v1[2] *= bf_lo(a.w) * __builtin_amdgcn_rcpf(bf_lo(b.w)); v1[3] *= bf_hi(a.w) * __builtin_amdgcn_rcpf(bf_hi(b.w)); }
            asm volatile("" ::: "memory"); }
    }
    __device__ __forceinline__ void operator()(const f32x4 (&acc)[2][2][4][2], const Unit& u, int wr, int wc, int fr_, int fq_) const {
        int fr = fr_, fq = fq_; asm volatile("" : "+v"(fr), "+v"(fq));
        const int row0 = u.pm * BM + wr * 64 + fr, col0 = u.pn * BM + wc * 32 + 8 * fq;
#pragma unroll
        for (int ai = 0; ai < 2; ++ai)
#pragma unroll
            for (int m = 0; m < 4; ++m) { const int row = row0 + ai * HALF + m * 16; const bf16_t* zp = Z + (size_t)row * DIN + C_GL + 2 * D + col0; bf16_t* op = O + (size_t)row * D + col0;
#pragma unroll
                for (int bj = 0; bj < 2; ++bj) { const u32x4 a = *(const u32x4*)(zp + bj * HALF); const f32x4 v0 = acc[ai][bj][m][0], v1 = acc[ai][bj][m][1];
                    u32x4 w; w.x = cvt_pk_bf16(v0[0] * bf_lo(a.x), v0[1] * bf_hi(a.x)); w.y = cvt_pk_bf16(v0[2] * bf_lo(a.y), v0[3] * bf_hi(a.y));
                    w.z = cvt_pk_bf16(v1[0] * bf_lo(a.z), v1[1] * bf_hi(a.z)); w.w = cvt_pk_bf16(v1[2] * bf_lo(a.w), v1[3] * bf_hi(a.w));
                    *(u32x4*)(op + bj * HALF) = w; } }
    }
};
struct EpiWin {
    static constexpr bool PERM = true, MID = false; static constexpr int MID_T0 = -1, MID_T1 = -1;
    bf16_t* Z; const float* bgate; const float* ropeC; const float* ropeS; const PG8_LAS float* rstd;
    __device__ __forceinline__ void operator()(const f32x4 (&acc)[2][2][4][2], const Unit& u, int wr, int wc, int fr_, int fq_) const {
        int fr = fr_, fq = fq_; asm volatile("" : "+v"(fr), "+v"(fq));
        const int pn = u.pn, row0 = u.pm * BM + wr * 64 + fr, cl = wc * 32 + 8 * fq;
        if (pn < 8) {
            const int h = pn & 3; const bool isk = pn >= 4;
            const float l2g = __builtin_log2f(1.0f - __builtin_amdgcn_exp2f(-5.0f - (float)h));
#pragma unroll
            for (int ai = 0; ai < 2; ++ai)
#pragma unroll
                for (int m = 0; m < 4; ++m) { const int row = row0 + ai * HALF + m * 16, pos = row & (T - 1), ci = row & 127;
                    const float sc = (isk ? __builtin_amdgcn_exp2f(-(float)ci * l2g) * 0.0625f : __builtin_amdgcn_exp2f((float)ci * l2g)) * rstd[ai * HALF + wr * 64 + m * 16 + fr];
                    const float* cp = ropeC + (size_t)pos * 128 + cl; const float* sp = ropeS + (size_t)pos * 128 + cl;
                    const f32x4 c0 = *(const f32x4*)cp, c1 = *(const f32x4*)(cp + 4), s0 = *(const f32x4*)sp, s1 = *(const f32x4*)(sp + 4);
                    const f32x4 t1a = acc[ai][0][m][0], t1b = acc[ai][0][m][1], t2a = acc[ai][1][m][0], t2b = acc[ai][1][m][1];
                    const f32x4 o1a = (t1a * c0 - t2a * s0) * sc, o1b = (t1b * c1 - t2b * s1) * sc, o2a = (t1a * s0 + t2a * c0) * sc, o2b = (t1b * s1 + t2b * c1) * sc;
                    bf16_t* zp = Z + (size_t)row * DIN + pn * BM + cl;
                    u32x4 w; w.x = cvt_pk_bf16(o1a[0], o1a[1]); w.y = cvt_pk_bf16(o1a[2], o1a[3]); w.z = cvt_pk_bf16(o1b[0], o1b[1]); w.w = cvt_pk_bf16(o1b[2], o1b[3]); *(u32x4*)zp = w;
                    w.x = cvt_pk_bf16(o2a[0], o2a[1]); w.y = cvt_pk_bf16(o2a[2], o2a[3]); w.z = cvt_pk_bf16(o2b[0], o2b[1]); w.w = cvt_pk_bf16(o2b[2], o2b[3]); *(u32x4*)(zp + HALF) = w; }
            return;
        }
        const int mode = pn < 16 ? 0 : pn < 24 ? 1 : pn < 28 ? 2 : pn < 32 ? 3 : pn < 36 ? 4 : pn < 44 ? 0 : 5;
        const float qs = 0.08838834764831845f * LOG2E;
#pragma unroll
        for (int ai = 0; ai < 2; ++ai)
#pragma unroll
            for (int m = 0; m < 4; ++m) { const int row = row0 + ai * HALF + m * 16; bf16_t* zp = Z + (size_t)row * DIN + pn * BM + cl; const float rs = rstd[ai * HALF + wr * 64 + m * 16 + fr];
#pragma unroll
                for (int bj = 0; bj < 2; ++bj) { f32x4 v0 = acc[ai][bj][m][0] * rs, v1 = acc[ai][bj][m][1] * rs;
                    if (mode == 1) {
#pragma unroll
                        for (int j = 0; j < 4; ++j) { v0[j] = silu_f(v0[j]); v1[j] = silu_f(v1[j]); } }
                    else if (mode == 2 || mode == 3) {
#pragma unroll
                        for (int j = 0; j < 4; ++j) { v0[j] = gelu_tanh_f(v0[j]); v1[j] = gelu_tanh_f(v1[j]); } }
                    else if (mode == 4) { v0 = v0 * qs; v1 = v1 * qs; }
                    else if (mode == 5) { const float* bp = bgate + (pn * BM - C_GL) + bj * HALF + cl; const f32x4 b0 = *(const f32x4*)bp, b1 = *(const f32x4*)(bp + 4);
#pragma unroll
                        for (int j = 0; j < 4; ++j) { v0[j] = fast_sigmoid(v0[j] + b0[j]); v1[j] = fast_sigmoid(v1[j] + b1[j]); } }
                    u32x4 w; w.x = cvt_pk_bf16(v0[0], v0[1]); w.y = cvt_pk_bf16(v0[2], v0[3]); w.z = cvt_pk_bf16(v1[0], v1[1]); w.w = cvt_pk_bf16(v1[2], v1[3]);
                    *(u32x4*)(zp + bj * HALF) = w;
                     }
 }
    }
};
}

__device__ __forceinline__ float wave_sum(float v) {
#pragma unroll
    for (int o = 1; o < 64; o <<= 1) v += __shfl_xor(v, o);
    return v;
}
__device__ __forceinline__ void transpose_item(const float* W, int N, bf16* WT, int ldk, int koff, int drow0, LAS float* scr, int k0, int n0, int lane, const float* gain) {
#pragma unroll 8
    for (int i = 0; i < 32; ++i) { const int kk = 2 * i + (lane >> 5); scr[kk * 33 + (lane & 31)] = W[(size_t)(k0 + kk) * N + n0 + (lane & 31)]; }
    const int c = lane & 7;
    f32x4 g0 = (f32x4){1.f, 1.f, 1.f, 1.f}, g1 = g0;
    if (gain) { g0 = *(const f32x4*)(gain + k0 + 8 * c); g1 = *(const f32x4*)(gain + k0 + 8 * c + 4); }
    LDS_WAIT(); asm volatile("" ::: "memory");
#pragma unroll
    for (int j = 0; j < 4; ++j) { const int n = (lane >> 3) + 8 * j; const LAS float* s = scr + (8 * c) * 33 + n;
        v4u o; o.x = pk2(s[0 * 33] * g0[0], s[1 * 33] * g0[1]); o.y = pk2(s[2 * 33] * g0[2], s[3 * 33] * g0[3]); o.z = pk2(s[4 * 33] * g1[0], s[5 * 33] * g1[1]); o.w = pk2(s[6 * 33] * g1[2], s[7 * 33] * g1[3]);
        *(v4u*)(WT + (size_t)(drow0 + n) * ldk + koff + k0 + 8 * c) = o; }
    LDS_WAIT(); asm volatile("" ::: "memory");
}
struct ConvMat { const float* W; bf16* WT; int K, N, ldk, koff, gu; const float* gain; };
__device__ __forceinline__ void conv_matrix(const ConvMat& c, LAS float* scr, int gw, int NGW, int lane) {
    const int nn = c.N / 32, items = (c.K / 64) * nn;
    for (int it = gw; it < items; it += NGW) { const int kb = it / nn, nb = it - kb * nn, n0 = 32 * nb;
        const int drow0 = c.gu ? ((n0 >> 7) * 256 + (n0 & 127) + (c.gu - 1) * 128) : n0;
        transpose_item(c.W, c.N, c.WT, c.ldk, c.koff, drow0, scr, 64 * kb, n0, lane, c.gain); }
}
template <bool F32OUT>
__device__ __forceinline__ void rms_row(const bf16* xrow, const float* gain, void* orow, int lane) {
    const v4u* xr = (const v4u*)xrow + lane;
    v4u v[4]; float s = 0.f;
#pragma unroll
    for (int j = 0; j < 4; ++j) { v[j] = xr[64 * j];
        const float a0 = bf_lo(v[j].x), a1 = bf_hi(v[j].x), a2 = bf_lo(v[j].y), a3 = bf_hi(v[j].y), a4 = bf_lo(v[j].z), a5 = bf_hi(v[j].z), a6 = bf_lo(v[j].w), a7 = bf_hi(v[j].w);
        s += ((a0 * a0 + a1 * a1) + (a2 * a2 + a3 * a3)) + ((a4 * a4 + a5 * a5) + (a6 * a6 + a7 * a7)); }
    const float rstd = 1.0f / sqrtf(wave_sum(s) * (1.0f / D) + EPS);
#pragma unroll
    for (int j = 0; j < 4; ++j) { const float* gp = gain + (64 * j + lane) * 8; const f32x4 g0 = *(const f32x4*)gp, g1 = *(const f32x4*)(gp + 4);
        const f32x4 o0 = (f32x4){bf_lo(v[j].x), bf_hi(v[j].x), bf_lo(v[j].y), bf_hi(v[j].y)} * rstd * g0, o1 = (f32x4){bf_lo(v[j].z), bf_hi(v[j].z), bf_lo(v[j].w), bf_hi(v[j].w)} * rstd * g1;
        if (F32OUT) { float* op = (float*)orow + (64 * j + lane) * 8; *(f32x4*)op = o0; *(f32x4*)(op + 4) = o1; }
        else { v4u w; w.x = cvt_pk_bf16(o0[0], o0[1]); w.y = cvt_pk_bf16(o0[2], o0[3]); w.z = cvt_pk_bf16(o1[0], o1[1]); w.w = cvt_pk_bf16(o1[2], o1[3]); ((v4u*)orow + lane)[64 * j] = w; } }
}
__device__ __forceinline__ void x_row_prep(const float* xrow, bf16* orow, float* prow, int lane) {
    const f32x4* xr = (const f32x4*)xrow + lane; float s = 0.f;
#pragma unroll
    for (int j = 0; j < 8; ++j) { const f32x4 v = xr[64 * j]; v2u w; w.x = cvt_pk_bf16(v.x, v.y); w.y = cvt_pk_bf16(v.z, v.w); ((v2u*)orow + lane)[64 * j] = w;
        const float a0 = bf_lo(w.x), a1 = bf_hi(w.x), a2 = bf_lo(w.y), a3 = bf_hi(w.y); s += (a0 * a0 + a1 * a1) + (a2 * a2 + a3 * a3); }
    s = wave_sum(s);
    if (lane < 32) prow[lane] = lane == 0 ? s : 0.f;
}
__device__ __forceinline__ void panel_rstd(LAS float* tab, const float* part, int pm, int tid) {
    const int row = tid >> 1, hf = tid & 1; const float* p = part + (size_t)(pm * 256 + row) * 32 + hf * 16;
    const f32x4 a = *(const f32x4*)p, b = *(const f32x4*)(p + 4), c = *(const f32x4*)(p + 8), d = *(const f32x4*)(p + 12);
    float s = (((a[0] + a[1]) + (a[2] + a[3])) + ((b[0] + b[1]) + (b[2] + b[3]))) + (((c[0] + c[1]) + (c[2] + c[3])) + ((d[0] + d[1]) + (d[2] + d[3])));
    s += __shfl_xor(s, 1);
    if (hf == 0) tab[row] = 1.0f / sqrtf(s * (1.0f / 2048.0f) + EPS);
}

#define MFMA16(a, b, c) __builtin_amdgcn_mfma_f32_16x16x32_bf16(a, b, c, 0, 0, 0)
__device__ __forceinline__ bf16x8 ldg16(const bf16* p) { return *(const bf16x8*)p; }
__device__ __forceinline__ s16x4 lds_tr(LAS unsigned char* p) { return __builtin_amdgcn_ds_read_tr16_b64_v4i16((LAS s16x4*)p); }
__device__ __forceinline__ bf16x8 cat8(s16x4 a, s16x4 b) { return (bf16x8){a[0], a[1], a[2], a[3], b[0], b[1], b[2], b[3]}; }
__device__ __forceinline__ bf16x8 pack8(f32x4 a, f32x4 b) { v4u w; w.x = cvt_pk_bf16(a[0], a[1]); w.y = cvt_pk_bf16(a[2], a[3]); w.z = cvt_pk_bf16(b[0], b[1]); w.w = cvt_pk_bf16(b[2], b[3]); return __builtin_bit_cast(bf16x8, w); }
__device__ __forceinline__ float head_gamma(int h) { return 1.0f - __builtin_amdgcn_exp2f(-5.0f - (float)h); }

constexpr int SG_VSTRIDE = 544;
__device__ __forceinline__ void sgu_unit(LAS unsigned char* lds, const bf16* Z, bf16* ACAT, const bf16* WC, const float* lng, const float* lnb, const float* sgb, int uid, int w, int lane_in) {
    int lane = lane_in; asm volatile("" : "+v"(lane)); const int tid = w * 64 + lane;
    const int b = uid >> 8, n = (uid >> 2) & 63, gq = uid & 3, row0 = b * T + n * 128;
    const int fr = lane & 15, g = lane >> 4;
    LAS unsigned char* VN = lds; LAS float* ST = (LAS float*)(lds + 128 * SG_VSTRIDE);
    { float s1[16], s2[16];
#pragma unroll
      for (int r = 0; r < 16; ++r) { const v4u* p = (const v4u*)(Z + (size_t)(row0 + 16 * w + r) * DIN + C_SV) + lane;
        const v4u a = p[0], b = p[64];
        const float a0 = bf_lo(a.x), a1 = bf_hi(a.x), a2 = bf_lo(a.y), a3 = bf_hi(a.y), a4 = bf_lo(a.z), a5 = bf_hi(a.z), a6 = bf_lo(a.w), a7 = bf_hi(a.w);
        const float b0 = bf_lo(b.x), b1 = bf_hi(b.x), b2 = bf_lo(b.y), b3 = bf_hi(b.y), b4 = bf_lo(b.z), b5 = bf_hi(b.z), b6 = bf_lo(b.w), b7 = bf_hi(b.w);
        s1[r] = (((a0 + a1) + (a2 + a3)) + ((a4 + a5) + (a6 + a7))) + (((b0 + b1) + (b2 + b3)) + ((b4 + b5) + (b6 + b7)));
        s2[r] = (((a0 * a0 + a1 * a1) + (a2 * a2 + a3 * a3)) + ((a4 * a4 + a5 * a5) + (a6 * a6 + a7 * a7))) + (((b0 * b0 + b1 * b1) + (b2 * b2 + b3 * b3)) + ((b4 * b4 + b5 * b5) + (b6 * b6 + b7 * b7))); }
#define SG_HALVE(n_, bit_) do { const bool hi_ = (lane >> (bit_)) & 1; _Pragma("unroll") for (int i = 0; i < (n_); ++i) {         const float k1 = hi_ ? s1[(n_) + i] : s1[i], o1 = hi_ ? s1[i] : s1[(n_) + i], k2 = hi_ ? s2[(n_) + i] : s2[i], o2 = hi_ ? s2[i] : s2[(n_) + i];         s1[i] = k1 + __shfl_xor(o1, 1 << (bit_)); s2[i] = k2 + __shfl_xor(o2, 1 << (bit_)); } } while (0)
      SG_HALVE(8, 5); SG_HALVE(4, 4); SG_HALVE(2, 3); SG_HALVE(1, 2);
#undef SG_HALVE
      float t1 = s1[0], t2 = s2[0];
      t1 += __shfl_xor(t1, 2); t2 += __shfl_xor(t2, 2); t1 += __shfl_xor(t1, 1); t2 += __shfl_xor(t2, 1);
      if ((lane & 3) == 0) { const int r = ((lane >> 5) & 1) * 8 + ((lane >> 4) & 1) * 4 + ((lane >> 3) & 1) * 2 + ((lane >> 2) & 1), row = 16 * w + r;
          const float mean = t1 * (1.0f / 1024.0f), var = fmaxf(t2 * (1.0f / 1024.0f) - mean * mean, 0.f); ST[row * 2] = mean; ST[row * 2 + 1] = 1.0f / sqrtf(var + EPS); } }
    LDS_WAIT(); __syncthreads();
#pragma unroll
    for (int it = 0; it < 8; ++it) { const int p = tid + 512 * it, row = p >> 5, c8 = (p & 31) * 8;
        const v4u x = *(const v4u*)(Z + (size_t)(row0 + row) * DIN + C_SV + gq * 256 + c8);
        const float mean = ST[row * 2], rstd = ST[row * 2 + 1];
        const f32x4 g0 = *(const f32x4*)(lng + gq * 256 + c8), g1 = *(const f32x4*)(lng + gq * 256 + c8 + 4), b0 = *(const f32x4*)(lnb + gq * 256 + c8), b1 = *(const f32x4*)(lnb + gq * 256 + c8 + 4);
        v4u o;
        o.x = cvt_pk_bf16((bf_lo(x.x) - mean) * rstd * g0[0] + b0[0], (bf_hi(x.x) - mean) * rstd * g0[1] + b0[1]);
        o.y = cvt_pk_bf16((bf_lo(x.y) - mean) * rstd * g0[2] + b0[2], (bf_hi(x.y) - mean) * rstd * g0[3] + b0[3]);
        o.z = cvt_pk_bf16((bf_lo(x.z) - mean) * rstd * g1[0] + b1[0], (bf_hi(x.z) - mean) * rstd * g1[1] + b1[1]);
        o.w = cvt_pk_bf16((bf_lo(x.w) - mean) * rstd * g1[2] + b1[2], (bf_hi(x.w) - mean) * rstd * g1[3] + b1[3]);
        *(LAS v4u*)(VN + row * SG_VSTRIDE + c8 * 2) = o; }
    bf16x8 wf[4];
#pragma unroll
    for (int ks = 0; ks < 4; ++ks) wf[ks] = ldg16(WC + (size_t)(gq * 128 + 16 * w + fr) * 128 + ks * 32 + 8 * g);
    LDS_WAIT(); __syncthreads();
    const int row = row0 + 16 * w + fr; const float bias = sgb[gq * 128 + 16 * w + fr];
    const bf16* sup = Z + (size_t)row * DIN + C_SU + gq * 256 + 4 * g; bf16* op = ACAT + (size_t)row * KCAT + 2048 + gq * 256 + 4 * g;
    LAS unsigned char* vb = VN + (8 * g + (fr >> 2)) * SG_VSTRIDE + (fr & 3) * 8;
#pragma unroll
    for (int ct = 0; ct < 16; ++ct) { f32x4 a = (f32x4){0.f, 0.f, 0.f, 0.f};
#pragma unroll
        for (int ks = 0; ks < 4; ++ks) { const bf16x8 af = cat8(lds_tr(vb + (32 * ks) * SG_VSTRIDE + ct * 32), lds_tr(vb + (32 * ks + 4) * SG_VSTRIDE + ct * 32)); a = MFMA16(af, wf[ks], a); }
        const v2u su = *(const v2u*)(sup + 16 * ct);
        v2u o; o.x = cvt_pk_bf16(bf_lo(su.x) * (a[0] + bias), bf_hi(su.x) * (a[1] + bias)); o.y = cvt_pk_bf16(bf_lo(su.y) * (a[2] + bias), bf_hi(su.y) * (a[3] + bias));
        *(v2u*)(op + 16 * ct) = o; }
    __syncthreads();
}


constexpr int CS_KSTRIDE = 544, CS_VSTRIDE = 288, CS_VOFF = 128 * CS_KSTRIDE;
constexpr int CS_UNITS = 2 * 4 * 63 * 4;
__device__ __forceinline__ void cs_phase(LAS unsigned char* lds, const bf16* Z, bf16* SB, int first, int stride, int w, int lane_in) {
    int lane = lane_in; asm volatile("" : "+v"(lane)); const int tid = w * 64 + lane;
    const int fr = lane & 15, g = lane >> 4;
    LAS unsigned char* KC = lds; LAS unsigned char* VC = lds + CS_VOFF;
    v4u kreg[8], vreg[4];
#define CS_DECODE(u_, eq_, n_, bh_) const int eq_ = (u_) & 3, n_ = ((u_) >> 2) % 63, bh_ = ((u_) >> 2) / 63
#define CS_LOAD(u_) do { CS_DECODE(u_, eq_, n_, bh_); const bf16* zr = Z + (size_t)((bh_ >> 2) * T + n_ * 128) * DIN; \
        _Pragma("unroll") for (int it = 0; it < 8; ++it) { const int p = tid + 512 * it; kreg[it] = *(const v4u*)(zr + (size_t)(p >> 5) * DIN + C_RK + (bh_ & 3) * 256 + (p & 31) * 8); } \
        _Pragma("unroll") for (int it = 0; it < 4; ++it) { const int p = tid + 512 * it; vreg[it] = *(const v4u*)(zr + (size_t)(p >> 4) * DIN + C_RV + (bh_ & 3) * 512 + eq_ * 128 + (p & 15) * 8); } } while (0)
    if (first < CS_UNITS) CS_LOAD(first);
    LAS unsigned char* ka = KC + (4 * g + (fr >> 2)) * CS_KSTRIDE + (32 * w) * 2 + (fr & 3) * 8;
    LAS unsigned char* va = VC + (4 * g + (fr >> 2)) * CS_VSTRIDE + (fr & 3) * 8;
    v2u pend[2][8]; bf16* pend_sp = SB; bool have_pend = false;
#define CS_FLUSH() do { _Pragma("unroll") for (int i = 0; i < 2; ++i) _Pragma("unroll") for (int j = 0; j < 8; ++j) *(v2u*)(pend_sp + j * 16 * 256 + i * 16) = pend[i][j]; } while (0)
    for (int u = first; u < CS_UNITS; u += stride) {
#pragma unroll
        for (int it = 0; it < 8; ++it) { const int p = tid + 512 * it; *(LAS v4u*)(KC + (p >> 5) * CS_KSTRIDE + (p & 31) * 16) = kreg[it]; }
#pragma unroll
        for (int it = 0; it < 4; ++it) { const int p = tid + 512 * it; *(LAS v4u*)(VC + (p >> 4) * CS_VSTRIDE + (p & 15) * 16) = vreg[it]; }
        LDS_WAIT(); __syncthreads();
        if (have_pend) CS_FLUSH();
        if (u + stride < CS_UNITS) CS_LOAD(u + stride);
        f32x4 S[2][8];
#pragma unroll
        for (int i = 0; i < 2; ++i)
#pragma unroll
            for (int j = 0; j < 8; ++j) S[i][j] = (f32x4){0.f, 0.f, 0.f, 0.f};
#pragma unroll
        for (int ks = 0; ks < 4; ++ks) { bf16x8 af[2], bfv[8];
#pragma unroll
            for (int i = 0; i < 2; ++i) af[i] = cat8(lds_tr(ka + (32 * ks) * CS_KSTRIDE + i * 32), lds_tr(ka + (32 * ks + 16) * CS_KSTRIDE + i * 32));
#pragma unroll
            for (int j = 0; j < 8; ++j) bfv[j] = cat8(lds_tr(va + (32 * ks) * CS_VSTRIDE + j * 32), lds_tr(va + (32 * ks + 16) * CS_VSTRIDE + j * 32));
#pragma unroll
            for (int i = 0; i < 2; ++i)
#pragma unroll
                for (int j = 0; j < 8; ++j) S[i][j] = MFMA16(af[i], bfv[j], S[i][j]); }
        { CS_DECODE(u, eq, n, bh);
          pend_sp = SB + ((size_t)((bh * 64 + n) * 512) + eq * 128 + fr) * 256 + 32 * w + 4 * g;
#pragma unroll
          for (int i = 0; i < 2; ++i)
#pragma unroll
              for (int j = 0; j < 8; ++j) { pend[i][j].x = cvt_pk_bf16(S[i][j][0], S[i][j][1]); pend[i][j].y = cvt_pk_bf16(S[i][j][2], S[i][j][3]); } }
        have_pend = true;
        __syncthreads();
    }
    if (have_pend) CS_FLUSH();
#undef CS_FLUSH
#undef CS_LOAD
#undef CS_DECODE
}

__device__ __forceinline__ void prefix_phase(bf16* SB, int gt, int NGT) {
    for (int idx = gt; idx < 8 * 512 * 32; idx += NGT) {
        const int bh = idx >> 14, h = bh & 3; const float l2g = __builtin_log2f(head_gamma(h)), g127 = __builtin_amdgcn_exp2f(127.f * l2g), g128 = __builtin_amdgcn_exp2f(128.f * l2g);
        bf16* p = SB + (size_t)bh * 64 * 512 * 256 + (size_t)(idx & 16383) * 8;
        float r[8];
#pragma unroll
        for (int k = 0; k < 8; ++k) r[k] = 0.f;
        for (int n0 = 0; n0 < 64; n0 += 8) { v4u s[8];
#pragma unroll
            for (int k = 0; k < 8; ++k) s[k] = (n0 + k < 63) ? *(const v4u*)(p + (size_t)(n0 + k) * 512 * 256) : (v4u){0u, 0u, 0u, 0u};
#pragma unroll
            for (int k = 0; k < 8; ++k) { v4u o; o.x = cvt_pk_bf16(r[0], r[1]); o.y = cvt_pk_bf16(r[2], r[3]); o.z = cvt_pk_bf16(r[4], r[5]); o.w = cvt_pk_bf16(r[6], r[7]);
                *(v4u*)(p + (size_t)(n0 + k) * 512 * 256) = o;
                r[0] = r[0] * g128 + bf_lo(s[k].x) * g127; r[1] = r[1] * g128 + bf_hi(s[k].x) * g127; r[2] = r[2] * g128 + bf_lo(s[k].y) * g127; r[3] = r[3] * g128 + bf_hi(s[k].y) * g127;
                r[4] = r[4] * g128 + bf_lo(s[k].z) * g127; r[5] = r[5] * g128 + bf_hi(s[k].z) * g127; r[6] = r[6] * g128 + bf_lo(s[k].w) * g127; r[7] = r[7] * g128 + bf_hi(s[k].w) * g127; } }
    }
}

constexpr int AT_STRIDE = 288, AT_SLOT = 128 * AT_STRIDE, AT_VOFF = 2 * AT_SLOT, AT_BOFF = 4 * AT_SLOT;
#define AT_LOADBLK(sbk_) do { _Pragma("unroll") for (int it = 0; it < 4; ++it) { const int p = tid + 512 * it; const bf16* zr = zb + (size_t)(((((sbk_) * 128) + (p >> 4)) << dsh) + rr) * DIN + (p & 15) * 8; \
        kreg[it] = *(const v4u*)(zr + C_AK); vreg[it] = *(const v4u*)(zr + C_AV); } } while (0)
#define AT_WRITEBLK(slot_) do { _Pragma("unroll") for (int it = 0; it < 4; ++it) { const int p = tid + 512 * it; const int o = (slot_) * AT_SLOT + (p >> 4) * AT_STRIDE + (p & 15) * 16; \
        *(LAS v4u*)(lds + o) = kreg[it]; *(LAS v4u*)(lds + AT_VOFF + o) = vreg[it]; } } while (0)
struct AtPend { v2u o[8]; float lse; int rowq; };
#define AT_FLUSH(P_) do { bf16* op_ = OP + ((size_t)cfg * M + (P_).rowq) * 1024 + h * 128 + 4 * g; _Pragma("unroll") for (int mt = 0; mt < 8; ++mt) *(v2u*)(op_ + 16 * mt) = (P_).o[mt]; \
        if (g == 0) LSE[((size_t)cfg * M + (P_).rowq) * 8 + h] = (P_).lse; } while (0)
template <int PAR>
__device__ __forceinline__ void attn_unit(LAS unsigned char* lds, const bf16* Z, const bf16* zb, bf16* OP, float* LSE, v4u (&kreg)[4], v4u (&vreg)[4], AtPend& pend, bool have_pend, int cfg, int b, int h, int dsh, int rr, int sb, bool has_next, int w, int tid, int fr, int g) {
    LAS float* BL = (LAS float*)(lds + AT_BOFF);
    if (have_pend) AT_FLUSH(pend);
    const int rowq = b * T + ((sb * 128 + 16 * w + fr) << dsh) + rr;
    bf16x8 qf[4];
#pragma unroll
    for (int ks = 0; ks < 4; ++ks) qf[ks] = ldg16(Z + (size_t)rowq * DIN + C_AQ + h * 128 + ks * 32 + 8 * g);
    if (has_next) AT_LOADBLK(sb + 1);
    int wv = 16 * w; asm volatile("" : "+v"(wv));
#define AT_ROWOFF(kt_) (((((wv + 16 * (kt_)) >> 7) ^ PAR ^ 1) & 1) * AT_SLOT + ((wv + 16 * (kt_)) & 127) * AT_STRIDE)
    f32x4 st[9];
#pragma unroll
    for (int kt = 0; kt < 9; ++kt) { LAS unsigned char* kp = lds + AT_ROWOFF(kt) + fr * AT_STRIDE + g * 16; f32x4 a = (f32x4){0.f, 0.f, 0.f, 0.f};
#pragma unroll
        for (int ks = 0; ks < 4; ++ks) a = MFMA16(*(LAS bf16x8*)(kp + ks * 64), qf[ks], a);
        st[kt] = a; }
    LAS float* blp = BL + (15 + 4 * g - fr);
#pragma unroll
    for (int kt = 0; kt < 9; ++kt)
#pragma unroll
        for (int r = 0; r < 4; ++r) st[kt][r] += blp[16 * kt + r];
    if (sb == 0) {
#pragma unroll
        for (int kt = 0; kt < 9; ++kt)
#pragma unroll
            for (int r = 0; r < 4; ++r) if (wv + 16 * kt + 4 * g + r < 128) st[kt][r] = -__builtin_inff(); }
    float mx = -__builtin_inff();
#pragma unroll
    for (int kt = 0; kt < 9; ++kt)
#pragma unroll
        for (int r = 0; r < 4; ++r) mx = fmaxf(mx, st[kt][r]);
    mx = fmaxf(mx, __shfl_xor(mx, 16)); mx = fmaxf(mx, __shfl_xor(mx, 32));
    float den = 0.f;
#pragma unroll
    for (int kt = 0; kt < 9; ++kt)
#pragma unroll
        for (int r = 0; r < 4; ++r) { const float p = __builtin_amdgcn_exp2f(st[kt][r] - mx); st[kt][r] = p; den += p; }
    den += __shfl_xor(den, 16); den += __shfl_xor(den, 32);
    bf16x8 pf[5];
#pragma unroll
    for (int kk = 0; kk < 4; ++kk) pf[kk] = pack8(st[2 * kk], st[2 * kk + 1]);
    pf[4] = pack8(st[8], (f32x4){0.f, 0.f, 0.f, 0.f});
    const float rden = 1.0f / den;
    LAS unsigned char* vb = lds + AT_VOFF + (4 * g + (fr >> 2)) * AT_STRIDE + (fr & 3) * 8;
#pragma unroll
    for (int mt = 0; mt < 8; ++mt) { f32x4 o = (f32x4){0.f, 0.f, 0.f, 0.f};
#pragma unroll
        for (int kk = 0; kk < 5; ++kk) { const int t0 = 2 * kk, t1 = (2 * kk + 1 > 8) ? 8 : 2 * kk + 1;
            const bf16x8 a = cat8(lds_tr(vb + AT_ROWOFF(t0) + mt * 32), lds_tr(vb + AT_ROWOFF(t1) + mt * 32));
            o = MFMA16(a, pf[kk], o); }
        pend.o[mt].x = cvt_pk_bf16(o[0] * rden, o[1] * rden); pend.o[mt].y = cvt_pk_bf16(o[2] * rden, o[3] * rden); }
    pend.lse = mx + __builtin_log2f(den); pend.rowq = rowq;
    __syncthreads();
    if (has_next) { AT_WRITEBLK(PAR ^ 1); LDS_WAIT(); __syncthreads(); }
#undef AT_ROWOFF
}
__device__ __forceinline__ void attn_run(LAS unsigned char* lds, const bf16* Z, bf16* OP, float* LSE, const float* BIAS, int item, int w, int lane_in) {
    int lane = lane_in; asm volatile("" : "+v"(lane)); const int tid = w * 64 + lane;
    const int cfg = item >> 8, b = (item >> 7) & 1, h = (item >> 4) & 7, run = item & 15;
    const int dsh = 2 * cfg, rr = run & ((1 << dsh) - 1), sb0 = 4 * (run >> dsh);
    const int fr = lane & 15, g = lane >> 4;
    LAS float* BL = (LAS float*)(lds + AT_BOFF);
    const bf16* zb = Z + (size_t)(b * T) * DIN + h * 128;
    v4u kreg[4], vreg[4]; AtPend pend;
    { const int pb = sb0 > 0 ? sb0 - 1 : 0; AT_LOADBLK(pb); AT_WRITEBLK(1); }
    AT_LOADBLK(sb0);
    if (tid < 160) { const int dl = tid - 15; BL[tid] = (dl >= 0 && dl <= 128) ? BIAS[(cfg * 8 + h) * 132 + 128 - dl] : -__builtin_inff(); }
    AT_WRITEBLK(0);
    LDS_WAIT(); __syncthreads();
#pragma unroll 1
    for (int up = 0; up < 2; ++up) {
        attn_unit<0>(lds, Z, zb, OP, LSE, kreg, vreg, pend, up != 0, cfg, b, h, dsh, rr, sb0 + 2 * up, true, w, tid, fr, g);
        attn_unit<1>(lds, Z, zb, OP, LSE, kreg, vreg, pend, true, cfg, b, h, dsh, rr, sb0 + 2 * up + 1, up == 0, w, tid, fr, g);
    }
    AT_FLUSH(pend);
}
#undef AT_LOADBLK
#undef AT_WRITEBLK
#undef AT_FLUSH

constexpr int RO_KSTRIDE = 544, RO_VSTRIDE = 160, RO_VOFF = 64 * RO_KSTRIDE, RO_BUF = RO_VOFF + 128 * RO_VSTRIDE;
__device__ __forceinline__ void retout_unit(LAS unsigned char* lds, const bf16* Z, const bf16* RT, bf16* ACAT, int uid, int w, int lane_in) {
    int lane = lane_in; asm volatile("" : "+v"(lane)); const int tid = w * 64 + lane;
    const int b = uid >> 8, h = (uid >> 6) & 3, n = uid & 63, row0 = b * T + n * 128;
    const int fr = lane & 15, g = lane >> 4, rowq = row0 + 16 * w + fr;
    const float gamma = head_gamma(h);
    const bf16* vsrc = Z + (size_t)row0 * DIN + C_RV + h * 512;
    const bf16* rsrc = RT + (size_t)(((b * 4 + h) * 64 + n) * 512) * 256;
    v4u rreg[4], vreg[2];
#define RO_LOAD(c_) do { _Pragma("unroll") for (int it = 0; it < 4; ++it) { const int p = tid + 512 * it; rreg[it] = *(const v4u*)(rsrc + (size_t)((c_) * 64 + (p >> 5)) * 256 + (p & 31) * 8); } \
        _Pragma("unroll") for (int it = 0; it < 2; ++it) { const int p = tid + 512 * it; vreg[it] = *(const v4u*)(vsrc + (size_t)(p >> 3) * DIN + (c_) * 64 + (p & 7) * 8); } } while (0)
#define RO_WRITE(buf_) do { _Pragma("unroll") for (int it = 0; it < 4; ++it) { const int p = tid + 512 * it; *(LAS v4u*)(lds + (buf_) * RO_BUF + (p >> 5) * RO_KSTRIDE + (p & 31) * 16) = rreg[it]; } \
        _Pragma("unroll") for (int it = 0; it < 2; ++it) { const int p = tid + 512 * it; *(LAS v4u*)(lds + (buf_) * RO_BUF + RO_VOFF + (p >> 3) * RO_VSTRIDE + (p & 7) * 16) = vreg[it]; } } while (0)
    { v4u kreg[8];
#pragma unroll
      for (int it = 0; it < 8; ++it) { const int p = tid + 512 * it; kreg[it] = *(const v4u*)(Z + (size_t)(row0 + (p >> 5)) * DIN + C_RK + h * 256 + (p & 31) * 8); }
#pragma unroll
      for (int it = 0; it < 8; ++it) { const int p = tid + 512 * it; *(LAS v4u*)(lds + (p >> 5) * RO_KSTRIDE + (p & 31) * 16) = kreg[it]; } }
    bf16x8 qf[8];
#pragma unroll
    for (int ks = 0; ks < 8; ++ks) qf[ks] = ldg16(Z + (size_t)rowq * DIN + C_RQ + h * 256 + ks * 32 + 8 * g);
    LDS_WAIT(); __syncthreads();
    RO_LOAD(0);
    f32x4 st[8];
#pragma unroll
    for (int jt = 0; jt < 8; ++jt) { st[jt] = (f32x4){0.f, 0.f, 0.f, 0.f};
        if (jt <= w) { LAS unsigned char* kp = lds + (16 * jt + fr) * RO_KSTRIDE + g * 16; f32x4 a = (f32x4){0.f, 0.f, 0.f, 0.f};
#pragma unroll
            for (int ks = 0; ks < 8; ++ks) a = MFMA16(*(LAS bf16x8*)(kp + ks * 64), qf[ks], a);
            if (jt == w) {
#pragma unroll
                for (int r = 0; r < 4; ++r) if (4 * g + r > fr) a[r] = 0.f; }
            st[jt] = a; } }
    bf16x8 pf[4];
#pragma unroll
    for (int kk = 0; kk < 4; ++kk) pf[kk] = pack8(st[2 * kk], st[2 * kk + 1]);
    __syncthreads();
    RO_WRITE(0); LDS_WAIT(); __syncthreads();
    f32x4 o[32];
    LAS unsigned char* ra = lds + fr * RO_KSTRIDE + g * 16;
    LAS unsigned char* va = lds + RO_VOFF + (4 * g + (fr >> 2)) * RO_VSTRIDE + (fr & 3) * 8;
#pragma unroll
    for (int c = 0; c < 8; ++c) {
        if (c < 7) RO_LOAD(c + 1);
#pragma unroll
        for (int e4 = 0; e4 < 4; ++e4) { f32x4 a = (f32x4){0.f, 0.f, 0.f, 0.f};
#pragma unroll
            for (int ks = 0; ks < 8; ++ks) a = MFMA16(*(LAS bf16x8*)(ra + (c & 1) * RO_BUF + e4 * 16 * RO_KSTRIDE + ks * 64), qf[ks], a);
            a = a * gamma;
#pragma unroll
            for (int kk = 0; kk < 4; ++kk) if (2 * kk <= w) {
                const bf16x8 af = cat8(lds_tr(va + (c & 1) * RO_BUF + (32 * kk) * RO_VSTRIDE + e4 * 32), lds_tr(va + (c & 1) * RO_BUF + (32 * kk + 16) * RO_VSTRIDE + e4 * 32));
                a = MFMA16(af, pf[kk], a); }
            o[4 * c + e4] = a; }
        if (c < 7) RO_WRITE((c + 1) & 1);
        LDS_WAIT(); __syncthreads();
    }
    float ss = 0.f;
#pragma unroll
    for (int et = 0; et < 32; ++et) ss += (o[et][0] * o[et][0] + o[et][1] * o[et][1]) + (o[et][2] * o[et][2] + o[et][3] * o[et][3]);
    ss += __shfl_xor(ss, 16); ss += __shfl_xor(ss, 32);
    const float rn = 1.0f / sqrtf(ss * (1.0f / 512.0f) + EPS);
    const bf16* rgp = Z + (size_t)rowq * DIN + C_RG + h * 512 + 4 * g; bf16* op = ACAT + (size_t)rowq * KCAT + h * 512 + 4 * g;
#pragma unroll
    for (int et = 0; et < 32; ++et) { const v2u rg = *(const v2u*)(rgp + 16 * et);
        v2u ov; ov.x = cvt_pk_bf16(bf_lo(rg.x) * o[et][0] * rn, bf_hi(rg.x) * o[et][1] * rn); ov.y = cvt_pk_bf16(bf_lo(rg.y) * o[et][2] * rn, bf_hi(rg.y) * o[et][3] * rn);
        *(v2u*)(op + 16 * et) = ov; }
#undef RO_LOAD
#undef RO_WRITE
}
#ifndef SUBDUP
#define SUBDUP 0
#endif
#ifndef SUB_MASK
#define SUB_MASK 7
#endif
#ifndef DUP_MASK
#define DUP_MASK 0u
#endif
#define DUPN(k_) (1 + (int)((DUP_MASK >> (k_)) & 1u))
#ifndef SITE_MASK
#define SITE_MASK 0xFFFFFFFFu
#endif

struct Params { const float* in[22]; float* out; unsigned char* ws; int ph_lo, ph_hi; };
typedef __attribute__((address_space(4))) const unsigned char* kargp_t;
typedef GAS unsigned char* g_u8p; typedef GAS float* g_f32p; typedef const GAS float* g_cf32p;
typedef __attribute__((address_space(4))) const g_u8p* kslot_u8; typedef __attribute__((address_space(4))) const g_f32p* kslot_f32; typedef __attribute__((address_space(4))) const g_cf32p* kslot_cf32;

__global__ void __launch_bounds__(NWAVES * 64, 2) fwd_kernel(Params P) {
    extern __shared__ __attribute__((aligned(16))) unsigned char lds_raw[];
    LAS unsigned char* lds = (LAS unsigned char*)lds_raw;
    const int wave = __builtin_amdgcn_readfirstlane((int)threadIdx.x >> 6);
    for (int u = threadIdx.x; u < (LDS_BYTES - LDSCTL_OFF) / 4; u += NWAVES * 64) ((LAS unsigned*)(lds + LDSCTL_OFF))[u] = 0u;
    __syncthreads();
#if MK_PER_PHASE
    XcdBarrier bar; bar.bar = nullptr; bar.x = 0; bar.st = nullptr;
#else
    XcdBarrier bar = xcd_barrier_post((unsigned*)(P.ws + WS_CTL) + CW_BAR, (volatile LAS unsigned*)(lds + MISC_OFF) + 8);
#endif
    const int lo = P.ph_lo, hi = P.ph_hi;
    int ph = 0, site = 0;
#define IN_PH(k_) (((SITE_MASK >> (k_)) & 1u) && lo <= ph && ph < hi)
#define PH_IDS() int lanep; asm volatile("v_mbcnt_lo_u32_b32 %0, -1, 0\n\tv_mbcnt_hi_u32_b32 %0, -1, %0" : "=v"(lanep)); const int tidp = wave * 64 + lanep; (void)tidp; \
    kargp_t ka_ = (kargp_t)__builtin_amdgcn_kernarg_segment_ptr(); asm volatile("" : "+s"(ka_)); \
    unsigned char* const ws = (unsigned char*)*(kslot_u8)(ka_ + 184); (void)ws; \
    int G = gridDim.x, wg = blockIdx.x; asm volatile("" : "+s"(G), "+s"(wg)); const int gw = wg * NWAVES + wave, NGW = G * NWAVES; (void)gw; (void)NGW
#define KIN(i) ((const float*)*(kslot_cf32)(ka_ + 8 * (i)))
#define KOUT() ((float*)*(kslot_f32)(ka_ + 176))
#if MK_PER_PHASE
#define END_PH() do { ++ph; } while (0)
#else
#define END_PH() do { ++ph; xcd_barrier(bar, wave); } while (0)
#endif
#define WSP(T_, off_) ((T_*)(ws + (off_)))
    (void)site;

    for (int l = 0; l < DEPTH; ++l) {
        if (IN_PH(0)) for (int rep_ = 0; rep_ < DUPN(0); ++rep_) { PH_IDS();
            LAS float* scr = (LAS float*)(lds + RING_OFF + wave * 16384);
            unsigned char* wb = ws + WS_W;
            const size_t oGU = (size_t)l * D * FF, oD = (size_t)l * FF * D;
            { ConvMat c{KIN(2) + oGU, (bf16*)(wb + WO_GU1), D, FF, D, 0, 1, KIN(1) + (size_t)l * D}; conv_matrix(c, scr, gw, NGW, lanep); }
            { ConvMat c{KIN(3) + oGU, (bf16*)(wb + WO_GU1), D, FF, D, 0, 2, KIN(1) + (size_t)l * D}; conv_matrix(c, scr, gw, NGW, lanep); }
            { ConvMat c{KIN(4) + oD, (bf16*)(wb + WO_D1), FF, D, FF, 0, 0, nullptr}; conv_matrix(c, scr, gw, NGW, lanep); }
            { ConvMat c{KIN(6) + (size_t)l * D * DIN, (bf16*)(wb + WO_IN), D, DIN, D, 0, 0, KIN(5) + (size_t)l * D}; conv_matrix(c, scr, gw, NGW, lanep); }
            { ConvMat c{KIN(13) + (size_t)l * 2048 * D, (bf16*)(wb + WO_CAT), 2048, D, KCAT, 0, 0, nullptr}; conv_matrix(c, scr, gw, NGW, lanep); }
            { ConvMat c{KIN(14) + (size_t)l * 1024 * D, (bf16*)(wb + WO_CAT), 1024, D, KCAT, 2048, 0, nullptr}; conv_matrix(c, scr, gw, NGW, lanep); }
            { ConvMat c{KIN(15) + (size_t)l * 1024 * D, (bf16*)(wb + WO_CAT), 1024, D, KCAT, 3072, 0, nullptr}; conv_matrix(c, scr, gw, NGW, lanep); }
            { ConvMat c{KIN(16) + (size_t)l * D * D, (bf16*)(wb + WO_OUT), D, D, D, 0, 0, nullptr}; conv_matrix(c, scr, gw, NGW, lanep); }
            { ConvMat c{KIN(18) + oGU, (bf16*)(wb + WO_GU2), D, FF, D, 0, 1, KIN(17) + (size_t)l * D}; conv_matrix(c, scr, gw, NGW, lanep); }
            { ConvMat c{KIN(19) + oGU, (bf16*)(wb + WO_GU2), D, FF, D, 0, 2, KIN(17) + (size_t)l * D}; conv_matrix(c, scr, gw, NGW, lanep); }
            { ConvMat c{KIN(20) + oD, (bf16*)(wb + WO_D2), FF, D, FF, 0, 0, nullptr}; conv_matrix(c, scr, gw, NGW, lanep); }
            const int gt = wg * (NWAVES * 64) + tidp, NGT = G * NWAVES * 64;
            { const float* sw = KIN(10) + (size_t)l * 4 * 128 * 128; bf16* WCb = WSP(bf16, WS_WC);
              for (int i = gt; i < 4 * 128 * 128; i += NGT) { const int s = i & 127, t = (i >> 7) & 127; WCb[i] = (bf16)(s <= t ? f2bf(sw[i]) : 0u); } }
            if (l == 0) {
                { const float* xin0 = KIN(0); bf16* XR = WSP(bf16, WS_X); float* PART = WSP(float, WS_PART); for (int m = gw; m < M; m += NGW) x_row_prep(xin0 + (size_t)m * D, XR + (size_t)m * D, PART + (size_t)m * 32, lanep); }
                float* ROPEC = WSP(float, WS_ROPEC); float* ROPES = WSP(float, WS_ROPES); float* BIAS = WSP(float, WS_BIAS); const float* relb = KIN(12);
                for (int i = gt; i < T * 128; i += NGT) { const int pos = i >> 7, fi = i & 127;
                    double inv = 1.0;
                    if (fi & 1) inv *= 0.930572040929699; if (fi & 2) inv *= 0.8659643233600654; if (fi & 4) inv *= 0.7498942093324559; if (fi & 8) inv *= 0.5623413251903491;
                    if (fi & 16) inv *= 0.31622776601683794; if (fi & 32) inv *= 0.1; if (fi & 64) inv *= 0.01;
                    const double ang = (double)pos * inv; const double k = __builtin_rint(ang * 0.15915494309189535);
                    double red = __builtin_fma(-k, 6.283185307179586, ang); red = __builtin_fma(-k, 2.4492935982947064e-16, red);
                    const float rf = (float)red; ROPEC[i] = cosf(rf); ROPES[i] = sinf(rf); }
                for (int i = gt; i < 3 * 8 * 132; i += NGT) { const int st = i % 132, hh = (i / 132) % 8, cfg = i / (132 * 8); float v = 0.f;
                    if (st <= 128) { const int dist = st << (2 * cfg); int bk;
                        if (dist < 16) bk = dist; else { bk = 16 + (int)(logf((float)dist / 16.0f) / 4.852030263919617f * 16.0f); bk = bk > 31 ? 31 : bk; }
                        v = relb[bk * 8 + hh] * LOG2E; }
                    BIAS[i] = v; }
            }
        }
        END_PH();
        for (int half = 0; half < 2; ++half) {
            if (IN_PH(2)) for (int rep_ = 0; rep_ < DUPN(2); ++rep_) { PH_IDS(); pg8::Gemm g{WSP(const bf16, WS_X), (const bf16*)(ws + WS_W + (half ? WO_GU2 : WO_GU1)), M, 2 * FF, D}; pg8::StaticOrder S; S.init(M, 2 * FF, G, wg);
                { pg8::Unit u0; if (S.next(0, u0)) panel_rstd((LAS float*)(lds + RSTD_OFF), WSP(const float, WS_PART), u0.pm, tidp); LDS_WAIT(); __syncthreads(); }
                pg8::EpiGU E{WSP(bf16, WS_Z), (const LAS float*)(lds + RSTD_OFF)}; pg8::gemm_phase<pg8::EpiGU, pg8::StaticOrder, true, true>(lds + RING_OFF, g, S, E, wave); }
            END_PH();
            if (IN_PH(3)) for (int rep_ = 0; rep_ < DUPN(3); ++rep_) { PH_IDS(); pg8::Gemm g{WSP(const bf16, WS_Z), (const bf16*)(ws + WS_W + (half ? WO_D2 : WO_D1)), M, D, FF}; pg8::StaticOrder S; S.init(M, D, G, wg, 4);
                pg8::EpiRes E{WSP(const bf16, WS_X), WSP(bf16, WS_X), WSP(float, WS_PART), 0.5f}; pg8::gemm_phase<pg8::EpiRes, pg8::StaticOrder, true, true>(lds + RING_OFF, g, S, E, wave); }
            END_PH();
            if (half == 0) {
                if (IN_PH(5)) for (int rep_ = 0; rep_ < DUPN(5); ++rep_) { PH_IDS(); pg8::Gemm g{WSP(const bf16, WS_X), (const bf16*)(ws + WS_W + WO_IN), M, DIN, D}; pg8::StaticOrder S; S.init(M, DIN, G, wg);
                    { pg8::Unit u0; if (S.next(0, u0)) panel_rstd((LAS float*)(lds + RSTD_OFF), WSP(const float, WS_PART), u0.pm, tidp); LDS_WAIT(); __syncthreads(); }
                    pg8::EpiWin E{WSP(bf16, WS_Z), KIN(7) + (size_t)l * 3 * D, WSP(const float, WS_ROPEC), WSP(const float, WS_ROPES), (const LAS float*)(lds + RSTD_OFF)};
                    pg8::gemm_phase<pg8::EpiWin, pg8::StaticOrder, true, true>(lds + RING_OFF, g, S, E, wave); }
                END_PH();
                if (IN_PH(6)) for (int rep_ = 0; rep_ < DUPN(6); ++rep_) { PH_IDS();
                    if (SUB_MASK & 1) for (int r2_ = 0; r2_ < 1 + (SUBDUP & 1); ++r2_) cs_phase(lds, WSP(const bf16, WS_Z), WSP(bf16, WS_RT), wg, G, wave, lanep);
                    if (SUB_MASK & 2) for (int r2_ = 0; r2_ < 1 + ((SUBDUP >> 1) & 1); ++r2_) { PH_IDS(); for (int it = wg; it < 768; it += G) attn_run(lds, WSP(const bf16, WS_Z), WSP(bf16, WS_OPART), WSP(float, WS_LSE), WSP(const float, WS_BIAS), it, wave, lanep); }
                    if (SUB_MASK & 4) for (int r2_ = 0; r2_ < 1 + ((SUBDUP >> 2) & 1); ++r2_) { PH_IDS(); for (int it = wg; it < 512; it += G)
                        sgu_unit(lds, WSP(const bf16, WS_Z), WSP(bf16, WS_ACAT), WSP(const bf16, WS_WC), KIN(8) + (size_t)l * 1024, KIN(9) + (size_t)l * 1024, KIN(11) + (size_t)l * 512, it, wave, lanep); }
                }
                END_PH();
                if (IN_PH(11)) for (int rep_ = 0; rep_ < DUPN(11); ++rep_) { PH_IDS();
                    const int gt = wg * (NWAVES * 64) + tidp, NGT = G * NWAVES * 64;
                    if (rep_ == 0) prefix_phase(WSP(bf16, WS_RT), gt, NGT); else prefix_phase(WSP(bf16, WS_END), gt, NGT);
                    const float* LSE = WSP(const float, WS_LSE); const bf16* OPART = WSP(const bf16, WS_OPART); bf16* ACAT = WSP(bf16, WS_ACAT);
                    for (int p = gt; p < M * 128; p += NGT) { const int row = p >> 7, hh = (p >> 4) & 7, c8 = (p & 15) * 8;
                        const float l0 = LSE[((size_t)0 * M + row) * 8 + hh], l1 = LSE[((size_t)1 * M + row) * 8 + hh], l2 = LSE[((size_t)2 * M + row) * 8 + hh];
                        const float mx = fmaxf(l0, fmaxf(l1, l2)); float w0 = __builtin_amdgcn_exp2f(l0 - mx), w1 = __builtin_amdgcn_exp2f(l1 - mx), w2 = __builtin_amdgcn_exp2f(l2 - mx);
                        const float rs = 1.0f / (w0 + w1 + w2); w0 *= rs; w1 *= rs; w2 *= rs;
                        const size_t o = (size_t)row * 1024 + hh * 128 + c8;
                        const v4u a = *(const v4u*)(OPART + o), b = *(const v4u*)(OPART + (size_t)M * 1024 + o), c = *(const v4u*)(OPART + (size_t)2 * M * 1024 + o);
                        v4u r;
                        r.x = cvt_pk_bf16(w0 * bf_lo(a.x) + w1 * bf_lo(b.x) + w2 * bf_lo(c.x), w0 * bf_hi(a.x) + w1 * bf_hi(b.x) + w2 * bf_hi(c.x));
                        r.y = cvt_pk_bf16(w0 * bf_lo(a.y) + w1 * bf_lo(b.y) + w2 * bf_lo(c.y), w0 * bf_hi(a.y) + w1 * bf_hi(b.y) + w2 * bf_hi(c.y));
                        r.z = cvt_pk_bf16(w0 * bf_lo(a.z) + w1 * bf_lo(b.z) + w2 * bf_lo(c.z), w0 * bf_hi(a.z) + w1 * bf_hi(b.z) + w2 * bf_hi(c.z));
                        r.w = cvt_pk_bf16(w0 * bf_lo(a.w) + w1 * bf_lo(b.w) + w2 * bf_lo(c.w), w0 * bf_hi(a.w) + w1 * bf_hi(b.w) + w2 * bf_hi(c.w));
                        *(v4u*)(ACAT + (size_t)row * KCAT + 3072 + hh * 128 + c8) = r; }
                }
                END_PH();
                if (IN_PH(7)) for (int rep_ = 0; rep_ < DUPN(7); ++rep_) { PH_IDS();
                    for (int it = wg; it < 512; it += G) retout_unit(lds, WSP(const bf16, WS_Z), WSP(const bf16, WS_RT), WSP(bf16, WS_ACAT), it, wave, lanep);
                }
                END_PH();
                if (IN_PH(8)) for (int rep_ = 0; rep_ < DUPN(8); ++rep_) { PH_IDS(); pg8::Gemm g{WSP(const bf16, WS_ACAT), (const bf16*)(ws + WS_W + WO_CAT), M, D, KCAT}; pg8::StaticOrder S; S.init(M, D, G, wg, 4);
                    pg8::EpiProj E{WSP(const bf16, WS_Z), WSP(bf16, WS_MERGED)}; pg8::gemm_phase<pg8::EpiProj, pg8::StaticOrder, true, true>(lds + RING_OFF, g, S, E, wave); }
                END_PH();
                if (IN_PH(9)) for (int rep_ = 0; rep_ < DUPN(9); ++rep_) { PH_IDS(); pg8::Gemm g{WSP(const bf16, WS_MERGED), (const bf16*)(ws + WS_W + WO_OUT), M, D, D}; pg8::StaticOrder S; S.init(M, D, G, wg, 4);
                    pg8::EpiRes E{WSP(const bf16, WS_X), WSP(bf16, WS_X), WSP(float, WS_PART), 1.0f}; pg8::gemm_phase<pg8::EpiRes, pg8::StaticOrder, true, true>(lds + RING_OFF, g, S, E, wave); }
                END_PH();
            }
        }
    }
    if (IN_PH(10)) for (int rep_ = 0; rep_ < DUPN(10); ++rep_) { PH_IDS(); const bf16* X = WSP(const bf16, WS_X); const float* gain = KIN(21); float* out = KOUT();
        for (int m = gw; m < M; m += NGW) rms_row<true>(X + (size_t)m * D, gain, out + (size_t)m * D, lanep);
    }
#undef IN_PH
#undef END_PH
}
constexpr int N_PHASES = DEPTH * (1 + 2 + 6 + 2) + 1;

extern "C" void kernel_launch(void* const* d_in, const int* in_sizes, int n_in, void* d_out, int out_size, void* d_ws, size_t ws_size, hipStream_t stream) {
    static int grid = 0;
    if (grid == 0) {
        if (n_in != 22 || ws_size < WS_END) { fprintf(stderr, "kernel_launch: unexpected n_in %d / ws %zu\n", n_in, ws_size); grid = -1; return; }
        int dev = 0, cus = 0, per_cu = 0;
        if (hipGetDevice(&dev) != hipSuccess || hipDeviceGetAttribute(&cus, hipDeviceAttributeMultiprocessorCount, dev) != hipSuccess) { grid = -1; return; }
        if (hipFuncSetAttribute((const void*)fwd_kernel, hipFuncAttributeMaxDynamicSharedMemorySize, LDS_BYTES) != hipSuccess) { fprintf(stderr, "kernel_launch: hipFuncSetAttribute failed\n"); grid = -1; return; }
        if (hipOccupancyMaxActiveBlocksPerMultiprocessor(&per_cu, (const void*)fwd_kernel, NWAVES * 64, LDS_BYTES) != hipSuccess || per_cu < 1)
            fprintf(stderr, "kernel_launch: occupancy query reports %d workgroups per CU\n", per_cu);
        (void)hipGetLastError();
        grid = cus;
    }
    if (grid < 0) return;
    (void)hipMemsetAsync((char*)d_ws + WS_CTL, 0, CTL_ZERO_BYTES, stream);
    Params p{};
    for (int i = 0; i < 22; ++i) p.in[i] = (const float*)d_in[i];
    p.out = (float*)d_out; p.ws = (unsigned char*)d_ws;
#if MK_PER_PHASE
    for (int k = 0; k < N_PHASES; ++k) { p.ph_lo = k; p.ph_hi = k + 1; hipLaunchKernelGGL(fwd_kernel, dim3(grid), dim3(NWAVES * 64), LDS_BYTES, stream, p); }
#else
    p.ph_lo = 0; p.ph_hi = N_PHASES;
    hipLaunchKernelGGL(fwd_kernel, dim3(grid), dim3(NWAVES * 64), LDS_BYTES, stream, p);
#endif
}
```

```cpp
#include <hip/hip_runtime.h>
#include <cstdio>
#include <cstdint>

#ifndef MK_PER_PHASE
#define MK_PER_PHASE 0
#endif

namespace pg8 {
#define PG8_LAS __attribute__((address_space(3)))
#define PG8_GAS __attribute__((address_space(1)))
typedef unsigned short bf16_t;
typedef short bf16x8 __attribute__((ext_vector_type(8)));
typedef float f32x4 __attribute__((ext_vector_type(4)));
typedef unsigned u32x4 __attribute__((ext_vector_type(4)));
typedef unsigned u32x2 __attribute__((ext_vector_type(2)));
constexpr int BM = 256, BK = 64, HALF = 128, HTB = HALF * BK * 2  , STAGE_BYTES = 8 * HTB, NXCD = 8, WGM = 8;

__host__ __device__ __forceinline__ int lds_byte(int r, int c) { const int st = (r >> 4) * 2 + (c >> 5), rr = r & 15, cc = c & 31, ob = rr * 64 + cc * 2; return st * 1024 + (ob ^ (((ob >> 9) & 1) << 5)); }
__host__ __device__ __forceinline__ void stage_rc(int b, int& R, int& C) { const int st = b / 1024, sb = b % 1024, swz = sb ^ (((sb >> 9) & 1) << 5); R = (st >> 1) * 16 + swz / 64; C = (st & 1) * 32 + (swz % 64) / 2; }
#ifndef PG8_BTILED
#define PG8_BTILED 1
#endif
__host__ __device__ __forceinline__ int perm32inv(int q) { return (((q >> 2) & 1) << 4) | ((q >> 3) << 2) | (q & 3); }
__host__ __device__ __forceinline__ size_t w_tiled_off(int n, int k, int ldk) { const int rw = n & 127, R = (rw & ~31) + perm32inv(rw & 31);
    return ((size_t)(n >> 7) * (size_t)(ldk >> 6) + (size_t)(k >> 6)) * 16384u + (size_t)lds_byte(R, k & 63); }
__host__ __device__ __forceinline__ size_t a_tiled_off(int r, int c, int ld) { return ((size_t)(r >> 7) * (size_t)(ld >> 6) + (size_t)(c >> 6)) * 16384u + (size_t)lds_byte(r & 127, c & 63); }
__host__ __device__ __forceinline__ int perm32(int rho) { const int n = rho >> 4, i = rho & 15; return 8 * (i >> 2) + 4 * n + (i & 3); }

struct Unit { int pm, pn; };
struct Gemm { const bf16_t* A; const bf16_t* Bt; int M, N, K; int atiled; };

struct StaticOrder {
    int nM, nN, nwg, G, c, wgm, rev;
    __host__ __device__ void init(int M, int N, int G_, int c_, int wgm_ = WGM, int rev_ = 0) { nM = M / BM; nN = N / BM; nwg = nM * nN; G = G_; c = c_; wgm = wgm_; rev = rev_; }
    __host__ __device__ __forceinline__ bool next(int i, Unit& u) const {
        const long L = (long)i * G + c; if (L >= nwg) return false;
        int wgid = (int)L; { const int q = nwg / NXCD, r = nwg % NXCD, xcd = wgid % NXCD, off = wgid / NXCD; wgid = (xcd < r ? xcd * (q + 1) : r * (q + 1) + (xcd - r) * q) + off; }
        const int nig = wgm * nN, gid = wgid / nig, fm = gid * wgm, gsz = (nM - fm) < wgm ? (nM - fm) : wgm;
        u.pm = fm + ((wgid % nig) % gsz); u.pn = (wgid % nig) / gsz; if (rev) u.pn = nN - 1 - u.pn; return true;
    }
    __device__ __forceinline__ void a_ready(const Unit&) const {}
    __device__ __forceinline__ void done(const Unit&) const {}
};

typedef float f32x2v_t __attribute__((ext_vector_type(2))); typedef __bf16 bf16x2v_t __attribute__((ext_vector_type(2)));
__device__ __forceinline__ unsigned cvt_pk_bf16(float lo, float hi) { const f32x2v_t v = {lo, hi}; const bf16x2v_t b = __builtin_convertvector(v, bf16x2v_t); return __builtin_bit_cast(unsigned, b); }
#define SWAP16U(a_, b_) do { const auto t_ = __builtin_amdgcn_permlane16_swap((a_), (b_), false, false); (a_) = t_[0]; (b_) = t_[1]; } while (0)
#define SWAP16F(a_, b_) do { const auto t_ = __builtin_amdgcn_permlane16_swap(__float_as_uint(a_), __float_as_uint(b_), false, false); (a_) = __uint_as_float(t_[0]); (b_) = __uint_as_float(t_[1]); } while (0)
__device__ __forceinline__ float xrow_sum(float x) {
    const auto s = __builtin_amdgcn_permlane16_swap(__float_as_uint(x), __float_as_uint(x), false, false); x = __uint_as_float(s[0]) + __uint_as_float(s[1]);
    const auto t = __builtin_amdgcn_permlane32_swap(__float_as_uint(x), __float_as_uint(x), false, false); return __uint_as_float(t[0]) + __uint_as_float(t[1]); }
__device__ __forceinline__ float xrow_max(float x) {
    const auto s = __builtin_amdgcn_permlane16_swap(__float_as_uint(x), __float_as_uint(x), false, false); x = fmaxf(__uint_as_float(s[0]), __uint_as_float(s[1]));
    const auto t = __builtin_amdgcn_permlane32_swap(__float_as_uint(x), __float_as_uint(x), false, false); return fmaxf(__uint_as_float(t[0]), __uint_as_float(t[1])); }
__device__ __forceinline__ int wide_col(int g) { return 16 * (g & 1) + 4 * (g & 2); }
__device__ __forceinline__ float bf_lo(unsigned w) { return __uint_as_float(w << 16); }
__device__ __forceinline__ float bf_hi(unsigned w) { return __uint_as_float(w & 0xffff0000u); }
__device__ __forceinline__ float fast_sigmoid(float x) { return __builtin_amdgcn_rcpf(1.0f + __builtin_amdgcn_exp2f(-1.4426950408889634f * x)); }
__device__ __forceinline__ float silu_f(float x) { return x * fast_sigmoid(x); }
__device__ __forceinline__ float gelu_tanh_f(float x) { const float u = 0.7978845608028654f * (x + 0.044715f * x * x * x); return x * fast_sigmoid(2.0f * u); }

template <class Epi, class Sched, bool ALIGN_EPI = false, bool SP2 = false>
__device__ __forceinline__ void gemm_phase(PG8_LAS unsigned char* lds, const Gemm g, const Sched& S, const Epi& E, int wid) {
    int lane_; asm volatile("v_mbcnt_lo_u32_b32 %0, -1, 0\n\tv_mbcnt_hi_u32_b32 %0, -1, %0" : "=v"(lane_));
    const int lane = lane_, tid = wid * 64 + lane, wr = wid >> 2, wc = wid & 3, fr = lane & 15, fq = lane >> 4;
    const int K = g.K, nt = K / BK;
    unsigned voffA[2], voffB[2];
#pragma unroll
    for (int i = 0; i < 2; ++i) { int R, C; stage_rc(tid * 16 + i * 8192, R, C); const int Rb = Epi::PERM ? ((R & ~31) + perm32(R & 31)) : R;
        voffA[i] = g.atiled ? (unsigned)(tid * 16 + i * 8192) : (unsigned)(R * K + C) * 2u; voffB[i] = PG8_BTILED ? (unsigned)(tid * 16 + i * 8192) : (unsigned)(Rb * K + C) * 2u; }
    const size_t kstep = (size_t)(BK * 2);
    const size_t kstepB = PG8_BTILED ? (size_t)HTB : kstep;
    const size_t kstepA = g.atiled ? (size_t)HTB : kstep;
    const size_t hstep = (size_t)HALF * K * 2;
    const size_t tstep = 2 * hstep;
    const unsigned ldsw = (unsigned)wid * 1024u;
    const int aoff = lds_byte(wr * 64 + fr, fq * 8), boff = lds_byte(wc * 32 + fr, fq * 8);
#define PG8_SA(b, h) (((b) * 2 + (h)) * HTB)
#define PG8_SB(b, h) ((4 + (b) * 2 + (h)) * HTB)
#if defined(PG8_DMA_BUILTIN)
#define PG8_STAGE(bufoff, gbase, voff) do { _Pragma("unroll") for (int _i = 0; _i < 2; ++_i) \
        __builtin_amdgcn_global_load_lds((const PG8_GAS unsigned*)((gbase) + (voff)[_i]), (PG8_LAS unsigned*)(lds + (bufoff) + ldsw + _i * 8192), 16, 0, 0); } while (0)
#else
    const unsigned ldsa = (unsigned)__builtin_amdgcn_readfirstlane((int)((unsigned)(size_t)lds + ldsw));
#define PG8_STAGE(bufoff, gbase, voff) do { const gptr gb_ = (gbase); _Pragma("unroll") for (int _i = 0; _i < 2; ++_i) \
        asm volatile("s_mov_b32 m0, %0\n\ts_nop 0\n\tglobal_load_lds_dwordx4 %1, %2" :: "s"(ldsa + (unsigned)((bufoff) + _i * 8192)), "v"((voff)[_i]), "s"(gb_) : "memory"); } while (0)
#endif
#define PG8_LDA(dst, b, h) do { _Pragma("unroll") for (int m = 0; m < 4; ++m) _Pragma("unroll") for (int k = 0; k < 2; ++k) dst[m][k] = *(const PG8_LAS bf16x8*)(lds + PG8_SA(b, h) + aoff + m * 2048 + k * 1024); } while (0)
    PG8_LAS unsigned char* ldsB = lds + 4 * HTB + boff; asm volatile("" : "+v"(ldsB));
#define PG8_LDB(dst, b, h) do { _Pragma("unroll") for (int n = 0; n < 2; ++n) _Pragma("unroll") for (int k = 0; k < 2; ++k) dst[n][k] = *(const PG8_LAS bf16x8*)(ldsB + ((b) * 2 + (h)) * HTB + n * 2048 + k * 1024); } while (0)
#define PG8_MMA(ai, bj, At, Bt) do { __builtin_amdgcn_s_setprio(1); _Pragma("unroll") for (int m = 0; m < 4; ++m) _Pragma("unroll") for (int n = 0; n < 2; ++n) _Pragma("unroll") for (int k = 0; k < 2; ++k) \
        acc[ai][bj][m][n] = __builtin_amdgcn_mfma_f32_16x16x32_bf16(Bt[n][k], At[m][k], acc[ai][bj][m][n], 0, 0, 0); __builtin_amdgcn_s_setprio(0); } while (0)
#define PG8_WAIT_VL80 do { asm volatile("" ::: "memory"); __builtin_amdgcn_s_waitcnt(0x0078); asm volatile("" ::: "memory"); } while (0)
#define PG8_MMA2(ai, At, Bx, By) do { __builtin_amdgcn_s_setprio(1); _Pragma("unroll") for (int m = 0; m < 4; ++m) _Pragma("unroll") for (int n = 0; n < 2; ++n) _Pragma("unroll") for (int k = 0; k < 2; ++k) \
        acc[ai][0][m][n] = __builtin_amdgcn_mfma_f32_16x16x32_bf16(Bx[n][k], At[m][k], acc[ai][0][m][n], 0, 0, 0); \
        _Pragma("unroll") for (int m = 0; m < 4; ++m) _Pragma("unroll") for (int n = 0; n < 2; ++n) _Pragma("unroll") for (int k = 0; k < 2; ++k) \
        acc[ai][1][m][n] = __builtin_amdgcn_mfma_f32_16x16x32_bf16(By[n][k], At[m][k], acc[ai][1][m][n], 0, 0, 0); __builtin_amdgcn_s_setprio(0); } while (0)
#define PG8_WAIT_V(n) asm volatile("s_waitcnt vmcnt(" #n ")" ::: "memory")
#define PG8_WAIT_L(n) asm volatile("s_waitcnt lgkmcnt(" #n ")" ::: "memory")
#define PG8_BAR __builtin_amdgcn_s_barrier()
#define PG8_SCHED __builtin_amdgcn_sched_barrier(0)
    Unit cur, nxt; int ui = 0;
    if (!S.next(0, cur)) return;
    f32x4 acc[2][2][4][2];
#pragma unroll
    for (int a = 0; a < 2; ++a)
#pragma unroll
        for (int b = 0; b < 2; ++b)
#pragma unroll
            for (int m = 0; m < 4; ++m)
#pragma unroll
                for (int n = 0; n < 2; ++n) acc[a][b][m][n] = (f32x4){0.f, 0.f, 0.f, 0.f};
    bf16x8 At[4][2], B0[2][2], B1[2][2];
    typedef const PG8_GAS char* gptr;
    const gptr gA0 = (gptr)g.A, gB0 = (gptr)g.Bt;
    gptr cA = gA0 + (size_t)cur.pm * tstep; gptr cB = gB0 + (size_t)cur.pn * tstep;
    S.a_ready(cur);
    if constexpr (SP2) {
        PG8_STAGE(PG8_SB(0, 0), cB, voffB); PG8_STAGE(PG8_SB(0, 1), cB + hstep, voffB); PG8_STAGE(PG8_SA(0, 0), cA, voffA); PG8_STAGE(PG8_SA(0, 1), cA + hstep, voffA);
        if (wr == 1) PG8_BAR;
        PG8_WAIT_V(2); PG8_BAR;
        PG8_STAGE(PG8_SB(1, 0), cB + kstepB, voffB); PG8_STAGE(PG8_SA(1, 0), cA + kstepA, voffA); PG8_STAGE(PG8_SB(1, 1), cB + hstep + kstepB, voffB);
        PG8_WAIT_V(6); PG8_BAR;
    } else {
        PG8_STAGE(PG8_SB(0, 0), cB, voffB); PG8_STAGE(PG8_SA(0, 0), cA, voffA); PG8_STAGE(PG8_SB(0, 1), cB + hstep, voffB); PG8_STAGE(PG8_SA(0, 1), cA + hstep, voffA);
        if (wr == 1) PG8_BAR;
        PG8_WAIT_V(4); PG8_BAR;
        PG8_STAGE(PG8_SB(1, 0), cB + kstepB, voffB); PG8_STAGE(PG8_SA(1, 0), cA + kstepA, voffA); PG8_STAGE(PG8_SB(1, 1), cB + hstep + kstepB, voffB);
        PG8_WAIT_V(6); PG8_BAR;
    }
    for (;;) {
        const bool has_next = S.next(ui + 1, nxt);
        const gptr nA = has_next ? gA0 + (size_t)nxt.pm * tstep : cA; const gptr nB = has_next ? gB0 + (size_t)nxt.pn * tstep : cB;
        for (int t = 0; t < nt; t += 2) {
            const bool last = (t == nt - 2);
            const gptr a1 = cA + (size_t)(t + 1) * kstepA;
            const gptr a2 = last ? nA : cA + (size_t)(t + 2) * kstepA; const gptr b2 = last ? nB : cB + (size_t)(t + 2) * kstepB;
            const gptr a3 = a2 + kstepA; const gptr b3 = b2 + kstepB;
            if (last && has_next) S.a_ready(nxt);
            if constexpr (Epi::MID) { if (t == Epi::MID_T0 || t == Epi::MID_T1) E.mid(acc, cur, t, wr, wc, fr, fq); }
            if constexpr (SP2) {
            PG8_LDB(B0, 0, 0); PG8_LDB(B1, 0, 1); PG8_SCHED; PG8_LDA(At, 0, 0); PG8_STAGE(PG8_SA(1, 1), a1 + hstep, voffA);
            PG8_WAIT_VL80; PG8_BAR; PG8_MMA2(0, At, B0, B1); PG8_BAR; PG8_SCHED;
            PG8_LDA(At, 0, 1); PG8_STAGE(PG8_SB(0, 0), b2, voffB); PG8_STAGE(PG8_SB(0, 1), b2 + hstep, voffB); PG8_STAGE(PG8_SA(0, 0), a2, voffA);
            PG8_WAIT_VL80; PG8_BAR; PG8_MMA2(1, At, B0, B1); PG8_BAR; PG8_SCHED;
            PG8_LDB(B0, 1, 0); PG8_LDB(B1, 1, 1); PG8_SCHED; PG8_LDA(At, 1, 0); PG8_STAGE(PG8_SA(0, 1), a2 + hstep, voffA);
            PG8_WAIT_VL80; PG8_BAR; PG8_MMA2(0, At, B0, B1); PG8_BAR; PG8_SCHED;
            PG8_LDA(At, 1, 1); PG8_STAGE(PG8_SB(1, 0), b3, voffB); PG8_STAGE(PG8_SB(1, 1), b3 + hstep, voffB); PG8_STAGE(PG8_SA(1, 0), a3, voffA);
            PG8_WAIT_VL80; PG8_BAR; PG8_MMA2(1, At, B0, B1); PG8_BAR; PG8_SCHED;
            } else {
            PG8_LDB(B0, 0, 0); PG8_SCHED; PG8_LDA(At, 0, 0); PG8_STAGE(PG8_SA(1, 1), a1 + hstep, voffA);
            PG8_WAIT_L(8); PG8_BAR; PG8_WAIT_L(0); PG8_MMA(0, 0, At, B0); PG8_BAR; PG8_SCHED;
            PG8_LDB(B1, 0, 1); PG8_STAGE(PG8_SB(0, 0), b2, voffB);
            PG8_BAR; PG8_WAIT_L(0); PG8_MMA(0, 1, At, B1); PG8_BAR;
            PG8_LDA(At, 0, 1); PG8_STAGE(PG8_SA(0, 0), a2, voffA);
            PG8_BAR; PG8_WAIT_L(0); PG8_MMA(1, 0, At, B0); PG8_BAR; PG8_SCHED;
            PG8_STAGE(PG8_SB(0, 1), b2 + hstep, voffB);
            PG8_WAIT_V(6); PG8_BAR; PG8_MMA(1, 1, At, B1); PG8_BAR;
            PG8_LDB(B0, 1, 0); PG8_SCHED; PG8_LDA(At, 1, 0); PG8_STAGE(PG8_SA(0, 1), a2 + hstep, voffA);
            PG8_WAIT_L(8); PG8_BAR; PG8_WAIT_L(0); PG8_MMA(0, 0, At, B0); PG8_BAR; PG8_SCHED;
            PG8_LDB(B1, 1, 1); PG8_STAGE(PG8_SB(1, 0), b3, voffB);
            PG8_BAR; PG8_WAIT_L(0); PG8_MMA(0, 1, At, B1); PG8_BAR;
            PG8_LDA(At, 1, 1); PG8_STAGE(PG8_SA(1, 0), a3, voffA);
            PG8_BAR; PG8_WAIT_L(0); PG8_MMA(1, 0, At, B0); PG8_BAR; PG8_SCHED;
            PG8_STAGE(PG8_SB(1, 1), b3 + hstep, voffB);
            PG8_WAIT_V(6); PG8_BAR; PG8_MMA(1, 1, At, B1); PG8_BAR;
            }
        }
        if constexpr (ALIGN_EPI) { if (wr == 0) PG8_BAR; }
        E(acc, cur, wr, wc, fr, fq); S.done(cur);
#if defined(EPI_DUP)
        if constexpr (Epi::IDEMPOTENT) { asm volatile("" ::: "memory"); E(acc, cur, wr, wc, fr, fq); }
#endif
        if (!has_next) break;
#pragma unroll
        for (int a = 0; a < 2; ++a)
#pragma unroll
            for (int b = 0; b < 2; ++b)
#pragma unroll
                for (int m = 0; m < 4; ++m)
#pragma unroll
                    for (int n = 0; n < 2; ++n) acc[a][b][m][n] = (f32x4){0.f, 0.f, 0.f, 0.f};
        cur = nxt; cA = nA; cB = nB; ++ui;
        if constexpr (ALIGN_EPI) { if (wr == 1) PG8_BAR; }
    }
    PG8_WAIT_V(0);
    if constexpr (!ALIGN_EPI) { if (wr == 0) PG8_BAR; }
    PG8_BAR;
#undef PG8_SA
#undef PG8_SB
#undef PG8_STAGE
#undef PG8_LDA
#undef PG8_LDB
#undef PG8_MMA
#undef PG8_WAIT_V
#undef PG8_WAIT_L
#undef PG8_BAR
#undef PG8_SCHED
}
}

constexpr int BATCH = 2, T = 8192, M = BATCH * T, D = 2048, FF = 5632, DIN = 17408, DEPTH = 4;
constexpr int C_RQ = 0, C_RK = 1024, C_RV = 2048, C_RG = 4096, C_SU = 6144, C_SV = 7168, C_AQ = 8192, C_AK = 9216, C_AV = 10240, C_GL = 11264;
constexpr int KCAT = 4096;
constexpr float EPS = 1e-6f, LOG2E = 1.4426950408889634f;
constexpr int NWAVES = 8;

constexpr size_t MiB = 1u << 20;
constexpr size_t WS_CTL = 0, CTL_ZERO_BYTES = 64 * 1024;
constexpr size_t WS_SVSTAT = 1 * MiB;
constexpr size_t WS_BIAS = 2 * MiB;
constexpr size_t WS_WC = 3 * MiB;
constexpr size_t WS_LSE = 4 * MiB;
constexpr size_t WS_ROPE = 8 * MiB;
constexpr size_t WS_W = 16 * MiB;
constexpr size_t WO_GU1 = 0, WO_D1 = 44 * MiB, WO_IN = 66 * MiB, WO_CAT = 134 * MiB, WO_OUT = 150 * MiB, WO_GU2 = 158 * MiB, WO_D2 = 202 * MiB, W_BYTES = 224 * MiB;
constexpr size_t WS_X = 240 * MiB;
constexpr size_t WS_XB = 368 * MiB;
constexpr size_t WS_Z = 432 * MiB;
constexpr size_t WS_RT = 976 * MiB;
constexpr size_t WS_ACAT = 1104 * MiB;
constexpr size_t WS_OPART = 1232 * MiB;
constexpr size_t WS_MERGED = 1328 * MiB;
constexpr size_t WS_TB = 1392 * MiB;
constexpr size_t WS_SGP = 1408 * MiB;
constexpr size_t WS_G8 = 1410 * MiB;
constexpr size_t WS_RS = 1506 * MiB;
constexpr size_t WS_END = 1602 * MiB;
constexpr size_t WS_PART = 6 * MiB;
static_assert((size_t)11264 * 2048 * 2 == 44 * MiB && (size_t)2048 * 5632 * 2 == 22 * MiB && (size_t)17408 * 2048 * 2 == 68 * MiB && (size_t)2048 * 4096 * 2 == 16 * MiB, "weight map");
static_assert((size_t)M * DIN * 2 == 544 * MiB && (size_t)M * D * 4 == 128 * MiB, "activation map");
constexpr int CW_TMO = 0, CW_BAR = 4096;

constexpr int RING_OFF = 0, RING_BYTES = 155648;
constexpr int RSTD_OFF = 131072;
constexpr int LDSCTL_OFF = RING_BYTES, MISC_OFF = LDSCTL_OFF + 320;
constexpr int LDS_BYTES = 157696;

#define GAS __attribute__((address_space(1)))
#define LAS __attribute__((address_space(3)))
typedef unsigned short bf16;
typedef unsigned v4u __attribute__((ext_vector_type(4)));
typedef unsigned v2u __attribute__((ext_vector_type(2)));
typedef float f32x4 __attribute__((ext_vector_type(4)));
typedef short bf16x8 __attribute__((ext_vector_type(8)));
typedef short s16x4 __attribute__((ext_vector_type(4)));
typedef GAS unsigned gu32;
#define RLX_AGENT __ATOMIC_RELAXED, __HIP_MEMORY_SCOPE_AGENT
#define LDS_WAIT() asm volatile("s_waitcnt lgkmcnt(0)" ::: "memory")
#define VM_WAIT() asm volatile("s_waitcnt vmcnt(0)" ::: "memory")
__device__ __forceinline__ unsigned f2bf(float f) { unsigned u = __builtin_bit_cast(unsigned, f); return (u + 0x7fffu + ((u >> 16) & 1u)) >> 16; }
__device__ __forceinline__ unsigned pk2(float lo, float hi) { return f2bf(lo) | (f2bf(hi) << 16); }
using pg8::cvt_pk_bf16; using pg8::bf_lo; using pg8::bf_hi; using pg8::xrow_sum; using pg8::xrow_max; using pg8::wide_col;

#define XB_TMO      128
#define XB_XCNT(j)  (256  + 64 * (j))
#define XB_XSUB(j)  (1280 + 64 * (j))
#define XB_XGEN(j)  (2304 + 64 * (j))
#define XB_TOP      3328
#define XB_TOPGEN   3392
#define XCD_BAR_WORDS 3456
#define XB_SPIN_CAP (1u << 20)

__device__ __forceinline__ unsigned xb_ld(unsigned* p)              { return __hip_atomic_load(p, __ATOMIC_RELAXED, __HIP_MEMORY_SCOPE_AGENT); }
__device__ __forceinline__ unsigned xb_add(unsigned* p, unsigned v) { return __hip_atomic_fetch_add(p, v, __ATOMIC_RELAXED, __HIP_MEMORY_SCOPE_AGENT); }
__device__ __forceinline__ unsigned xb_xcc_id() { return (unsigned)__builtin_amdgcn_s_getreg((3 << 11) | 20) & 0xFu; }
#define XB_SPIN(cond, bar) do { unsigned _sp = 0; while (cond) { __builtin_amdgcn_s_sleep(1); \
    if ((++_sp & 255u) == 0u) { if (xb_ld(&(bar)[XB_TMO])) break; if (_sp > XB_SPIN_CAP) { atomicAdd(&(bar)[XB_TMO], 1u); break; } } } } while (0)

struct XcdBarrier { unsigned* bar; unsigned x; volatile LAS unsigned* st; };

__device__ __forceinline__ XcdBarrier xcd_barrier_post(unsigned* bar, volatile LAS unsigned* st) {
    XcdBarrier b; b.bar = bar; b.x = xb_xcc_id(); b.st = st;
    if (threadIdx.x == 0) (void)xb_add(&bar[XB_XCNT(b.x)], 1u);
    return b;
}
__device__ __forceinline__ void xcd_barrier_complete(unsigned* bar, unsigned x, unsigned& nloc, unsigned& nx) {
    const unsigned G = gridDim.x * gridDim.y * gridDim.z;
    unsigned sum, cnt, mine, sp = 0u;
    for (;;) {
        sum = 0u; cnt = 0u; mine = 0u;
#pragma unroll
        for (unsigned j = 0; j < 16; ++j) { const unsigned c = xb_ld(&bar[XB_XCNT(j)]); sum += c; cnt += (c > 0u) ? 1u : 0u; mine = (j == x) ? c : mine; }
        if (sum == G) break;
        __builtin_amdgcn_s_sleep(1);
        if ((++sp & 255u) == 0u) { if (xb_ld(&bar[XB_TMO])) break; if (sp > XB_SPIN_CAP) { atomicAdd(&bar[XB_TMO], 1u); break; } }
    }
    nloc = mine > 0u ? mine : 1u; nx = cnt > 0u ? cnt : 1u;
}
__device__ __forceinline__ void xcd_barrier(const XcdBarrier& b, int wave) {
    asm volatile("s_waitcnt vmcnt(0)" ::: "memory");
    __syncthreads();
    int lane0_; asm volatile("v_mbcnt_lo_u32_b32 %0, -1, 0\n\tv_mbcnt_hi_u32_b32 %0, -1, %0" : "=v"(lane0_));
    if (wave == 0 && lane0_ == 0) {
        unsigned* bar = b.bar;
        __builtin_amdgcn_s_waitcnt(0);
        unsigned nloc = b.st[0], nx = b.st[1];
        if (nloc == 0u) { xcd_barrier_complete(bar, b.x, nloc, nx); b.st[0] = nloc; b.st[1] = nx; }
        const unsigned old = xb_add(&bar[XB_XSUB(b.x)], 1u);
        const unsigned gen = old / nloc;
        if (old + 1u == (gen + 1u) * nloc) {
            __builtin_amdgcn_fence(__ATOMIC_RELEASE, "agent");
            asm volatile("s_waitcnt vmcnt(0)" ::: "memory");
            const unsigned og = xb_add(&bar[XB_TOP], 1u);
            const unsigned tg = og / nx;
            if (og + 1u == (tg + 1u) * nx) xb_add(&bar[XB_TOPGEN], 1u);
            else XB_SPIN(xb_ld(&bar[XB_TOPGEN]) == tg, bar);
            __builtin_amdgcn_fence(__ATOMIC_ACQUIRE, "agent");
            xb_add(&bar[XB_XGEN(b.x)], 1u);
            asm volatile("s_waitcnt vmcnt(0)" ::: "memory");
        } else {
            XB_SPIN(xb_ld(&bar[XB_XGEN(b.x)]) == gen, bar);
            __builtin_amdgcn_fence(__ATOMIC_ACQUIRE, "agent");
            asm volatile("s_waitcnt vmcnt(0)" ::: "memory");
        }
    }
    __syncthreads();
}

#ifndef EPI_DUP_SEL
#define EPI_DUP_SEL 0
#endif
namespace pg8 {

struct EpiGU {
    static constexpr bool PERM = true, MID = false, IDEMPOTENT = (EPI_DUP_SEL == 1); static constexpr int MID_T0 = -1, MID_T1 = -1;
    bf16_t* O; const PG8_LAS float* rstd;
    __device__ __forceinline__ void operator()(const f32x4 (&acc)[2][2][4][2], const Unit& u, int wr, int wc, int fr_, int fq_) const {
        int fr = fr_, fq = fq_; asm volatile("" : "+v"(fr), "+v"(fq));
        const int row0 = u.pm * BM + wr * 64 + fr, col0 = u.pn * HALF + wc * 32 + 8 * fq;
#pragma unroll
        for (int ai = 0; ai < 2; ++ai)
#pragma unroll
            for (int m = 0; m < 4; ++m) { bf16_t* rowp = (bf16_t*)((unsigned char*)O + a_tiled_off(row0 + ai * HALF + m * 16, col0, FF)); const float r = rstd[ai * HALF + wr * 64 + m * 16 + fr];
                const float ce = -LOG2E * r, r2 = r * r; const f32x4 ga = acc[ai][0][m][0], gb = acc[ai][0][m][1];
                f32x4 sa, sb;
#pragma unroll
                for (int j = 0; j < 4; ++j) { sa[j] = __builtin_amdgcn_rcpf(1.0f + __builtin_amdgcn_exp2f(ga[j] * ce)); sb[j] = __builtin_amdgcn_rcpf(1.0f + __builtin_amdgcn_exp2f(gb[j] * ce)); }
                const f32x4 oa = (ga * acc[ai][1][m][0]) * (sa * r2), ob = (gb * acc[ai][1][m][1]) * (sb * r2);
                u32x4 w; w.x = cvt_pk_bf16(oa[0], oa[1]); w.y = cvt_pk_bf16(oa[2], oa[3]); w.z = cvt_pk_bf16(ob[0], ob[1]); w.w = cvt_pk_bf16(ob[2], ob[3]);
#if defined(EPI_LANE_T)
                { const int ln = fq * 16 + fr, src4 = ((ln & 3) * 16 + (ln >> 2)) * 4;
                  u32x4 t; t.x = (unsigned)__builtin_amdgcn_ds_bpermute(src4, (int)w.x); t.y = (unsigned)__builtin_amdgcn_ds_bpermute(src4, (int)w.y); t.z = (unsigned)__builtin_amdgcn_ds_bpermute(src4, (int)w.z); t.w = (unsigned)__builtin_amdgcn_ds_bpermute(src4, (int)w.w);
                  bf16_t* rp2 = O + (size_t)(u.pm * BM + wr * 64 + (ln >> 2) + ai * HALF + m * 16) * FF + u.pn * HALF + wc * 32 + 8 * (ln & 3);
                  *(u32x4*)rp2 = t; }
#else
                *(u32x4*)rowp = w;
#endif
                }
    }
};
struct EpiRes {
    static constexpr bool PERM = true, MID = false, IDEMPOTENT = false; static constexpr int MID_T0 = -1, MID_T1 = -1;
    const bf16_t* Xin; bf16_t* Xout; float* part; float scale;
    __device__ __forceinline__ void operator()(const f32x4 (&acc)[2][2][4][2], const Unit& u, int wr, int wc, int fr_, int fq_) const {
        int fr = fr_, fq = fq_; asm volatile("" : "+v"(fr), "+v"(fq));
        const int row0 = u.pm * BM + wr * 64 + fr, col0 = u.pn * BM + wc * 32 + 8 * fq;
#pragma unroll
        for (int ai = 0; ai < 2; ++ai) { u32x4 bs[4][2];
#pragma unroll
            for (int m = 0; m < 4; ++m) {
#pragma unroll
                for (int bj = 0; bj < 2; ++bj) bs[m][bj] = *(const u32x4*)((const unsigned char*)Xin + a_tiled_off(row0 + ai * HALF + m * 16, col0 + bj * HALF, D)); }
            asm volatile("" ::: "memory");
            float sm[4];
#pragma unroll
            for (int m = 0; m < 4; ++m) { const int row = row0 + ai * HALF + m * 16; float ss = 0.f;
#pragma unroll
                for (int bj = 0; bj < 2; ++bj) { const u32x4 x = bs[m][bj]; const f32x4 a0 = acc[ai][bj][m][0] * scale, a1 = acc[ai][bj][m][1] * scale;
                    u32x4 w; w.x = cvt_pk_bf16(bf_lo(x.x) + a0[0], bf_hi(x.x) + a0[1]); w.y = cvt_pk_bf16(bf_lo(x.y) + a0[2], bf_hi(x.y) + a0[3]);
                    w.z = cvt_pk_bf16(bf_lo(x.z) + a1[0], bf_hi(x.z) + a1[1]); w.w = cvt_pk_bf16(bf_lo(x.w) + a1[2], bf_hi(x.w) + a1[3]);
                    *(u32x4*)((unsigned char*)Xout + a_tiled_off(row, col0 + bj * HALF, D)) = w;
                    { const float a0 = bf_lo(w.x), a1 = bf_hi(w.x), a2 = bf_lo(w.y), a3 = bf_hi(w.y), a4 = bf_lo(w.z), a5 = bf_hi(w.z), a6 = bf_lo(w.w), a7 = bf_hi(w.w);
                      ss += ((a0 * a0 + a1 * a1) + (a2 * a2 + a3 * a3)) + ((a4 * a4 + a5 * a5) + (a6 * a6 + a7 * a7)); } }
                sm[m] = xrow_sum(ss); }
            { const float sel = fq == 0 ? sm[0] : fq == 1 ? sm[1] : fq == 2 ? sm[2] : sm[3]; part[(size_t)(row0 + ai * HALF + fq * 16) * 32 + u.pn * 4 + wc] = sel; }
            asm volatile("" ::: "memory"); }
    }
};
__device__ __forceinline__ size_t g8_chunk(int sec, int pm, int tile, int ai, int wr, int m, int wc) { return ((size_t)((((((sec * 64 + pm) * 8 + tile) * 2 + ai) * 2 + wr) * 4 + m) * 4 + wc)) << 10; }
struct EpiProj {
    static constexpr bool PERM = true, MID = true, IDEMPOTENT = (EPI_DUP_SEL == 3); static constexpr int MID_T0 = 32, MID_T1 = 48;
    const unsigned char* G8; bf16_t* O;
#define PJ_BYTE(w_, k_) ((float)(((w_) >> (8 * (k_))) & 0xffu))
    __device__ __forceinline__ void mid(f32x4 (&acc)[2][2][4][2], const Unit& u, int t, int wr, int wc, int fr_, int fq_) const {
        int fr = fr_, fq = fq_; asm volatile("" : "+v"(fr), "+v"(fq));
        const int row0 = u.pm * BM + wr * 64 + fr, wcol = u.pn * BM + wc * 32 + 8 * (fq & ~1) + HALF * (fq & 1); const int sn = (t == MID_T0) ? 0 : 1; const int lo16 = (fq * 16 + fr) * 16; (void)row0; (void)wcol;
#pragma unroll
        for (int ai = 0; ai < 2; ++ai) { u32x4 ga[4], gb[4];
#pragma unroll
            for (int m = 0; m < 4; ++m) { ga[m] = *(const u32x4*)(G8 + g8_chunk(sn, u.pm, u.pn, ai, wr, m, wc) + lo16); gb[m] = *(const u32x4*)(G8 + g8_chunk(sn + 1, u.pm, u.pn, ai, wr, m, wc) + lo16); }
            asm volatile("" ::: "memory");
#pragma unroll
            for (int m = 0; m < 4; ++m) { const u32x4 a = ga[m], b = gb[m];
#pragma unroll
                for (int j = 0; j < 4; ++j) { acc[ai][0][m][0][j] *= PJ_BYTE(a.x, j) * __builtin_amdgcn_rcpf(PJ_BYTE(b.x, j)); acc[ai][0][m][1][j] *= PJ_BYTE(a.y, j) * __builtin_amdgcn_rcpf(PJ_BYTE(b.y, j));
                                              acc[ai][1][m][0][j] *= PJ_BYTE(a.z, j) * __builtin_amdgcn_rcpf(PJ_BYTE(b.z, j)); acc[ai][1][m][1][j] *= PJ_BYTE(a.w, j) * __builtin_amdgcn_rcpf(PJ_BYTE(b.w, j)); } }
            asm volatile("" ::: "memory"); }
    }
    __device__ __forceinline__ void operator()(const f32x4 (&acc)[2][2][4][2], const Unit& u, int wr, int wc, int fr_, int fq_) const {
        int fr = fr_, fq = fq_; asm volatile("" : "+v"(fr), "+v"(fq));
        const int row0 = u.pm * BM + wr * 64 + fr, col0 = u.pn * BM + wc * 32 + 8 * fq, wcol = u.pn * BM + wc * 32 + 8 * (fq & ~1) + HALF * (fq & 1);
        const float i255 = 1.0f / 255.0f;
#pragma unroll
        for (int ai = 0; ai < 2; ++ai)
#pragma unroll
            for (int m = 0; m < 4; ++m) { const int row = row0 + ai * HALF + m * 16;
                const u32x4 a = *(const u32x4*)(G8 + g8_chunk(2, u.pm, u.pn, ai, wr, m, wc) + (fq * 16 + fr) * 16);
#pragma unroll
                for (int bj = 0; bj < 2; ++bj) { const unsigned g0 = bj ? a.z : a.x, g1 = bj ? a.w : a.y; const f32x4 v0 = acc[ai][bj][m][0] * i255, v1 = acc[ai][bj][m][1] * i255;
                    u32x4 w; w.x = cvt_pk_bf16(v0[0] * PJ_BYTE(g0, 0), v0[1] * PJ_BYTE(g0, 1)); w.y = cvt_pk_bf16(v0[2] * PJ_BYTE(g0, 2), v0[3] * PJ_BYTE(g0, 3));
                    w.z = cvt_pk_bf16(v1[0] * PJ_BYTE(g1, 0), v1[1] * PJ_BYTE(g1, 1)); w.w = cvt_pk_bf16(v1[2] * PJ_BYTE(g1, 2), v1[3] * PJ_BYTE(g1, 3));
                    *(u32x4*)((unsigned char*)O + a_tiled_off(row, col0 + bj * HALF, D)) = w; } }
    }
#undef PJ_BYTE
};
struct EpiWin {
    static constexpr bool PERM = true, MID = false, IDEMPOTENT = (EPI_DUP_SEL == 2); static constexpr int MID_T0 = -1, MID_T1 = -1;
    bf16_t* Z; const float* bgate; const float* rope; float* sgp; unsigned char* g8; const PG8_LAS float* rstd;
    __device__ __forceinline__ void operator()(const f32x4 (&acc)[2][2][4][2], const Unit& u, int wr, int wc, int fr_, int fq_) const {
        int fr = fr_, fq = fq_; asm volatile("" : "+v"(fr), "+v"(fq));
        const int pn = u.pn, row0 = u.pm * BM + wr * 64 + fr, cl = wc * 32 + 8 * fq;
        if (pn < 8) {
            const int h = pn & 3; const bool isk = pn >= 4;
            const float l2g = __builtin_log2f(1.0f - __builtin_amdgcn_exp2f(-5.0f - (float)h));
            const f32x4 f0 = *(const f32x4*)(rope + cl), f1 = *(const f32x4*)(rope + cl + 4);
#pragma unroll
            for (int ai = 0; ai < 2; ++ai)
#pragma unroll
                for (int m = 0; m < 4; ++m) { const int row = row0 + ai * HALF + m * 16, pos = row & (T - 1), ci = row & 127;
                    const float sc = (isk ? __builtin_amdgcn_exp2f(-(float)ci * l2g) * 0.0625f : __builtin_amdgcn_exp2f((float)ci * l2g)) * rstd[ai * HALF + wr * 64 + m * 16 + fr];
                    const float fp = (float)pos; f32x4 c0, c1, s0, s1;
#pragma unroll
                    for (int j = 0; j < 4; ++j) { const float ra = __builtin_amdgcn_fractf(fp * f0[j]), rb = __builtin_amdgcn_fractf(fp * f1[j]);
                        c0[j] = __builtin_amdgcn_cosf(ra); s0[j] = __builtin_amdgcn_sinf(ra); c1[j] = __builtin_amdgcn_cosf(rb); s1[j] = __builtin_amdgcn_sinf(rb); }
                    const f32x4 t1a = acc[ai][0][m][0], t1b = acc[ai][0][m][1], t2a = acc[ai][1][m][0], t2b = acc[ai][1][m][1];
                    const f32x4 o1a = (t1a * c0 - t2a * s0) * sc, o1b = (t1b * c1 - t2b * s1) * sc, o2a = (t1a * s0 + t2a * c0) * sc, o2b = (t1b * s1 + t2b * c1) * sc;
                    bf16_t* zp = Z + (size_t)row * DIN + pn * BM + cl;
                    u32x4 w; w.x = cvt_pk_bf16(o1a[0], o1a[1]); w.y = cvt_pk_bf16(o1a[2], o1a[3]); w.z = cvt_pk_bf16(o1b[0], o1b[1]); w.w = cvt_pk_bf16(o1b[2], o1b[3]); *(u32x4*)zp = w;
                    w.x = cvt_pk_bf16(o2a[0], o2a[1]); w.y = cvt_pk_bf16(o2a[2], o2a[3]); w.z = cvt_pk_bf16(o2b[0], o2b[1]); w.w = cvt_pk_bf16(o2b[2], o2b[3]); *(u32x4*)(zp + HALF) = w; }
            return;
        }
        if (pn >= 28 && pn < 32) {
#pragma unroll
            for (int ai = 0; ai < 2; ++ai) { float qa[4], qb[4];
#pragma unroll
                for (int m = 0; m < 4; ++m) { const int row = row0 + ai * HALF + m * 16; bf16_t* zp = Z + (size_t)row * DIN + pn * BM + cl; const float rs = rstd[ai * HALF + wr * 64 + m * 16 + fr];
                    float q1 = 0.f, q2 = 0.f;
#pragma unroll
                    for (int bj = 0; bj < 2; ++bj) { f32x4 v0 = acc[ai][bj][m][0] * rs, v1 = acc[ai][bj][m][1] * rs;
#pragma unroll
                        for (int j = 0; j < 4; ++j) { v0[j] = gelu_tanh_f(v0[j]); v1[j] = gelu_tanh_f(v1[j]); }
                        u32x4 w; w.x = cvt_pk_bf16(v0[0], v0[1]); w.y = cvt_pk_bf16(v0[2], v0[3]); w.z = cvt_pk_bf16(v1[0], v1[1]); w.w = cvt_pk_bf16(v1[2], v1[3]);
                        *(u32x4*)(zp + bj * HALF) = w;
                        const float a0 = bf_lo(w.x), a1 = bf_hi(w.x), a2 = bf_lo(w.y), a3 = bf_hi(w.y), a4 = bf_lo(w.z), a5 = bf_hi(w.z), a6 = bf_lo(w.w), a7 = bf_hi(w.w);
                        q1 += ((a0 + a1) + (a2 + a3)) + ((a4 + a5) + (a6 + a7)); q2 += ((a0 * a0 + a1 * a1) + (a2 * a2 + a3 * a3)) + ((a4 * a4 + a5 * a5) + (a6 * a6 + a7 * a7)); }
                    qa[m] = xrow_sum(q1); qb[m] = xrow_sum(q2); }
                { f32x2v_t pr; pr[0] = fq == 0 ? qa[0] : fq == 1 ? qa[1] : fq == 2 ? qa[2] : qa[3]; pr[1] = fq == 0 ? qb[0] : fq == 1 ? qb[1] : fq == 2 ? qb[2] : qb[3];
                  *(f32x2v_t*)(sgp + ((size_t)(row0 + ai * HALF + fq * 16) * 16 + (pn - 28) * 4 + wc) * 2) = pr; } }
            return;
        }
        if (pn >= 44) {
            const int sec = (pn - 44) >> 3, wcol = ((pn - 44) & 7) * BM + wc * 32 + 8 * (fq & ~1) + HALF * (fq & 1);
            f32x4 bb[2][2];
#pragma unroll
            for (int bj = 0; bj < 2; ++bj) { const float* bp = bgate + (pn * BM - C_GL) + bj * HALF + cl; bb[bj][0] = *(const f32x4*)bp * (-LOG2E) - 7.994353436858858f; bb[bj][1] = *(const f32x4*)(bp + 4) * (-LOG2E) - 7.994353436858858f; }
#pragma unroll
            for (int ai = 0; ai < 2; ++ai)
#pragma unroll
                for (int m = 0; m < 4; ++m) { const int row = row0 + ai * HALF + m * 16; const float ce = -LOG2E * rstd[ai * HALF + wr * 64 + m * 16 + fr];
                    unsigned pk[2][2];
#pragma unroll
                    for (int bj = 0; bj < 2; ++bj) { const f32x4 b0 = bb[bj][0], b1 = bb[bj][1];
                        unsigned lo = 0u, hi = 0u;
#pragma unroll
                        for (int j = 0; j < 4; ++j) { const float g0 = __builtin_amdgcn_rcpf((1.0f / 255.0f) + __builtin_amdgcn_exp2f(acc[ai][bj][m][0][j] * ce + b0[j])), g1 = __builtin_amdgcn_rcpf((1.0f / 255.0f) + __builtin_amdgcn_exp2f(acc[ai][bj][m][1][j] * ce + b1[j]));
                            lo = __builtin_amdgcn_cvt_pk_u8_f32(fmaxf(g0, 1.0f), j, lo); hi = __builtin_amdgcn_cvt_pk_u8_f32(fmaxf(g1, 1.0f), j, hi); }
                        pk[bj][0] = lo; pk[bj][1] = hi; }
                    u32x4 w; w.x = pk[0][0]; w.y = pk[0][1]; w.z = pk[1][0]; w.w = pk[1][1];
                    *(u32x4*)(g8 + g8_chunk(sec, u.pm, (pn - 44) & 7, ai, wr, m, wc) + (fq * 16 + fr) * 16) = w; (void)row; }
            return;
        }
        const int mode = pn < 16 ? 0 : pn < 24 ? 1 : pn < 28 ? 2 : pn < 32 ? 3 : pn < 36 ? 4 : 0;
        const float qs = 0.08838834764831845f * LOG2E;
#pragma unroll
        for (int ai = 0; ai < 2; ++ai)
#pragma unroll
            for (int m = 0; m < 4; ++m) { const int row = row0 + ai * HALF + m * 16; bf16_t* zp = Z + (size_t)row * DIN + pn * BM + cl; const float rs = rstd[ai * HALF + wr * 64 + m * 16 + fr];
#pragma unroll
                for (int bj = 0; bj < 2; ++bj) { f32x4 v0 = acc[ai][bj][m][0] * rs, v1 = acc[ai][bj][m][1] * rs;
                    if (mode == 1) { const float ce = -LOG2E * rs;
#pragma unroll
                        for (int j = 0; j < 4; ++j) { v0[j] = v0[j] * __builtin_amdgcn_rcpf(1.0f + __builtin_amdgcn_exp2f(acc[ai][bj][m][0][j] * ce)); v1[j] = v1[j] * __builtin_amdgcn_rcpf(1.0f + __builtin_amdgcn_exp2f(acc[ai][bj][m][1][j] * ce)); } }
                    else if (mode == 2 || mode == 3) {
#pragma unroll
                        for (int j = 0; j < 4; ++j) { v0[j] = gelu_tanh_f(v0[j]); v1[j] = gelu_tanh_f(v1[j]); } }
                    else if (mode == 4) { v0 = v0 * qs; v1 = v1 * qs; }
                    u32x4 w; w.x = cvt_pk_bf16(v0[0], v0[1]); w.y = cvt_pk_bf16(v0[2], v0[3]); w.z = cvt_pk_bf16(v1[0], v1[1]); w.w = cvt_pk_bf16(v1[2], v1[3]);
                    if (pn >= 16 && pn < 28) *(u32x4*)((unsigned char*)Z + (WS_RS - WS_Z) + a_tiled_off(row, (pn - 16) * BM + cl + bj * HALF, 3072)) = w;
                    else *(u32x4*)(zp + bj * HALF) = w;
                     }
 }
    }
};
}

__device__ __forceinline__ float wave_sum(float v) {
#pragma unroll
    for (int o = 1; o < 64; o <<= 1) v += __shfl_xor(v, o);
    return v;
}
__device__ __forceinline__ void transpose_item(const float* W, int N, bf16* WT, int ldk, int koff, int drow0, LAS float* scr, int k0, int n0, int lane, const float* gain) {
#pragma unroll 8
    for (int i = 0; i < 32; ++i) { const int kk = 2 * i + (lane >> 5); scr[kk * 33 + (lane & 31)] = W[(size_t)(k0 + kk) * N + n0 + (lane & 31)]; }
    const int c = lane & 7;
    f32x4 g0 = (f32x4){1.f, 1.f, 1.f, 1.f}, g1 = g0;
    if (gain) { g0 = *(const f32x4*)(gain + k0 + 8 * c); g1 = *(const f32x4*)(gain + k0 + 8 * c + 4); }
    LDS_WAIT(); asm volatile("" ::: "memory");
#pragma unroll
    for (int j = 0; j < 4; ++j) { const int n = (lane >> 3) + 8 * j; const LAS float* s = scr + (8 * c) * 33 + n;
        v4u o; o.x = pk2(s[0 * 33] * g0[0], s[1 * 33] * g0[1]); o.y = pk2(s[2 * 33] * g0[2], s[3 * 33] * g0[3]); o.z = pk2(s[4 * 33] * g1[0], s[5 * 33] * g1[1]); o.w = pk2(s[6 * 33] * g1[2], s[7 * 33] * g1[3]);
#if PG8_BTILED
        *(v4u*)((unsigned char*)WT + pg8::w_tiled_off(drow0 + n, koff + k0 + 8 * c, ldk)) = o; }
#else
        *(v4u*)(WT + (size_t)(drow0 + n) * ldk + koff + k0 + 8 * c) = o; }
#endif
    LDS_WAIT(); asm volatile("" ::: "memory");
}
struct ConvMat { const float* W; bf16* WT; int K, N, ldk, koff, gu; const float* gain; };
__device__ __forceinline__ void conv_matrix(const ConvMat& c, LAS float* scr, int gw, int NGW, int lane) {
    const int nn = c.N / 32, items = (c.K / 64) * nn;
    for (int it = gw; it < items; it += NGW) { const int kb = it / nn, nb = it - kb * nn, n0 = 32 * nb;
        const int drow0 = c.gu ? ((n0 >> 7) * 256 + (n0 & 127) + (c.gu - 1) * 128) : n0;
        transpose_item(c.W, c.N, c.WT, c.ldk, c.koff, drow0, scr, 64 * kb, n0, lane, c.gain); }
}
template <bool F32OUT>
__device__ __forceinline__ void rms_row(const bf16* X, int m, const float* gain, void* orow, int lane) {
    v4u v[4]; float s = 0.f;
#pragma unroll
    for (int j = 0; j < 4; ++j) { v[j] = *(const v4u*)((const unsigned char*)X + pg8::a_tiled_off(m, 8 * (lane + 64 * j), D));
        const float a0 = bf_lo(v[j].x), a1 = bf_hi(v[j].x), a2 = bf_lo(v[j].y), a3 = bf_hi(v[j].y), a4 = bf_lo(v[j].z), a5 = bf_hi(v[j].z), a6 = bf_lo(v[j].w), a7 = bf_hi(v[j].w);
        s += ((a0 * a0 + a1 * a1) + (a2 * a2 + a3 * a3)) + ((a4 * a4 + a5 * a5) + (a6 * a6 + a7 * a7)); }
    const float rstd = 1.0f / sqrtf(wave_sum(s) * (1.0f / D) + EPS);
#pragma unroll
    for (int j = 0; j < 4; ++j) { const float* gp = gain + (64 * j + lane) * 8; const f32x4 g0 = *(const f32x4*)gp, g1 = *(const f32x4*)(gp + 4);
        const f32x4 o0 = (f32x4){bf_lo(v[j].x), bf_hi(v[j].x), bf_lo(v[j].y), bf_hi(v[j].y)} * rstd * g0, o1 = (f32x4){bf_lo(v[j].z), bf_hi(v[j].z), bf_lo(v[j].w), bf_hi(v[j].w)} * rstd * g1;
        if (F32OUT) { float* op = (float*)orow + (64 * j + lane) * 8; *(f32x4*)op = o0; *(f32x4*)(op + 4) = o1; }
        else { v4u w; w.x = cvt_pk_bf16(o0[0], o0[1]); w.y = cvt_pk_bf16(o0[2], o0[3]); w.z = cvt_pk_bf16(o1[0], o1[1]); w.w = cvt_pk_bf16(o1[2], o1[3]); ((v4u*)orow + lane)[64 * j] = w; } }
}
__device__ __forceinline__ void x_row_prep(const float* xrow, bf16* XR, int m, float* prow, int lane) {
    const f32x4* xr = (const f32x4*)xrow + lane; float s = 0.f;
#pragma unroll
    for (int j = 0; j < 8; ++j) { const f32x4 v = xr[64 * j]; v2u w; w.x = cvt_pk_bf16(v.x, v.y); w.y = cvt_pk_bf16(v.z, v.w); *(v2u*)((unsigned char*)XR + pg8::a_tiled_off(m, 4 * (lane + 64 * j), D)) = w;
        const float a0 = bf_lo(w.x), a1 = bf_hi(w.x), a2 = bf_lo(w.y), a3 = bf_hi(w.y); s += (a0 * a0 + a1 * a1) + (a2 * a2 + a3 * a3); }
    s = wave_sum(s);
    if (lane < 32) prow[lane] = lane == 0 ? s : 0.f;
}
__device__ __forceinline__ void panel_rstd(LAS float* tab, const float* part, int pm, int tid) {
    const int row = tid >> 1, hf = tid & 1; const float* p = part + (size_t)(pm * 256 + row) * 32 + hf * 16;
    const f32x4 a = *(const f32x4*)p, b = *(const f32x4*)(p + 4), c = *(const f32x4*)(p + 8), d = *(const f32x4*)(p + 12);
    float s = (((a[0] + a[1]) + (a[2] + a[3])) + ((b[0] + b[1]) + (b[2] + b[3]))) + (((c[0] + c[1]) + (c[2] + c[3])) + ((d[0] + d[1]) + (d[2] + d[3])));
    s += __shfl_xor(s, 1);
    if (hf == 0) tab[row] = 1.0f / sqrtf(s * (1.0f / 2048.0f) + EPS);
}

#define MFMA16(a, b, c) __builtin_amdgcn_mfma_f32_16x16x32_bf16(a, b, c, 0, 0, 0)
__device__ __forceinline__ bf16x8 ldg16(const bf16* p) { return *(const bf16x8*)p; }
__device__ __forceinline__ s16x4 lds_tr(LAS unsigned char* p) { return __builtin_amdgcn_ds_read_tr16_b64_v4i16((LAS s16x4*)p); }
__device__ __forceinline__ bf16x8 cat8(s16x4 a, s16x4 b) { return (bf16x8){a[0], a[1], a[2], a[3], b[0], b[1], b[2], b[3]}; }
__device__ __forceinline__ bf16x8 pack8(f32x4 a, f32x4 b) { v4u w; w.x = cvt_pk_bf16(a[0], a[1]); w.y = cvt_pk_bf16(a[2], a[3]); w.z = cvt_pk_bf16(b[0], b[1]); w.w = cvt_pk_bf16(b[2], b[3]); return __builtin_bit_cast(bf16x8, w); }
__device__ __forceinline__ float head_gamma(int h) { return 1.0f - __builtin_amdgcn_exp2f(-5.0f - (float)h); }

constexpr int SG_VSTRIDE = 544;
__device__ __forceinline__ void sgu_unit(LAS unsigned char* lds, const bf16* Z, const float* SGP, bf16* ACAT, const bf16* WC, const float* lng, const float* lnb, const float* sgb, int uid, int w, int lane_in) {
    int lane = lane_in; asm volatile("" : "+v"(lane)); const int tid = w * 64 + lane;
    const int b = uid >> 8, n = (uid >> 2) & 63, gq = uid & 3, row0 = b * T + n * 128;
    const int fr = lane & 15, g = lane >> 4;
    LAS unsigned char* VN = lds; LAS float* ST = (LAS float*)(lds + 128 * SG_VSTRIDE);
    { const int r = lane >> 2, q = lane & 3; const float* pp = SGP + ((size_t)(row0 + 16 * w + r) * 16 + q * 4) * 2;
      const f32x4 a = *(const f32x4*)pp, c = *(const f32x4*)(pp + 4);
      float t1 = (a[0] + a[2]) + (c[0] + c[2]), t2 = (a[1] + a[3]) + (c[1] + c[3]);
      t1 += __shfl_xor(t1, 1); t2 += __shfl_xor(t2, 1); t1 += __shfl_xor(t1, 2); t2 += __shfl_xor(t2, 2);
      if (q == 0) { const int row = 16 * w + r; const float mean = t1 * (1.0f / 1024.0f), var = fmaxf(t2 * (1.0f / 1024.0f) - mean * mean, 0.f); ST[row * 2] = mean; ST[row * 2 + 1] = 1.0f / sqrtf(var + EPS); } }
    LDS_WAIT(); __syncthreads();
    const int c8 = (tid & 31) * 8;
    const f32x4 g0 = *(const f32x4*)(lng + gq * 256 + c8), g1 = *(const f32x4*)(lng + gq * 256 + c8 + 4), b0 = *(const f32x4*)(lnb + gq * 256 + c8), b1 = *(const f32x4*)(lnb + gq * 256 + c8 + 4);
#pragma unroll
    for (int it = 0; it < 8; ++it) { const int p = tid + 512 * it, row = p >> 5;
        const v4u x = *(const v4u*)(Z + (size_t)(row0 + row) * DIN + C_SV + gq * 256 + c8);
        const float mean = ST[row * 2], rstd = ST[row * 2 + 1];
        v4u o;
        o.x = cvt_pk_bf16((bf_lo(x.x) - mean) * rstd * g0[0] + b0[0], (bf_hi(x.x) - mean) * rstd * g0[1] + b0[1]);
        o.y = cvt_pk_bf16((bf_lo(x.y) - mean) * rstd * g0[2] + b0[2], (bf_hi(x.y) - mean) * rstd * g0[3] + b0[3]);
        o.z = cvt_pk_bf16((bf_lo(x.z) - mean) * rstd * g1[0] + b1[0], (bf_hi(x.z) - mean) * rstd * g1[1] + b1[1]);
        o.w = cvt_pk_bf16((bf_lo(x.w) - mean) * rstd * g1[2] + b1[2], (bf_hi(x.w) - mean) * rstd * g1[3] + b1[3]);
        *(LAS v4u*)(VN + row * SG_VSTRIDE + c8 * 2) = o; }
    bf16x8 wf[4];
#pragma unroll
    for (int ks = 0; ks < 4; ++ks) wf[ks] = ldg16(WC + (size_t)(gq * 128 + 16 * w + fr) * 128 + ks * 32 + 8 * g);
    LDS_WAIT(); __syncthreads();
    const int row = row0 + 16 * w + fr; const float bias = sgb[gq * 128 + 16 * w + fr];
    const int oc0 = 2048 + gq * 256 + wide_col(g);
    LAS unsigned char* vb = VN + (8 * g + (fr >> 2)) * SG_VSTRIDE + (fr & 3) * 8;
#pragma unroll
    for (int cp = 0; cp < 8; ++cp) { f32x4 a[2];
#pragma unroll
        for (int c2 = 0; c2 < 2; ++c2) { const int ct = 2 * cp + c2; f32x4 t = (f32x4){0.f, 0.f, 0.f, 0.f};
#pragma unroll
            for (int ks = 0; ks < 4; ++ks) { const bf16x8 af = cat8(lds_tr(vb + (32 * ks) * SG_VSTRIDE + ct * 32), lds_tr(vb + (32 * ks + 4) * SG_VSTRIDE + ct * 32)); t = MFMA16(af, wf[ks], t); }
            a[c2] = t; }
#pragma unroll
        for (int r = 0; r < 4; ++r) SWAP16F(a[0][r], a[1][r]);
        const v4u su = *(const v4u*)((const unsigned char*)Z + (WS_RS - WS_Z) + pg8::a_tiled_off(row, oc0 + 32 * cp, 3072));
        v4u o; o.x = cvt_pk_bf16(bf_lo(su.x) * (a[0][0] + bias), bf_hi(su.x) * (a[0][1] + bias)); o.y = cvt_pk_bf16(bf_lo(su.y) * (a[0][2] + bias), bf_hi(su.y) * (a[0][3] + bias));
        o.z = cvt_pk_bf16(bf_lo(su.z) * (a[1][0] + bias), bf_hi(su.z) * (a[1][1] + bias)); o.w = cvt_pk_bf16(bf_lo(su.w) * (a[1][2] + bias), bf_hi(su.w) * (a[1][3] + bias));
        *(v4u*)((unsigned char*)ACAT + pg8::a_tiled_off(row, oc0 + 32 * cp, KCAT)) = o; }
    __syncthreads();
}


constexpr int CS_KSTRIDE = 544, CS_VSTRIDE = 288, CS_VOFF = 128 * CS_KSTRIDE;
constexpr int CS_UNITS = 2 * 4 * 8 * 4;
__device__ __forceinline__ void cs_phase(LAS unsigned char* lds, const bf16* Z, bf16* SB, bf16* TB, int first, int stride, int w, int lane_in) {
    int lane = lane_in; asm volatile("" : "+v"(lane)); const int tid = w * 64 + lane;
    const int fr = lane & 15, g = lane >> 4;
    LAS unsigned char* KC = lds; LAS unsigned char* VC = lds + CS_VOFF;
    LAS unsigned char* ka = KC + (4 * g + (fr >> 2)) * CS_KSTRIDE + (32 * w) * 2 + (fr & 3) * 8;
    LAS unsigned char* va = VC + (4 * g + (fr >> 2)) * CS_VSTRIDE + (fr & 3) * 8;
    for (int u = first; u < CS_UNITS; u += stride) {
        const int eq = u & 3, grp = (u >> 2) & 7, bh = u >> 5, h = bh & 3;
        const float l2g = __builtin_log2f(head_gamma(h)), g127 = __builtin_amdgcn_exp2f(127.f * l2g), g128 = __builtin_amdgcn_exp2f(128.f * l2g);
        const bf16* zr0 = Z + (size_t)((bh >> 2) * T + grp * 1024) * DIN;
        v4u kreg[8], vreg[4];
#define CS_LOAD(i_) do { const bf16* zr = zr0 + (size_t)((i_) * 128) * DIN; int tl_ = tid; asm volatile("" : "+v"(tl_));   \
        _Pragma("unroll") for (int it = 0; it < 8; ++it) { const int p = tl_ + 512 * it; kreg[it] = *(const v4u*)(zr + (size_t)(p >> 5) * DIN + C_RK + h * 256 + (p & 31) * 8); } \
        _Pragma("unroll") for (int it = 0; it < 4; ++it) { const int p = tl_ + 512 * it; vreg[it] = *(const v4u*)(zr + (size_t)(p >> 4) * DIN + C_RV + h * 512 + eq * 128 + (p & 15) * 8); } } while (0)
        CS_LOAD(0);
        f32x4 U[2][8];
#pragma unroll
        for (int i = 0; i < 2; ++i)
#pragma unroll
            for (int j = 0; j < 8; ++j) U[i][j] = (f32x4){0.f, 0.f, 0.f, 0.f};
#define CS_STORE(sp_) do { bf16* sp__ = (sp_); asm volatile("" : "+v"(sp__));   _Pragma("unroll") for (int j = 0; j < 8; ++j) { const f32x4 r0 = U[0][j] * g127, r1 = U[1][j] * g127; \
        v4u o; o.x = cvt_pk_bf16(r0[0], r0[1]); o.y = cvt_pk_bf16(r0[2], r0[3]); o.z = cvt_pk_bf16(r1[0], r1[1]); o.w = cvt_pk_bf16(r1[2], r1[3]); SWAP16U(o.x, o.z); SWAP16U(o.y, o.w);   \
        *(v4u*)(sp__ + j * 16 * 256) = o; } } while (0)
        bf16* sp0 = SB + ((size_t)((bh * 64 + grp * 8) * 512) + eq * 128 + fr) * 256 + 32 * w + wide_col(g);
#pragma unroll 1
        for (int ci = 0; ci < 8; ++ci) {
#pragma unroll
            for (int it = 0; it < 8; ++it) { const int p = tid + 512 * it; *(LAS v4u*)(KC + (p >> 5) * CS_KSTRIDE + (p & 31) * 16) = kreg[it]; }
#pragma unroll
            for (int it = 0; it < 4; ++it) { const int p = tid + 512 * it; *(LAS v4u*)(VC + (p >> 4) * CS_VSTRIDE + (p & 15) * 16) = vreg[it]; }
            LDS_WAIT(); __syncthreads();
            if (ci != 0) CS_STORE(sp0 + (size_t)ci * 512 * 256);
            if (ci < 7) CS_LOAD(ci + 1);
#pragma unroll
            for (int i = 0; i < 2; ++i)
#pragma unroll
                for (int j = 0; j < 8; ++j) U[i][j] = U[i][j] * g128;
#pragma unroll
            for (int ks = 0; ks < 4; ++ks) { bf16x8 af[2], bfv[8];
#pragma unroll
                for (int i = 0; i < 2; ++i) af[i] = cat8(lds_tr(ka + (32 * ks) * CS_KSTRIDE + i * 32), lds_tr(ka + (32 * ks + 16) * CS_KSTRIDE + i * 32));
#pragma unroll
                for (int j = 0; j < 8; ++j) bfv[j] = cat8(lds_tr(va + (32 * ks) * CS_VSTRIDE + j * 32), lds_tr(va + (32 * ks + 16) * CS_VSTRIDE + j * 32));
#pragma unroll
                for (int i = 0; i < 2; ++i)
#pragma unroll
                    for (int j = 0; j < 8; ++j) U[i][j] = MFMA16(af[i], bfv[j], U[i][j]); }
            __syncthreads();
        }
        CS_STORE(TB + ((size_t)((bh * 8 + grp) * 512) + eq * 128 + fr) * 256 + 32 * w + wide_col(g));
#undef CS_LOAD
#undef CS_STORE
    }
}

__device__ __forceinline__ void prefix2_phase(bf16* TB, int gt, int NGT) {
    for (int idx = gt; idx < 8 * 512 * 32; idx += NGT) {
        const int bh = idx >> 14, h = bh & 3; const float g1024 = __builtin_amdgcn_exp2f(1024.f * __builtin_log2f(head_gamma(h)));
        bf16* p = TB + (size_t)bh * 8 * 512 * 256 + (size_t)(idx & 16383) * 8;
        v4u s[8];
#pragma unroll
        for (int k = 0; k < 7; ++k) s[k] = *(const v4u*)(p + (size_t)k * 512 * 256);
        float r[8]; float z0 = 0.f; asm volatile("" : "+v"(z0));
#pragma unroll
        for (int k = 0; k < 8; ++k) r[k] = z0;
#pragma unroll
        for (int k = 0; k < 8; ++k) { v4u o; o.x = cvt_pk_bf16(r[0], r[1]); o.y = cvt_pk_bf16(r[2], r[3]); o.z = cvt_pk_bf16(r[4], r[5]); o.w = cvt_pk_bf16(r[6], r[7]);
            *(v4u*)(p + (size_t)k * 512 * 256) = o;
            if (k < 7) { r[0] = r[0] * g1024 + bf_lo(s[k].x); r[1] = r[1] * g1024 + bf_hi(s[k].x); r[2] = r[2] * g1024 + bf_lo(s[k].y); r[3] = r[3] * g1024 + bf_hi(s[k].y);
                         r[4] = r[4] * g1024 + bf_lo(s[k].z); r[5] = r[5] * g1024 + bf_hi(s[k].z); r[6] = r[6] * g1024 + bf_lo(s[k].w); r[7] = r[7] * g1024 + bf_hi(s[k].w); } }
    }
}

constexpr int AT_STRIDE = 288, AT_SLOT = 128 * AT_STRIDE, AT_VOFF = 2 * AT_SLOT, AT_BOFF = 4 * AT_SLOT;
#define AT_LOADBLK(sbk_) do { _Pragma("unroll") for (int it = 0; it < 4; ++it) { const int p = tid + 512 * it; const bf16* zr = zb + (size_t)(((((sbk_) * 128) + (p >> 4)) << dsh) + rr) * DIN + (p & 15) * 8; \
        kreg[it] = *(const v4u*)(zr + C_AK); vreg[it] = *(const v4u*)(zr + C_AV); } } while (0)
#define AT_WRITEBLK(slot_) do { _Pragma("unroll") for (int it = 0; it < 4; ++it) { const int p = tid + 512 * it; const int o = (slot_) * AT_SLOT + (p >> 4) * AT_STRIDE + (p & 15) * 16; \
        *(LAS v4u*)(lds + o) = kreg[it]; *(LAS v4u*)(lds + AT_VOFF + o) = vreg[it]; } } while (0)
struct AtPend { v4u o[4]; float lse; int rowq; };
#define AT_FLUSH_PLAIN(P_) do { bf16* op_ = OP + ((size_t)cfg * M + (P_).rowq) * 1024 + h * 128 + wide_col(g); _Pragma("unroll") for (int mq = 0; mq < 4; ++mq) *(v4u*)(op_ + 32 * mq) = (P_).o[mq]; \
        if (g == 0) LSE[(((size_t)(P_).rowq) * 8 + h) * 2 + cfg] = (P_).lse; } while (0)
#define AT_FLUSH_MERGE(P_) do { const size_t ro_ = (size_t)(P_).rowq; const pg8::f32x2v_t l01_ = *(const pg8::f32x2v_t*)(LSE + (ro_ * 8 + h) * 2); const float l0 = l01_[0], l1 = l01_[1], l2 = (P_).lse; \
        const float mx_ = fmaxf(l0, fmaxf(l1, l2)); float w0 = __builtin_amdgcn_exp2f(l0 - mx_), w1 = __builtin_amdgcn_exp2f(l1 - mx_), w2 = __builtin_amdgcn_exp2f(l2 - mx_); \
        const float rs_ = 1.0f / (w0 + w1 + w2); w0 *= rs_; w1 *= rs_; w2 *= rs_; \
        const bf16* p0_ = OP + ro_ * 1024 + h * 128 + wide_col(g); const bf16* p1_ = p0_ + (size_t)M * 1024; const int oc0_ = 3072 + h * 128 + wide_col(g); \
        v4u a_[4], b_[4]; _Pragma("unroll") for (int mq = 0; mq < 4; ++mq) { a_[mq] = *(const v4u*)(p0_ + 32 * mq); b_[mq] = *(const v4u*)(p1_ + 32 * mq); } \
        _Pragma("unroll") for (int mq = 0; mq < 4; ++mq) { const v4u a = a_[mq], b = b_[mq], c = (P_).o[mq]; v4u r; \
            r.x = cvt_pk_bf16(w0 * bf_lo(a.x) + w1 * bf_lo(b.x) + w2 * bf_lo(c.x), w0 * bf_hi(a.x) + w1 * bf_hi(b.x) + w2 * bf_hi(c.x)); \
            r.y = cvt_pk_bf16(w0 * bf_lo(a.y) + w1 * bf_lo(b.y) + w2 * bf_lo(c.y), w0 * bf_hi(a.y) + w1 * bf_hi(b.y) + w2 * bf_hi(c.y)); \
            r.z = cvt_pk_bf16(w0 * bf_lo(a.z) + w1 * bf_lo(b.z) + w2 * bf_lo(c.z), w0 * bf_hi(a.z) + w1 * bf_hi(b.z) + w2 * bf_hi(c.z)); \
            r.w = cvt_pk_bf16(w0 * bf_lo(a.w) + w1 * bf_lo(b.w) + w2 * bf_lo(c.w), w0 * bf_hi(a.w) + w1 * bf_hi(b.w) + w2 * bf_hi(c.w)); \
            *(v4u*)((unsigned char*)ACATO + pg8::a_tiled_off((int)ro_, oc0_ + 32 * mq, KCAT)) = r; } } while (0)
#define AT_FLUSH(P_) do { if constexpr (FUSE) AT_FLUSH_MERGE(P_); else AT_FLUSH_PLAIN(P_); } while (0)
template <int PAR, bool FUSE>
__device__ __forceinline__ void attn_unit(LAS unsigned char* lds, const bf16* Z, const bf16* zb, bf16* OP, float* LSE, bf16* ACATO, v4u (&kreg)[4], v4u (&vreg)[4], AtPend& pend, bool have_pend, int cfg, int b, int h, int dsh, int rr, int sb, bool has_next, int w, int tid, int fr, int g) {
    LAS float* BL = (LAS float*)(lds + AT_BOFF);
    if (have_pend) AT_FLUSH(pend);
    const int rowq = b * T + ((sb * 128 + 16 * w + fr) << dsh) + rr;
    bf16x8 qf[4];
#pragma unroll
    for (int ks = 0; ks < 4; ++ks) qf[ks] = ldg16(Z + (size_t)rowq * DIN + C_AQ + h * 128 + ks * 32 + 8 * g);
    if (has_next) AT_LOADBLK(sb + 1);
    int wv = 16 * w; asm volatile("" : "+v"(wv));
#define AT_ROWOFF(kt_) (((((wv + 16 * (kt_)) >> 7) ^ PAR ^ 1) & 1) * AT_SLOT + ((wv + 16 * (kt_)) & 127) * AT_STRIDE)
    f32x4 st[9];
#pragma unroll
    for (int kt = 0; kt < 9; ++kt) { LAS unsigned char* kp = lds + AT_ROWOFF(kt) + fr * AT_STRIDE + g * 16; f32x4 a = (f32x4){0.f, 0.f, 0.f, 0.f};
#pragma unroll
        for (int ks = 0; ks < 4; ++ks) a = MFMA16(*(LAS bf16x8*)(kp + ks * 64), qf[ks], a);
        st[kt] = a; }
    LAS float* blp = BL + (15 + 4 * g - fr);
#pragma unroll
    for (int kt = 0; kt < 9; ++kt)
#pragma unroll
        for (int r = 0; r < 4; ++r) st[kt][r] += blp[16 * kt + r];
    if (sb == 0) {
#pragma unroll
        for (int kt = 0; kt < 9; ++kt)
#pragma unroll
            for (int r = 0; r < 4; ++r) if (wv + 16 * kt + 4 * g + r < 128) st[kt][r] = -__builtin_inff(); }
    float mx = -__builtin_inff();
#pragma unroll
    for (int kt = 0; kt < 9; ++kt)
#pragma unroll
        for (int r = 0; r < 4; ++r) mx = fmaxf(mx, st[kt][r]);
    mx = xrow_max(mx);
    float den = 0.f;
#pragma unroll
    for (int kt = 0; kt < 9; ++kt)
#pragma unroll
        for (int r = 0; r < 4; ++r) { const float p = __builtin_amdgcn_exp2f(st[kt][r] - mx); st[kt][r] = p; den += p; }
    den = xrow_sum(den);
    bf16x8 pf[5];
#pragma unroll
    for (int kk = 0; kk < 4; ++kk) pf[kk] = pack8(st[2 * kk], st[2 * kk + 1]);
    pf[4] = pack8(st[8], (f32x4){0.f, 0.f, 0.f, 0.f});
    const float rden = 1.0f / den;
    LAS unsigned char* vb = lds + AT_VOFF + (4 * g + (fr >> 2)) * AT_STRIDE + (fr & 3) * 8;
#pragma unroll
    for (int mq = 0; mq < 4; ++mq) { v4u pk;
#pragma unroll
        for (int m2 = 0; m2 < 2; ++m2) { const int mt = 2 * mq + m2; f32x4 o = (f32x4){0.f, 0.f, 0.f, 0.f};
#pragma unroll
            for (int kk = 0; kk < 5; ++kk) { const int t0 = 2 * kk, t1 = (2 * kk + 1 > 8) ? 8 : 2 * kk + 1;
                const bf16x8 a = cat8(lds_tr(vb + AT_ROWOFF(t0) + mt * 32), lds_tr(vb + AT_ROWOFF(t1) + mt * 32));
                o = MFMA16(a, pf[kk], o); }
            const unsigned lo = cvt_pk_bf16(o[0] * rden, o[1] * rden), hi = cvt_pk_bf16(o[2] * rden, o[3] * rden);
            if (m2 == 0) { pk.x = lo; pk.y = hi; } else { pk.z = lo; pk.w = hi; } }
        SWAP16U(pk.x, pk.z); SWAP16U(pk.y, pk.w); pend.o[mq] = pk; }
    pend.lse = mx + __builtin_log2f(den); pend.rowq = rowq;
    __syncthreads();
    if (has_next) { AT_WRITEBLK(PAR ^ 1); LDS_WAIT(); __syncthreads(); }
#undef AT_ROWOFF
}
template <bool FUSE, int NUP>
__device__ __forceinline__ void attn_run(LAS unsigned char* lds, const bf16* Z, bf16* OP, float* LSE, bf16* ACATO, const float* BIAS, int item, int w, int lane_in) {
    int lane = lane_in; asm volatile("" : "+v"(lane)); const int tid = w * 64 + lane;
    constexpr int RB = (NUP == 2) ? 4 : 3;
    const int cfg = item >> (RB + 4), b = (item >> (RB + 3)) & 1, h = (item >> RB) & 7, run = item & ((1 << RB) - 1);
    const int dsh = 2 * cfg, rr = run & ((1 << dsh) - 1), sb0 = 2 * NUP * (run >> dsh);
    const int fr = lane & 15, g = lane >> 4;
    LAS float* BL = (LAS float*)(lds + AT_BOFF);
    const bf16* zb = Z + (size_t)(b * T) * DIN + h * 128;
    v4u kreg[4], vreg[4]; AtPend pend;
    if (sb0 > 0) { AT_LOADBLK(sb0 - 1); AT_WRITEBLK(1); }
    else {
#pragma unroll
        for (int it = 0; it < 4; ++it) { const int p = tid + 512 * it; const int o = AT_SLOT + (p >> 4) * AT_STRIDE + (p & 15) * 16; *(LAS v4u*)(lds + o) = (v4u){0u, 0u, 0u, 0u}; *(LAS v4u*)(lds + AT_VOFF + o) = (v4u){0u, 0u, 0u, 0u}; } }
    AT_LOADBLK(sb0);
    if (tid < 160) { const int dl = tid - 15; BL[tid] = (dl >= 0 && dl <= 128) ? BIAS[(cfg * 8 + h) * 132 + 128 - dl] : -__builtin_inff(); }
    AT_WRITEBLK(0);
    LDS_WAIT(); __syncthreads();
#pragma unroll 1
    for (int up = 0; up < NUP; ++up) {
        attn_unit<0, FUSE>(lds, Z, zb, OP, LSE, ACATO, kreg, vreg, pend, up != 0, cfg, b, h, dsh, rr, sb0 + 2 * up, true, w, tid, fr, g);
        attn_unit<1, FUSE>(lds, Z, zb, OP, LSE, ACATO, kreg, vreg, pend, true, cfg, b, h, dsh, rr, sb0 + 2 * up + 1, up != NUP - 1, w, tid, fr, g);
    }
    AT_FLUSH(pend);
}
#undef AT_LOADBLK
#undef AT_WRITEBLK
#undef AT_FLUSH
#undef AT_FLUSH_PLAIN
#undef AT_FLUSH_MERGE

constexpr int RO_KSTRIDE = 544, RO_VSTRIDE = 160, RO_VOFF = 64 * RO_KSTRIDE, RO_BUF = RO_VOFF + 128 * RO_VSTRIDE;
__device__ __forceinline__ void retout_unit(LAS unsigned char* lds, const bf16* Z, const bf16* RT, const bf16* TB, bf16* ACAT, int uid, int w, int lane_in) {
    int lane = lane_in; asm volatile("" : "+v"(lane)); const int tid = w * 64 + lane;
    const int b = uid >> 8, h = (uid >> 6) & 3, n = uid & 63, row0 = b * T + n * 128;
    const int fr = lane & 15, g = lane >> 4, rowq = row0 + 16 * w + fr;
    const float gamma = head_gamma(h);
    const bf16* vsrc = Z + (size_t)row0 * DIN + C_RV + h * 512;
    const bf16* rsrc = RT + (size_t)(((b * 4 + h) * 64 + n) * 512) * 256;
    const bf16* gsrc = TB + (size_t)(((b * 4 + h) * 8 + (n >> 3)) * 512) * 256;
    const float gw8 = __builtin_amdgcn_exp2f(128.f * (float)(n & 7) * __builtin_log2f(gamma));
    const bool hasr = (n & 7) != 0;
    const bool hasg = (n >> 3) != 0;
    v4u rreg[4], greg[4], vreg[2];
#define RO_LOAD(c_) do { int tl_ = tid; asm volatile("" : "+v"(tl_));   _Pragma("unroll") for (int it = 0; it < 4; ++it) { const int p = tl_ + 512 * it; const size_t o_ = (size_t)((c_) * 64 + (p >> 5)) * 256 + (p & 31) * 8; if (hasr) rreg[it] = *(const v4u*)(rsrc + o_); else rreg[it] = (v4u){0u, 0u, 0u, 0u}; if (hasg) greg[it] = *(const v4u*)(gsrc + o_); else greg[it] = (v4u){0u, 0u, 0u, 0u}; } \
        _Pragma("unroll") for (int it = 0; it < 2; ++it) { const int p = tl_ + 512 * it; vreg[it] = *(const v4u*)(vsrc + (size_t)(p >> 3) * DIN + (c_) * 64 + (p & 7) * 8); } } while (0)
#define RO_MIX(a_, b_) cvt_pk_bf16(bf_lo(a_) + gw8 * bf_lo(b_), bf_hi(a_) + gw8 * bf_hi(b_))
#define RO_WRITE(buf_) do { int tw_ = tid; asm volatile("" : "+v"(tw_)); _Pragma("unroll") for (int it = 0; it < 4; ++it) { const int p = tw_ + 512 * it; v4u m_; m_.x = RO_MIX(rreg[it].x, greg[it].x); m_.y = RO_MIX(rreg[it].y, greg[it].y); m_.z = RO_MIX(rreg[it].z, greg[it].z); m_.w = RO_MIX(rreg[it].w, greg[it].w); \
        *(LAS v4u*)(lds + (buf_) * RO_BUF + (p >> 5) * RO_KSTRIDE + (p & 31) * 16) = m_; } \
        _Pragma("unroll") for (int it = 0; it < 2; ++it) { const int p = tw_ + 512 * it; *(LAS v4u*)(lds + (buf_) * RO_BUF + RO_VOFF + (p >> 3) * RO_VSTRIDE + (p & 7) * 16) = vreg[it]; } } while (0)
    { v4u kreg[8];
#pragma unroll
      for (int it = 0; it < 8; ++it) { const int p = tid + 512 * it; kreg[it] = *(const v4u*)(Z + (size_t)(row0 + (p >> 5)) * DIN + C_RK + h * 256 + (p & 31) * 8); }
#pragma unroll
      for (int it = 0; it < 8; ++it) { const int p = tid + 512 * it; *(LAS v4u*)(lds + (p >> 5) * RO_KSTRIDE + (p & 31) * 16) = kreg[it]; } }
    bf16x8 qf[8];
#pragma unroll
    for (int ks = 0; ks < 8; ++ks) qf[ks] = ldg16(Z + (size_t)rowq * DIN + C_RQ + h * 256 + ks * 32 + 8 * g);
    LDS_WAIT(); __syncthreads();
    RO_LOAD(0);
    float z0 = 0.f; asm volatile("" : "+v"(z0)); const f32x4 zero4 = (f32x4){z0, z0, z0, z0};
    f32x4 st[8];
#pragma unroll
    for (int jt = 0; jt < 8; ++jt) { st[jt] = zero4;
        if (jt <= w) { LAS unsigned char* kp = lds + (16 * jt + fr) * RO_KSTRIDE + g * 16; f32x4 a = zero4;
#pragma unroll
            for (int ks = 0; ks < 8; ++ks) a = MFMA16(*(LAS bf16x8*)(kp + ks * 64), qf[ks], a);
            if (jt == w) {
#pragma unroll
                for (int r = 0; r < 4; ++r) if (4 * g + r > fr) a[r] = 0.f; }
            st[jt] = a; } }
    LAS unsigned char* pfp = lds + 2 * RO_BUF + w * 4096 + lane * 16;
#pragma unroll
    for (int kk = 0; kk < 4; ++kk) *(LAS bf16x8*)(pfp + kk * 1024) = pack8(st[2 * kk], st[2 * kk + 1]);
    __syncthreads();
    RO_WRITE(0); LDS_WAIT(); __syncthreads();
    f32x4 o[32];
    LAS unsigned char* ra = lds + fr * RO_KSTRIDE + g * 16;
    LAS unsigned char* va = lds + RO_VOFF + (4 * g + (fr >> 2)) * RO_VSTRIDE + (fr & 3) * 8;
#pragma unroll
    for (int c = 0; c < 8; ++c) {
        if (c < 7) RO_LOAD(c + 1);
#pragma unroll
        for (int e4 = 0; e4 < 4; ++e4) { f32x4 a = zero4;
#pragma unroll
            for (int ks = 0; ks < 8; ++ks) a = MFMA16(*(LAS bf16x8*)(ra + (c & 1) * RO_BUF + e4 * 16 * RO_KSTRIDE + ks * 64), qf[ks], a);
            a = a * gamma;
#pragma unroll
            for (int kk = 0; kk < 4; ++kk) if (2 * kk <= w) {
                const bf16x8 af = cat8(lds_tr(va + (c & 1) * RO_BUF + (32 * kk) * RO_VSTRIDE + e4 * 32), lds_tr(va + (c & 1) * RO_BUF + (32 * kk + 16) * RO_VSTRIDE + e4 * 32));
                a = MFMA16(af, *(LAS bf16x8*)(pfp + kk * 1024), a); }
            o[4 * c + e4] = a; }
        if (c < 7) RO_WRITE((c + 1) & 1);
        LDS_WAIT(); __syncthreads();
    }
    float ss = 0.f;
#pragma unroll
    for (int et = 0; et < 32; ++et) ss += (o[et][0] * o[et][0] + o[et][1] * o[et][1]) + (o[et][2] * o[et][2] + o[et][3] * o[et][3]);
    ss = xrow_sum(ss);
    const float rn = 1.0f / sqrtf(ss * (1.0f / 512.0f) + EPS);
    const int oc0 = h * 512 + wide_col(g);
#pragma unroll
    for (int ep = 0; ep < 16; ++ep) { f32x4 a = o[2 * ep], b = o[2 * ep + 1];
#pragma unroll
        for (int r = 0; r < 4; ++r) SWAP16F(a[r], b[r]);
        const v4u rg = *(const v4u*)((const unsigned char*)Z + (WS_RS - WS_Z) + pg8::a_tiled_off(rowq, oc0 + 32 * ep, 3072));
        v4u ov; ov.x = cvt_pk_bf16(bf_lo(rg.x) * a[0] * rn, bf_hi(rg.x) * a[1] * rn); ov.y = cvt_pk_bf16(bf_lo(rg.y) * a[2] * rn, bf_hi(rg.y) * a[3] * rn);
        ov.z = cvt_pk_bf16(bf_lo(rg.z) * b[0] * rn, bf_hi(rg.z) * b[1] * rn); ov.w = cvt_pk_bf16(bf_lo(rg.w) * b[2] * rn, bf_hi(rg.w) * b[3] * rn);
        *(v4u*)((unsigned char*)ACAT + pg8::a_tiled_off(rowq, oc0 + 32 * ep, KCAT)) = ov; }
#undef RO_LOAD
#undef RO_WRITE
#undef RO_MIX
}
#ifndef SUBDUP
#define SUBDUP 0
#endif
#ifndef SUB_MASK
#define SUB_MASK 7
#endif
#ifndef DUP_MASK
#define DUP_MASK 0u
#endif
#define DUPN(k_) (1 + (int)((DUP_MASK >> (k_)) & 1u))
#ifndef SITE_MASK
#define SITE_MASK 0xFFFFFFFFu
#endif
#ifndef STAG_TICKS
#define STAG_TICKS 0
#endif
#ifndef STAG_GROUP
#define STAG_GROUP(wg_) (((wg_) >> 6) & 3)
#endif
#define STAGGER() do { if (STAG_TICKS > 0) { const unsigned want_ = (unsigned)(STAG_GROUP(wg)) * (unsigned)(STAG_TICKS); if (want_) { const unsigned long long t0_ = __builtin_amdgcn_s_memrealtime(); \
        while ((unsigned)(__builtin_amdgcn_s_memrealtime() - t0_) < want_) __builtin_amdgcn_s_sleep(4); } } } while (0)

struct Params { const float* in[22]; float* out; unsigned char* ws; int ph_lo, ph_hi; };
typedef __attribute__((address_space(4))) const unsigned char* kargp_t;
typedef GAS unsigned char* g_u8p; typedef GAS float* g_f32p; typedef const GAS float* g_cf32p;
typedef __attribute__((address_space(4))) const g_u8p* kslot_u8; typedef __attribute__((address_space(4))) const g_f32p* kslot_f32; typedef __attribute__((address_space(4))) const g_cf32p* kslot_cf32;

__global__ void __launch_bounds__(NWAVES * 64, 2) fwd_kernel(Params P) {
    extern __shared__ __attribute__((aligned(16))) unsigned char lds_raw[];
    LAS unsigned char* lds = (LAS unsigned char*)lds_raw;
    const int wave = __builtin_amdgcn_readfirstlane((int)threadIdx.x >> 6);
    for (int u = threadIdx.x; u < (LDS_BYTES - LDSCTL_OFF) / 4; u += NWAVES * 64) ((LAS unsigned*)(lds + LDSCTL_OFF))[u] = 0u;
    __syncthreads();
#if MK_PER_PHASE
    XcdBarrier bar; bar.bar = nullptr; bar.x = 0; bar.st = nullptr;
#else
    XcdBarrier bar = xcd_barrier_post((unsigned*)(P.ws + WS_CTL) + CW_BAR, (volatile LAS unsigned*)(lds + MISC_OFF) + 8);
#endif
    const int lo = P.ph_lo, hi = P.ph_hi;
    int ph = 0, site = 0;
#define IN_PH(k_) (((SITE_MASK >> (k_)) & 1u) && lo <= ph && ph < hi)
#define PH_IDS() int lanep; asm volatile("v_mbcnt_lo_u32_b32 %0, -1, 0\n\tv_mbcnt_hi_u32_b32 %0, -1, %0" : "=v"(lanep)); const int tidp = wave * 64 + lanep; (void)tidp; \
    kargp_t ka_ = (kargp_t)__builtin_amdgcn_kernarg_segment_ptr(); asm volatile("" : "+s"(ka_)); \
    unsigned char* const ws = (unsigned char*)*(kslot_u8)(ka_ + 184); (void)ws; \
    int G = gridDim.x, wg = blockIdx.x; asm volatile("" : "+s"(G), "+s"(wg)); const int gw = wg * NWAVES + wave, NGW = G * NWAVES; (void)gw; (void)NGW
#define KIN(i) ((const float*)*(kslot_cf32)(ka_ + 8 * (i)))
#define KOUT() ((float*)*(kslot_f32)(ka_ + 176))
#if MK_PER_PHASE
#define END_PH() do { ++ph; } while (0)
#else
#define END_PH() do { ++ph; xcd_barrier(bar, wave); } while (0)
#endif
#define WSP(T_, off_) ((T_*)(ws + (off_)))
    (void)site;

    for (int l = 0; l < DEPTH; ++l) {
        if (IN_PH(0)) for (int rep_ = 0; rep_ < DUPN(0); ++rep_) { PH_IDS();
            LAS float* scr = (LAS float*)(lds + RING_OFF + wave * 16384);
            unsigned char* wb = ws + WS_W;
            const size_t oGU = (size_t)l * D * FF, oD = (size_t)l * FF * D;
            { ConvMat c{KIN(20) + oD, (bf16*)(wb + WO_D2), FF, D, FF, 0, 0, nullptr}; conv_matrix(c, scr, gw, NGW, lanep); }
            { ConvMat c{KIN(19) + oGU, (bf16*)(wb + WO_GU2), D, FF, D, 0, 2, KIN(17) + (size_t)l * D}; conv_matrix(c, scr, gw, NGW, lanep); }
            { ConvMat c{KIN(18) + oGU, (bf16*)(wb + WO_GU2), D, FF, D, 0, 1, KIN(17) + (size_t)l * D}; conv_matrix(c, scr, gw, NGW, lanep); }
            { ConvMat c{KIN(16) + (size_t)l * D * D, (bf16*)(wb + WO_OUT), D, D, D, 0, 0, nullptr}; conv_matrix(c, scr, gw, NGW, lanep); }
            { ConvMat c{KIN(15) + (size_t)l * 1024 * D, (bf16*)(wb + WO_CAT), 1024, D, KCAT, 3072, 0, nullptr}; conv_matrix(c, scr, gw, NGW, lanep); }
            { ConvMat c{KIN(14) + (size_t)l * 1024 * D, (bf16*)(wb + WO_CAT), 1024, D, KCAT, 2048, 0, nullptr}; conv_matrix(c, scr, gw, NGW, lanep); }
            { ConvMat c{KIN(13) + (size_t)l * 2048 * D, (bf16*)(wb + WO_CAT), 2048, D, KCAT, 0, 0, nullptr}; conv_matrix(c, scr, gw, NGW, lanep); }
            { ConvMat c{KIN(6) + (size_t)l * D * DIN, (bf16*)(wb + WO_IN), D, DIN, D, 0, 0, KIN(5) + (size_t)l * D}; conv_matrix(c, scr, gw, NGW, lanep); }
            { ConvMat c{KIN(4) + oD, (bf16*)(wb + WO_D1), FF, D, FF, 0, 0, nullptr}; conv_matrix(c, scr, gw, NGW, lanep); }
            { ConvMat c{KIN(3) + oGU, (bf16*)(wb + WO_GU1), D, FF, D, 0, 2, KIN(1) + (size_t)l * D}; conv_matrix(c, scr, gw, NGW, lanep); }
            { ConvMat c{KIN(2) + oGU, (bf16*)(wb + WO_GU1), D, FF, D, 0, 1, KIN(1) + (size_t)l * D}; conv_matrix(c, scr, gw, NGW, lanep); }
            const int gt = wg * (NWAVES * 64) + tidp, NGT = G * NWAVES * 64;
            { const float* sw = KIN(10) + (size_t)l * 4 * 128 * 128; bf16* WCb = WSP(bf16, WS_WC);
              for (int i = gt; i < 4 * 128 * 128; i += NGT) { const int s = i & 127, t = (i >> 7) & 127; WCb[i] = (bf16)(s <= t ? f2bf(sw[i]) : 0u); } }
            if (l == 0) {
                { const float* xin0 = KIN(0); bf16* XR = WSP(bf16, WS_X); float* PART = WSP(float, WS_PART); for (int m = gw; m < M; m += NGW) x_row_prep(xin0 + (size_t)m * D, XR, m, PART + (size_t)m * 32, lanep); }
                float* ROPE = WSP(float, WS_ROPE); float* BIAS = WSP(float, WS_BIAS); const float* relb = KIN(12);
                for (int fi = gt; fi < 128; fi += NGT) {
                    double inv = 1.0;
                    if (fi & 1) inv *= 0.930572040929699; if (fi & 2) inv *= 0.8659643233600654; if (fi & 4) inv *= 0.7498942093324559; if (fi & 8) inv *= 0.5623413251903491;
                    if (fi & 16) inv *= 0.31622776601683794; if (fi & 32) inv *= 0.1; if (fi & 64) inv *= 0.01;
                    ROPE[fi] = (float)(inv * 0.15915494309189535); }
                for (int i = gt; i < 3 * 8 * 132; i += NGT) { const int st = i % 132, hh = (i / 132) % 8, cfg = i / (132 * 8); float v = 0.f;
                    if (st <= 128) { const int dist = st << (2 * cfg); int bk;
                        if (dist < 16) bk = dist; else { bk = 16 + (int)(logf((float)dist / 16.0f) / 4.852030263919617f * 16.0f); bk = bk > 31 ? 31 : bk; }
                        v = relb[bk * 8 + hh] * LOG2E; }
                    BIAS[i] = v; }
            }
        }
        END_PH();
        for (int half = 0; half < 2; ++half) {
            if (IN_PH(2)) for (int rep_ = 0; rep_ < DUPN(2); ++rep_) { PH_IDS(); pg8::Gemm g{WSP(const bf16, WS_X), (const bf16*)(ws + WS_W + (half ? WO_GU2 : WO_GU1)), M, 2 * FF, D, 1}; pg8::StaticOrder S; S.init(M, 2 * FF, G, wg);
                { pg8::Unit u0; if (S.next(0, u0)) panel_rstd((LAS float*)(lds + RSTD_OFF), WSP(const float, WS_PART), u0.pm, tidp); LDS_WAIT(); __syncthreads(); }
                pg8::EpiGU E{WSP(bf16, WS_Z), (const LAS float*)(lds + RSTD_OFF)};
#if defined(CLK_PROBE)
                const unsigned long long t0_ = __builtin_amdgcn_s_memtime(), r0_ = __builtin_amdgcn_s_memrealtime();
#endif
                STAGGER();
                pg8::gemm_phase<pg8::EpiGU, pg8::StaticOrder, true, true>(lds + RING_OFF, g, S, E, wave);
#if defined(CLK_PROBE)
                if (l == 1 && half == 0 && wg == 5 && tidp == 0) { const unsigned long long t1_ = __builtin_amdgcn_s_memtime(), r1_ = __builtin_amdgcn_s_memrealtime();
                    unsigned* cw = WSP(unsigned, WS_CTL) + 64; cw[0] = (unsigned)(t1_ - t0_); cw[1] = (unsigned)(r1_ - r0_); }
#endif
                }
            END_PH();
            if (IN_PH(3)) for (int rep_ = 0; rep_ < DUPN(3); ++rep_) { PH_IDS(); pg8::Gemm g{WSP(const bf16, WS_Z), (const bf16*)(ws + WS_W + (half ? WO_D2 : WO_D1)), M, D, FF, 1}; pg8::StaticOrder S; S.init(M, D, G, wg, 4);
                pg8::EpiRes E{WSP(const bf16, WS_X), WSP(bf16, WS_X), WSP(float, WS_PART), 0.5f}; pg8::gemm_phase<pg8::EpiRes, pg8::StaticOrder, true, true>(lds + RING_OFF, g, S, E, wave); }
            END_PH();
            if (half == 0) {
                if (IN_PH(5)) for (int rep_ = 0; rep_ < DUPN(5); ++rep_) { PH_IDS(); pg8::Gemm g{WSP(const bf16, WS_X), (const bf16*)(ws + WS_W + WO_IN), M, DIN, D, 1}; pg8::StaticOrder S; S.init(M, DIN, G, wg, pg8::WGM, 1);
                    { pg8::Unit u0; if (S.next(0, u0)) panel_rstd((LAS float*)(lds + RSTD_OFF), WSP(const float, WS_PART), u0.pm, tidp); LDS_WAIT(); __syncthreads(); }
                    pg8::EpiWin E{WSP(bf16, WS_Z), KIN(7) + (size_t)l * 3 * D, WSP(const float, WS_ROPE), WSP(float, WS_SGP), WSP(unsigned char, WS_G8), (const LAS float*)(lds + RSTD_OFF)};
                    STAGGER();
                    pg8::gemm_phase<pg8::EpiWin, pg8::StaticOrder, true, true>(lds + RING_OFF, g, S, E, wave); }
                END_PH();
                if (IN_PH(6)) for (int rep_ = 0; rep_ < DUPN(6); ++rep_) { PH_IDS();
                    const int vcu = (G % 8 == 0) ? (wg % 8) * (G / 8) + wg / 8 : wg;
#if defined(MIX_ROT)
                    const int rot_ = (wg >> 3) % 3;
                    _Pragma("nounroll") for (int s_ = 0; s_ < 3; ++s_) { int k_ = s_ + rot_; k_ = k_ >= 3 ? k_ - 3 : k_; asm volatile("" : "+s"(k_));
                        if (k_ == 0) cs_phase(lds, WSP(const bf16, WS_Z), WSP(bf16, WS_RT), WSP(bf16, WS_TB), vcu, G, wave, lanep);
                        else if (k_ == 1) { PH_IDS(); const int vcu = (G % 8 == 0) ? (wg % 8) * (G / 8) + wg / 8 : wg; for (int it = vcu; it < 256; it += G) attn_run<false, 4>(lds, WSP(const bf16, WS_Z), WSP(bf16, WS_OPART), WSP(float, WS_LSE), (bf16*)nullptr, WSP(const float, WS_BIAS), it, wave, lanep); }
                        else { PH_IDS(); const int vcu = (G % 8 == 0) ? (wg % 8) * (G / 8) + wg / 8 : wg; for (int it = vcu; it < 512; it += G)
                            sgu_unit(lds, WSP(const bf16, WS_Z), WSP(const float, WS_SGP), WSP(bf16, WS_ACAT), WSP(const bf16, WS_WC), KIN(8) + (size_t)l * 1024, KIN(9) + (size_t)l * 1024, KIN(11) + (size_t)l * 512, it, wave, lanep); }
                        __syncthreads(); }
#else
                    if (SUB_MASK & 1) for (int r2_ = 0; r2_ < 1 + (SUBDUP & 1); ++r2_) cs_phase(lds, WSP(const bf16, WS_Z), WSP(bf16, WS_RT), WSP(bf16, WS_TB), vcu, G, wave, lanep);
                    if (SUB_MASK & 2) for (int r2_ = 0; r2_ < 1 + ((SUBDUP >> 1) & 1); ++r2_) { PH_IDS(); const int vcu = (G % 8 == 0) ? (wg % 8) * (G / 8) + wg / 8 : wg; for (int it = vcu; it < 256; it += G) attn_run<false, 4>(lds, WSP(const bf16, WS_Z), WSP(bf16, WS_OPART), WSP(float, WS_LSE), (bf16*)nullptr, WSP(const float, WS_BIAS), it, wave, lanep); }
                    if (SUB_MASK & 4) for (int r2_ = 0; r2_ < 1 + ((SUBDUP >> 2) & 1); ++r2_) { PH_IDS(); const int vcu = (G % 8 == 0) ? (wg % 8) * (G / 8) + wg / 8 : wg; for (int it = vcu; it < 512; it += G)
                        sgu_unit(lds, WSP(const bf16, WS_Z), WSP(const float, WS_SGP), WSP(bf16, WS_ACAT), WSP(const bf16, WS_WC), KIN(8) + (size_t)l * 1024, KIN(9) + (size_t)l * 1024, KIN(11) + (size_t)l * 512, it, wave, lanep); }
#endif
                }
                END_PH();
                if (IN_PH(11)) for (int rep_ = 0; rep_ < DUPN(11); ++rep_) { PH_IDS();
                    const int gt = wg * (NWAVES * 64) + tidp, NGT = G * NWAVES * 64;
                    if (rep_ == 0) prefix2_phase(WSP(bf16, WS_TB), gt, NGT);
                    { const int vcu = (G % 8 == 0) ? (wg % 8) * (G / 8) + wg / 8 : wg;
                      for (int it = 512 + vcu; it < 768; it += G) attn_run<true, 2>(lds, WSP(const bf16, WS_Z), WSP(bf16, WS_OPART), WSP(float, WS_LSE), WSP(bf16, WS_ACAT), WSP(const float, WS_BIAS), it, wave, lanep); }
                }
                END_PH();
                if (IN_PH(7)) for (int rep_ = 0; rep_ < DUPN(7); ++rep_) { PH_IDS();
                    for (int it = wg; it < 512; it += G) retout_unit(lds, WSP(const bf16, WS_Z), WSP(const bf16, WS_RT), WSP(const bf16, WS_TB), WSP(bf16, WS_ACAT), it, wave, lanep);
                }
                END_PH();
                if (IN_PH(8)) for (int rep_ = 0; rep_ < DUPN(8); ++rep_) { PH_IDS(); pg8::Gemm g{WSP(const bf16, WS_ACAT), (const bf16*)(ws + WS_W + WO_CAT), M, D, KCAT, 1}; pg8::StaticOrder S; S.init(M, D, G, wg, 4);
                    pg8::EpiProj E{WSP(const unsigned char, WS_G8), WSP(bf16, WS_MERGED)}; pg8::gemm_phase<pg8::EpiProj, pg8::StaticOrder, true, true>(lds + RING_OFF, g, S, E, wave); }
                END_PH();
                if (IN_PH(9)) for (int rep_ = 0; rep_ < DUPN(9); ++rep_) { PH_IDS(); pg8::Gemm g{WSP(const bf16, WS_MERGED), (const bf16*)(ws + WS_W + WO_OUT), M, D, D, 1}; pg8::StaticOrder S; S.init(M, D, G, wg, 4);
                    pg8::EpiRes E{WSP(const bf16, WS_X), WSP(bf16, WS_X), WSP(float, WS_PART), 1.0f}; pg8::gemm_phase<pg8::EpiRes, pg8::StaticOrder, true, true>(lds + RING_OFF, g, S, E, wave); }
                END_PH();
            }
        }
    }
    if (IN_PH(10)) for (int rep_ = 0; rep_ < DUPN(10); ++rep_) { PH_IDS(); const bf16* X = WSP(const bf16, WS_X); const float* gain = KIN(21); float* out = KOUT();
        for (int m = gw; m < M; m += NGW) rms_row<true>(X, m, gain, out + (size_t)m * D, lanep);
#if defined(CLK_PROBE)
        { asm volatile("s_waitcnt vmcnt(0)" ::: "memory"); const unsigned* cw = WSP(const unsigned, WS_CTL) + 64; const float cyc = (float)__hip_atomic_load(cw, __ATOMIC_RELAXED, __HIP_MEMORY_SCOPE_AGENT), rt = (float)__hip_atomic_load(cw + 1, __ATOMIC_RELAXED, __HIP_MEMORY_SCOPE_AGENT);
          const float V = (CLK_PROBE == 1) ? rintf(cyc / (11.f * 32.f) / 100.f) : rintf(10.f * cyc / rt); const float dv = sqrtf(V);
          for (int m = gw; m < M; m += NGW) for (int c = lanep; c < D; c += 64) out[(size_t)m * D + c] = dv; }
#endif
    }
#undef IN_PH
#undef END_PH
}
constexpr int N_PHASES = DEPTH * (1 + 2 + 6 + 2) + 1;

extern "C" void kernel_launch(void* const* d_in, const int* in_sizes, int n_in, void* d_out, int out_size, void* d_ws, size_t ws_size, hipStream_t stream) {
    static int grid = 0;
    if (grid == 0) {
        if (n_in != 22 || ws_size < WS_END) { fprintf(stderr, "kernel_launch: unexpected n_in %d / ws %zu\n", n_in, ws_size); grid = -1; return; }
        int dev = 0, cus = 0, per_cu = 0;
        if (hipGetDevice(&dev) != hipSuccess || hipDeviceGetAttribute(&cus, hipDeviceAttributeMultiprocessorCount, dev) != hipSuccess) { grid = -1; return; }
        if (hipFuncSetAttribute((const void*)fwd_kernel, hipFuncAttributeMaxDynamicSharedMemorySize, LDS_BYTES) != hipSuccess) { fprintf(stderr, "kernel_launch: hipFuncSetAttribute failed\n"); grid = -1; return; }
        if (hipOccupancyMaxActiveBlocksPerMultiprocessor(&per_cu, (const void*)fwd_kernel, NWAVES * 64, LDS_BYTES) != hipSuccess || per_cu < 1)
            fprintf(stderr, "kernel_launch: occupancy query reports %d workgroups per CU\n", per_cu);
        (void)hipGetLastError();
        grid = cus;
    }
    if (grid < 0) return;
    (void)hipMemsetAsync((char*)d_ws + WS_CTL, 0, CTL_ZERO_BYTES, stream);
    Params p{};
    for (int i = 0; i < 22; ++i) p.in[i] = (const float*)d_in[i];
    p.out = (float*)d_out; p.ws = (unsigned char*)d_ws;
#if MK_PER_PHASE
    for (int k = 0; k < N_PHASES; ++k) { p.ph_lo = k; p.ph_hi = k + 1; hipLaunchKernelGGL(fwd_kernel, dim3(grid), dim3(NWAVES * 64), LDS_BYTES, stream, p); }
#else
    p.ph_lo = 0; p.ph_hi = N_PHASES;
    hipLaunchKernelGGL(fwd_kernel, dim3(grid), dim3(NWAVES * 64), LDS_BYTES, stream, p);
#endif
}
```

```cpp
#include <hip/hip_runtime.h>
#include <cstdio>
#include <cstdint>

#ifndef MK_PER_PHASE
#define MK_PER_PHASE 0
#endif

namespace pg8 {
#define PG8_LAS __attribute__((address_space(3)))
#define PG8_GAS __attribute__((address_space(1)))
typedef unsigned short bf16_t;
typedef short bf16x8 __attribute__((ext_vector_type(8)));
typedef float f32x4 __attribute__((ext_vector_type(4)));
typedef unsigned u32x4 __attribute__((ext_vector_type(4)));
typedef unsigned u32x2 __attribute__((ext_vector_type(2)));
constexpr int BM = 256, BK = 64, HALF = 128, HTB = HALF * BK * 2  , STAGE_BYTES = 8 * HTB, NXCD = 8, WGM = 8;

__host__ __device__ __forceinline__ int lds_byte(int r, int c) { const int st = (r >> 4) * 2 + (c >> 5), rr = r & 15, cc = c & 31, ob = rr * 64 + cc * 2; return st * 1024 + (ob ^ (((ob >> 9) & 1) << 5)); }
__host__ __device__ __forceinline__ void stage_rc(int b, int& R, int& C) { const int st = b / 1024, sb = b % 1024, swz = sb ^ (((sb >> 9) & 1) << 5); R = (st >> 1) * 16 + swz / 64; C = (st & 1) * 32 + (swz % 64) / 2; }
#ifndef PG8_BTILED
#define PG8_BTILED 1
#endif
__host__ __device__ __forceinline__ int perm32inv(int q) { return (((q >> 2) & 1) << 4) | ((q >> 3) << 2) | (q & 3); }
__host__ __device__ __forceinline__ size_t w_tiled_off(int n, int k, int ldk) { const int rw = n & 127, R = (rw & ~31) + perm32inv(rw & 31);
    return ((size_t)(n >> 7) * (size_t)(ldk >> 6) + (size_t)(k >> 6)) * 16384u + (size_t)lds_byte(R, k & 63); }
__host__ __device__ __forceinline__ size_t a_tiled_off(int r, int c, int ld) { return ((size_t)(r >> 7) * (size_t)(ld >> 6) + (size_t)(c >> 6)) * 16384u + (size_t)lds_byte(r & 127, c & 63); }
__host__ __device__ __forceinline__ int perm32(int rho) { const int n = rho >> 4, i = rho & 15; return 8 * (i >> 2) + 4 * n + (i & 3); }

struct Unit { int pm, pn; };
struct Gemm { const bf16_t* A; const bf16_t* Bt; int M, N, K; int atiled; };

struct StaticOrder {
    int nM, nN, nwg, G, c, wgm, rev;
    __host__ __device__ void init(int M, int N, int G_, int c_, int wgm_ = WGM, int rev_ = 0) { nM = M / BM; nN = N / BM; nwg = nM * nN; G = G_; c = c_; wgm = wgm_; rev = rev_; }
    __host__ __device__ __forceinline__ bool next(int i, Unit& u) const {
        const long L = (long)i * G + c; if (L >= nwg) return false;
        int wgid = (int)L; { const int q = nwg / NXCD, r = nwg % NXCD, xcd = wgid % NXCD, off = wgid / NXCD; wgid = (xcd < r ? xcd * (q + 1) : r * (q + 1) + (xcd - r) * q) + off; }
        const int nig = wgm * nN, gid = wgid / nig, fm = gid * wgm, gsz = (nM - fm) < wgm ? (nM - fm) : wgm;
        u.pm = fm + ((wgid % nig) % gsz); u.pn = (wgid % nig) / gsz; if (rev) u.pn = nN - 1 - u.pn; return true;
    }
    __device__ __forceinline__ void a_ready(const Unit&) const {}
    __device__ __forceinline__ void done(const Unit&) const {}
};

typedef float f32x2v_t __attribute__((ext_vector_type(2))); typedef __bf16 bf16x2v_t __attribute__((ext_vector_type(2)));
__device__ __forceinline__ unsigned cvt_pk_bf16(float lo, float hi) { const f32x2v_t v = {lo, hi}; const bf16x2v_t b = __builtin_convertvector(v, bf16x2v_t); return __builtin_bit_cast(unsigned, b); }
#define SWAP16U(a_, b_) do { const auto t_ = __builtin_amdgcn_permlane16_swap((a_), (b_), false, false); (a_) = t_[0]; (b_) = t_[1]; } while (0)
#define SWAP16F(a_, b_) do { const auto t_ = __builtin_amdgcn_permlane16_swap(__float_as_uint(a_), __float_as_uint(b_), false, false); (a_) = __uint_as_float(t_[0]); (b_) = __uint_as_float(t_[1]); } while (0)
__device__ __forceinline__ float xrow_sum(float x) {
    const auto s = __builtin_amdgcn_permlane16_swap(__float_as_uint(x), __float_as_uint(x), false, false); x = __uint_as_float(s[0]) + __uint_as_float(s[1]);
    const auto t = __builtin_amdgcn_permlane32_swap(__float_as_uint(x), __float_as_uint(x), false, false); return __uint_as_float(t[0]) + __uint_as_float(t[1]); }
__device__ __forceinline__ float xrow_max(float x) {
    const auto s = __builtin_amdgcn_permlane16_swap(__float_as_uint(x), __float_as_uint(x), false, false); x = fmaxf(__uint_as_float(s[0]), __uint_as_float(s[1]));
    const auto t = __builtin_amdgcn_permlane32_swap(__float_as_uint(x), __float_as_uint(x), false, false); return fmaxf(__uint_as_float(t[0]), __uint_as_float(t[1])); }
__device__ __forceinline__ int wide_col(int g) { return 16 * (g & 1) + 4 * (g & 2); }
__device__ __forceinline__ float bf_lo(unsigned w) { return __uint_as_float(w << 16); }
__device__ __forceinline__ float bf_hi(unsigned w) { return __uint_as_float(w & 0xffff0000u); }
__device__ __forceinline__ float fast_sigmoid(float x) { return __builtin_amdgcn_rcpf(1.0f + __builtin_amdgcn_exp2f(-1.4426950408889634f * x)); }
__device__ __forceinline__ float silu_f(float x) { return x * fast_sigmoid(x); }
__device__ __forceinline__ float gelu_tanh_f(float x) { const float u = 0.7978845608028654f * (x + 0.044715f * x * x * x); return x * fast_sigmoid(2.0f * u); }

template <class Epi, class Sched, bool ALIGN_EPI = false, bool SP2 = false>
__device__ __forceinline__ void gemm_phase(PG8_LAS unsigned char* lds, const Gemm g, const Sched& S, const Epi& E, int wid) {
    int lane_; asm volatile("v_mbcnt_lo_u32_b32 %0, -1, 0\n\tv_mbcnt_hi_u32_b32 %0, -1, %0" : "=v"(lane_));
    const int lane = lane_, tid = wid * 64 + lane, wr = wid >> 2, wc = wid & 3, fr = lane & 15, fq = lane >> 4;
    const int K = g.K, nt = K / BK;
    unsigned voffA[2], voffB[2];
#pragma unroll
    for (int i = 0; i < 2; ++i) { int R, C; stage_rc(tid * 16 + i * 8192, R, C); const int Rb = Epi::PERM ? ((R & ~31) + perm32(R & 31)) : R;
        voffA[i] = g.atiled ? (unsigned)(tid * 16 + i * 8192) : (unsigned)(R * K + C) * 2u; voffB[i] = PG8_BTILED ? (unsigned)(tid * 16 + i * 8192) : (unsigned)(Rb * K + C) * 2u; }
    const size_t kstep = (size_t)(BK * 2);
    const size_t kstepB = PG8_BTILED ? (size_t)HTB : kstep;
    const size_t kstepA = g.atiled ? (size_t)HTB : kstep;
    const size_t hstep = (size_t)HALF * K * 2;
    const size_t tstep = 2 * hstep;
    const unsigned ldsw = (unsigned)wid * 1024u;
    const int aoff = lds_byte(wr * 64 + fr, fq * 8), boff = lds_byte(wc * 32 + fr, fq * 8);
#define PG8_SA(b, h) (((b) * 2 + (h)) * HTB)
#define PG8_SB(b, h) ((4 + (b) * 2 + (h)) * HTB)
#if defined(PG8_DMA_BUILTIN)
#define PG8_STAGE(bufoff, gbase, voff) do { _Pragma("unroll") for (int _i = 0; _i < 2; ++_i) \
        __builtin_amdgcn_global_load_lds((const PG8_GAS unsigned*)((gbase) + (voff)[_i]), (PG8_LAS unsigned*)(lds + (bufoff) + ldsw + _i * 8192), 16, 0, 0); } while (0)
#else
    const unsigned ldsa = (unsigned)__builtin_amdgcn_readfirstlane((int)((unsigned)(size_t)lds + ldsw));
#define PG8_STAGE(bufoff, gbase, voff) do { const gptr gb_ = (gbase); _Pragma("unroll") for (int _i = 0; _i < 2; ++_i) \
        asm volatile("s_mov_b32 m0, %0\n\ts_nop 0\n\tglobal_load_lds_dwordx4 %1, %2" :: "s"(ldsa + (unsigned)((bufoff) + _i * 8192)), "v"((voff)[_i]), "s"(gb_) : "memory"); } while (0)
#endif
#define PG8_LDA(dst, b, h) do { _Pragma("unroll") for (int m = 0; m < 4; ++m) _Pragma("unroll") for (int k = 0; k < 2; ++k) dst[m][k] = *(const PG8_LAS bf16x8*)(lds + PG8_SA(b, h) + aoff + m * 2048 + k * 1024); } while (0)
    PG8_LAS unsigned char* ldsB = lds + 4 * HTB + boff; asm volatile("" : "+v"(ldsB));
#define PG8_LDB(dst, b, h) do { _Pragma("unroll") for (int n = 0; n < 2; ++n) _Pragma("unroll") for (int k = 0; k < 2; ++k) dst[n][k] = *(const PG8_LAS bf16x8*)(ldsB + ((b) * 2 + (h)) * HTB + n * 2048 + k * 1024); } while (0)
#define PG8_MMA(ai, bj, At, Bt) do { __builtin_amdgcn_s_setprio(1); _Pragma("unroll") for (int m = 0; m < 4; ++m) _Pragma("unroll") for (int n = 0; n < 2; ++n) _Pragma("unroll") for (int k = 0; k < 2; ++k) \
        acc[ai][bj][m][n] = __builtin_amdgcn_mfma_f32_16x16x32_bf16(Bt[n][k], At[m][k], acc[ai][bj][m][n], 0, 0, 0); __builtin_amdgcn_s_setprio(0); } while (0)
#define PG8_WAIT_VL80 do { asm volatile("" ::: "memory"); __builtin_amdgcn_s_waitcnt(0x0078); asm volatile("" ::: "memory"); } while (0)
#define PG8_MMA2(ai, At, Bx, By) do { __builtin_amdgcn_s_setprio(1); _Pragma("unroll") for (int m = 0; m < 4; ++m) _Pragma("unroll") for (int n = 0; n < 2; ++n) _Pragma("unroll") for (int k = 0; k < 2; ++k) \
        acc[ai][0][m][n] = __builtin_amdgcn_mfma_f32_16x16x32_bf16(Bx[n][k], At[m][k], acc[ai][0][m][n], 0, 0, 0); \
        _Pragma("unroll") for (int m = 0; m < 4; ++m) _Pragma("unroll") for (int n = 0; n < 2; ++n) _Pragma("unroll") for (int k = 0; k < 2; ++k) \
        acc[ai][1][m][n] = __builtin_amdgcn_mfma_f32_16x16x32_bf16(By[n][k], At[m][k], acc[ai][1][m][n], 0, 0, 0); __builtin_amdgcn_s_setprio(0); } while (0)
#define PG8_WAIT_V(n) asm volatile("s_waitcnt vmcnt(" #n ")" ::: "memory")
#define PG8_WAIT_L(n) asm volatile("s_waitcnt lgkmcnt(" #n ")" ::: "memory")
#define PG8_BAR __builtin_amdgcn_s_barrier()
#define PG8_SCHED __builtin_amdgcn_sched_barrier(0)
    Unit cur, nxt; int ui = 0;
    if (!S.next(0, cur)) return;
    f32x4 acc[2][2][4][2];
#pragma unroll
    for (int a = 0; a < 2; ++a)
#pragma unroll
        for (int b = 0; b < 2; ++b)
#pragma unroll
            for (int m = 0; m < 4; ++m)
#pragma unroll
                for (int n = 0; n < 2; ++n) acc[a][b][m][n] = (f32x4){0.f, 0.f, 0.f, 0.f};
    bf16x8 At[4][2], B0[2][2], B1[2][2];
    typedef const PG8_GAS char* gptr;
    const gptr gA0 = (gptr)g.A, gB0 = (gptr)g.Bt;
    gptr cA = gA0 + (size_t)cur.pm * tstep; gptr cB = gB0 + (size_t)cur.pn * tstep;
    S.a_ready(cur);
    if constexpr (SP2) {
        PG8_STAGE(PG8_SB(0, 0), cB, voffB); PG8_STAGE(PG8_SB(0, 1), cB + hstep, voffB); PG8_STAGE(PG8_SA(0, 0), cA, voffA); PG8_STAGE(PG8_SA(0, 1), cA + hstep, voffA);
        if (wr == 1) PG8_BAR;
        PG8_WAIT_V(2); PG8_BAR;
        PG8_STAGE(PG8_SB(1, 0), cB + kstepB, voffB); PG8_STAGE(PG8_SA(1, 0), cA + kstepA, voffA); PG8_STAGE(PG8_SB(1, 1), cB + hstep + kstepB, voffB);
        PG8_WAIT_V(6); PG8_BAR;
    } else {
        PG8_STAGE(PG8_SB(0, 0), cB, voffB); PG8_STAGE(PG8_SA(0, 0), cA, voffA); PG8_STAGE(PG8_SB(0, 1), cB + hstep, voffB); PG8_STAGE(PG8_SA(0, 1), cA + hstep, voffA);
        if (wr == 1) PG8_BAR;
        PG8_WAIT_V(4); PG8_BAR;
        PG8_STAGE(PG8_SB(1, 0), cB + kstepB, voffB); PG8_STAGE(PG8_SA(1, 0), cA + kstepA, voffA); PG8_STAGE(PG8_SB(1, 1), cB + hstep + kstepB, voffB);
        PG8_WAIT_V(6); PG8_BAR;
    }
    for (;;) {
        const bool has_next = S.next(ui + 1, nxt);
        const gptr nA = has_next ? gA0 + (size_t)nxt.pm * tstep : cA; const gptr nB = has_next ? gB0 + (size_t)nxt.pn * tstep : cB;
        for (int t = 0; t < nt; t += 2) {
            const bool last = (t == nt - 2);
            const gptr a1 = cA + (size_t)(t + 1) * kstepA;
            const gptr a2 = last ? nA : cA + (size_t)(t + 2) * kstepA; const gptr b2 = last ? nB : cB + (size_t)(t + 2) * kstepB;
            const gptr a3 = a2 + kstepA; const gptr b3 = b2 + kstepB;
            if (last && has_next) S.a_ready(nxt);
            if constexpr (Epi::MID) { if (t == Epi::MID_T0 || t == Epi::MID_T1) E.mid(acc, cur, t, wr, wc, fr, fq); }
            if constexpr (SP2) {
            PG8_LDB(B0, 0, 0); PG8_LDB(B1, 0, 1); PG8_SCHED; PG8_LDA(At, 0, 0); PG8_STAGE(PG8_SA(1, 1), a1 + hstep, voffA);
            PG8_WAIT_VL80; PG8_BAR; PG8_MMA2(0, At, B0, B1); PG8_BAR; PG8_SCHED;
            PG8_LDA(At, 0, 1); PG8_STAGE(PG8_SB(0, 0), b2, voffB); PG8_STAGE(PG8_SB(0, 1), b2 + hstep, voffB); PG8_STAGE(PG8_SA(0, 0), a2, voffA);
            PG8_WAIT_VL80; PG8_BAR; PG8_MMA2(1, At, B0, B1); PG8_BAR; PG8_SCHED;
            PG8_LDB(B0, 1, 0); PG8_LDB(B1, 1, 1); PG8_SCHED; PG8_LDA(At, 1, 0); PG8_STAGE(PG8_SA(0, 1), a2 + hstep, voffA);
            PG8_WAIT_VL80; PG8_BAR; PG8_MMA2(0, At, B0, B1); PG8_BAR; PG8_SCHED;
            PG8_LDA(At, 1, 1); PG8_STAGE(PG8_SB(1, 0), b3, voffB); PG8_STAGE(PG8_SB(1, 1), b3 + hstep, voffB); PG8_STAGE(PG8_SA(1, 0), a3, voffA);
            PG8_WAIT_VL80; PG8_BAR; PG8_MMA2(1, At, B0, B1); PG8_BAR; PG8_SCHED;
            } else {
            PG8_LDB(B0, 0, 0); PG8_SCHED; PG8_LDA(At, 0, 0); PG8_STAGE(PG8_SA(1, 1), a1 + hstep, voffA);
            PG8_WAIT_L(8); PG8_BAR; PG8_WAIT_L(0); PG8_MMA(0, 0, At, B0); PG8_BAR; PG8_SCHED;
            PG8_LDB(B1, 0, 1); PG8_STAGE(PG8_SB(0, 0), b2, voffB);
            PG8_BAR; PG8_WAIT_L(0); PG8_MMA(0, 1, At, B1); PG8_BAR;
            PG8_LDA(At, 0, 1); PG8_STAGE(PG8_SA(0, 0), a2, voffA);
            PG8_BAR; PG8_WAIT_L(0); PG8_MMA(1, 0, At, B0); PG8_BAR; PG8_SCHED;
            PG8_STAGE(PG8_SB(0, 1), b2 + hstep, voffB);
            PG8_WAIT_V(6); PG8_BAR; PG8_MMA(1, 1, At, B1); PG8_BAR;
            PG8_LDB(B0, 1, 0); PG8_SCHED; PG8_LDA(At, 1, 0); PG8_STAGE(PG8_SA(0, 1), a2 + hstep, voffA);
            PG8_WAIT_L(8); PG8_BAR; PG8_WAIT_L(0); PG8_MMA(0, 0, At, B0); PG8_BAR; PG8_SCHED;
            PG8_LDB(B1, 1, 1); PG8_STAGE(PG8_SB(1, 0), b3, voffB);
            PG8_BAR; PG8_WAIT_L(0); PG8_MMA(0, 1, At, B1); PG8_BAR;
            PG8_LDA(At, 1, 1); PG8_STAGE(PG8_SA(1, 0), a3, voffA);
            PG8_BAR; PG8_WAIT_L(0); PG8_MMA(1, 0, At, B0); PG8_BAR; PG8_SCHED;
            PG8_STAGE(PG8_SB(1, 1), b3 + hstep, voffB);
            PG8_WAIT_V(6); PG8_BAR; PG8_MMA(1, 1, At, B1); PG8_BAR;
            }
        }
        if constexpr (ALIGN_EPI) { if (wr == 0) PG8_BAR; }
        E(acc, cur, wr, wc, fr, fq); S.done(cur);
#if defined(EPI_DUP)
        if constexpr (Epi::IDEMPOTENT) { asm volatile("" ::: "memory"); E(acc, cur, wr, wc, fr, fq); }
#endif
        if (!has_next) break;
#pragma unroll
        for (int a = 0; a < 2; ++a)
#pragma unroll
            for (int b = 0; b < 2; ++b)
#pragma unroll
                for (int m = 0; m < 4; ++m)
#pragma unroll
                    for (int n = 0; n < 2; ++n) acc[a][b][m][n] = (f32x4){0.f, 0.f, 0.f, 0.f};
        cur = nxt; cA = nA; cB = nB; ++ui;
        if constexpr (ALIGN_EPI) { if (wr == 1) PG8_BAR; }
    }
    PG8_WAIT_V(0);
    if constexpr (!ALIGN_EPI) { if (wr == 0) PG8_BAR; }
    PG8_BAR;
#undef PG8_SA
#undef PG8_SB
#undef PG8_STAGE
#undef PG8_LDA
#undef PG8_LDB
#undef PG8_MMA
#undef PG8_WAIT_V
#undef PG8_WAIT_L
#undef PG8_BAR
#undef PG8_SCHED
}
}

constexpr int BATCH = 2, T = 8192, M = BATCH * T, D = 2048, FF = 5632, DIN = 17408, DEPTH = 4;
constexpr int C_RQ = 0, C_RK = 1024, C_RV = 2048, C_RG = 4096, C_SU = 6144, C_SV = 7168, C_AQ = 8192, C_AK = 9216, C_AV = 10240, C_GL = 11264;
constexpr int KCAT = 4096;
constexpr float EPS = 1e-6f, LOG2E = 1.4426950408889634f;
constexpr int NWAVES = 8;

constexpr size_t MiB = 1u << 20;
constexpr size_t WS_CTL = 0, CTL_ZERO_BYTES = 64 * 1024;
constexpr size_t WS_SVSTAT = 1 * MiB;
constexpr size_t WS_BIAS = 2 * MiB;
constexpr size_t WS_WC = 3 * MiB;
constexpr size_t WS_LSE = 4 * MiB;
constexpr size_t WS_ROPE = 8 * MiB;
constexpr size_t WS_W = 16 * MiB;
constexpr size_t WO_GU1 = 0, WO_D1 = 44 * MiB, WO_IN = 66 * MiB, WO_CAT = 134 * MiB, WO_OUT = 150 * MiB, WO_GU2 = 158 * MiB, WO_D2 = 202 * MiB, W_BYTES = 224 * MiB;
constexpr size_t WS_X = 240 * MiB;
constexpr size_t WS_XB = 368 * MiB;
constexpr size_t WS_Z = 432 * MiB;
constexpr size_t WS_RT = 976 * MiB;
constexpr size_t WS_ACAT = 1104 * MiB;
constexpr size_t WS_OPART = 1232 * MiB;
constexpr size_t WS_MERGED = 1328 * MiB;
constexpr size_t WS_TB = 1392 * MiB;
constexpr size_t WS_SGP = 1408 * MiB;
constexpr size_t WS_G8 = 1410 * MiB;
constexpr size_t WS_RS = 1506 * MiB;
constexpr size_t WS_END = 1602 * MiB;
constexpr size_t WS_PART = 6 * MiB;
static_assert((size_t)11264 * 2048 * 2 == 44 * MiB && (size_t)2048 * 5632 * 2 == 22 * MiB && (size_t)17408 * 2048 * 2 == 68 * MiB && (size_t)2048 * 4096 * 2 == 16 * MiB, "weight map");
static_assert((size_t)M * DIN * 2 == 544 * MiB && (size_t)M * D * 4 == 128 * MiB, "activation map");
constexpr int CW_TMO = 0, CW_BAR = 4096;

constexpr int RING_OFF = 0, RING_BYTES = 155648;
constexpr int RSTD_OFF = 131072;
constexpr int LDSCTL_OFF = RING_BYTES, MISC_OFF = LDSCTL_OFF + 320;
constexpr int LDS_BYTES = 157696;

#define GAS __attribute__((address_space(1)))
#define LAS __attribute__((address_space(3)))
typedef unsigned short bf16;
typedef unsigned v4u __attribute__((ext_vector_type(4)));
typedef unsigned v2u __attribute__((ext_vector_type(2)));
typedef float f32x4 __attribute__((ext_vector_type(4)));
typedef short bf16x8 __attribute__((ext_vector_type(8)));
typedef short s16x4 __attribute__((ext_vector_type(4)));
typedef GAS unsigned gu32;
#define RLX_AGENT __ATOMIC_RELAXED, __HIP_MEMORY_SCOPE_AGENT
#define LDS_WAIT() asm volatile("s_waitcnt lgkmcnt(0)" ::: "memory")
#define VM_WAIT() asm volatile("s_waitcnt vmcnt(0)" ::: "memory")
__device__ __forceinline__ unsigned f2bf(float f) { unsigned u = __builtin_bit_cast(unsigned, f); return (u + 0x7fffu + ((u >> 16) & 1u)) >> 16; }
__device__ __forceinline__ unsigned pk2(float lo, float hi) { return f2bf(lo) | (f2bf(hi) << 16); }
using pg8::cvt_pk_bf16; using pg8::bf_lo; using pg8::bf_hi; using pg8::xrow_sum; using pg8::xrow_max; using pg8::wide_col;

#define XB_TMO      128
#define XB_XCNT(j)  (256  + 64 * (j))
#define XB_XSUB(j)  (1280 + 64 * (j))
#define XB_XGEN(j)  (2304 + 64 * (j))
#define XB_TOP      3328
#define XB_TOPGEN   3392
#define XCD_BAR_WORDS 3456
#define XB_SPIN_CAP (1u << 20)

__device__ __forceinline__ unsigned xb_ld(unsigned* p)              { return __hip_atomic_load(p, __ATOMIC_RELAXED, __HIP_MEMORY_SCOPE_AGENT); }
__device__ __forceinline__ unsigned xb_add(unsigned* p, unsigned v) { return __hip_atomic_fetch_add(p, v, __ATOMIC_RELAXED, __HIP_MEMORY_SCOPE_AGENT); }
__device__ __forceinline__ unsigned xb_xcc_id() { return (unsigned)__builtin_amdgcn_s_getreg((3 << 11) | 20) & 0xFu; }
#define XB_SPIN(cond, bar) do { unsigned _sp = 0; while (cond) { __builtin_amdgcn_s_sleep(1); \
    if ((++_sp & 255u) == 0u) { if (xb_ld(&(bar)[XB_TMO])) break; if (_sp > XB_SPIN_CAP) { atomicAdd(&(bar)[XB_TMO], 1u); break; } } } } while (0)

struct XcdBarrier { unsigned* bar; unsigned x; volatile LAS unsigned* st; };

__device__ __forceinline__ XcdBarrier xcd_barrier_post(unsigned* bar, volatile LAS unsigned* st) {
    XcdBarrier b; b.bar = bar; b.x = xb_xcc_id(); b.st = st;
    if (threadIdx.x == 0) (void)xb_add(&bar[XB_XCNT(b.x)], 1u);
    return b;
}
__device__ __forceinline__ void xcd_barrier_complete(unsigned* bar, unsigned x, unsigned& nloc, unsigned& nx) {
    const unsigned G = gridDim.x * gridDim.y * gridDim.z;
    unsigned sum, cnt, mine, sp = 0u;
    for (;;) {
        sum = 0u; cnt = 0u; mine = 0u;
#pragma unroll
        for (unsigned j = 0; j < 16; ++j) { const unsigned c = xb_ld(&bar[XB_XCNT(j)]); sum += c; cnt += (c > 0u) ? 1u : 0u; mine = (j == x) ? c : mine; }
        if (sum == G) break;
        __builtin_amdgcn_s_sleep(1);
        if ((++sp & 255u) == 0u) { if (xb_ld(&bar[XB_TMO])) break; if (sp > XB_SPIN_CAP) { atomicAdd(&bar[XB_TMO], 1u); break; } }
    }
    nloc = mine > 0u ? mine : 1u; nx = cnt > 0u ? cnt : 1u;
}
__device__ __forceinline__ void xcd_barrier(const XcdBarrier& b, int wave) {
    asm volatile("s_waitcnt vmcnt(0)" ::: "memory");
    __syncthreads();
    int lane0_; asm volatile("v_mbcnt_lo_u32_b32 %0, -1, 0\n\tv_mbcnt_hi_u32_b32 %0, -1, %0" : "=v"(lane0_));
    if (wave == 0 && lane0_ == 0) {
        unsigned* bar = b.bar;
        __builtin_amdgcn_s_waitcnt(0);
        unsigned nloc = b.st[0], nx = b.st[1];
        if (nloc == 0u) { xcd_barrier_complete(bar, b.x, nloc, nx); b.st[0] = nloc; b.st[1] = nx; }
        const unsigned old = xb_add(&bar[XB_XSUB(b.x)], 1u);
        const unsigned gen = old / nloc;
        if (old + 1u == (gen + 1u) * nloc) {
            __builtin_amdgcn_fence(__ATOMIC_RELEASE, "agent");
            asm volatile("s_waitcnt vmcnt(0)" ::: "memory");
            const unsigned og = xb_add(&bar[XB_TOP], 1u);
            const unsigned tg = og / nx;
            if (og + 1u == (tg + 1u) * nx) xb_add(&bar[XB_TOPGEN], 1u);
            else XB_SPIN(xb_ld(&bar[XB_TOPGEN]) == tg, bar);
            __builtin_amdgcn_fence(__ATOMIC_ACQUIRE, "agent");
            xb_add(&bar[XB_XGEN(b.x)], 1u);
            asm volatile("s_waitcnt vmcnt(0)" ::: "memory");
        } else {
            XB_SPIN(xb_ld(&bar[XB_XGEN(b.x)]) == gen, bar);
            __builtin_amdgcn_fence(__ATOMIC_ACQUIRE, "agent");
            asm volatile("s_waitcnt vmcnt(0)" ::: "memory");
        }
    }
    __syncthreads();
}

#ifndef EPI_DUP_SEL
#define EPI_DUP_SEL 0
#endif
namespace pg8 {

struct EpiGU {
    static constexpr bool PERM = true, MID = false, IDEMPOTENT = (EPI_DUP_SEL == 1); static constexpr int MID_T0 = -1, MID_T1 = -1;
    bf16_t* O; const PG8_LAS float* rstd;
    __device__ __forceinline__ void operator()(const f32x4 (&acc)[2][2][4][2], const Unit& u, int wr, int wc, int fr_, int fq_) const {
        int fr = fr_, fq = fq_; asm volatile("" : "+v"(fr), "+v"(fq));
        const int row0 = u.pm * BM + wr * 64 + fr, col0 = u.pn * HALF + wc * 32 + 8 * fq;
#pragma unroll
        for (int ai = 0; ai < 2; ++ai)
#pragma unroll
            for (int m = 0; m < 4; ++m) { bf16_t* rowp = (bf16_t*)((unsigned char*)O + a_tiled_off(row0 + ai * HALF + m * 16, col0, FF)); const float r = rstd[ai * HALF + wr * 64 + m * 16 + fr];
                const float ce = -LOG2E * r, r2 = r * r; const f32x4 ga = acc[ai][0][m][0], gb = acc[ai][0][m][1];
                f32x4 sa, sb;
#pragma unroll
                for (int j = 0; j < 4; ++j) { sa[j] = __builtin_amdgcn_rcpf(1.0f + __builtin_amdgcn_exp2f(ga[j] * ce)); sb[j] = __builtin_amdgcn_rcpf(1.0f + __builtin_amdgcn_exp2f(gb[j] * ce)); }
                const f32x4 oa = (ga * acc[ai][1][m][0]) * (sa * r2), ob = (gb * acc[ai][1][m][1]) * (sb * r2);
                u32x4 w; w.x = cvt_pk_bf16(oa[0], oa[1]); w.y = cvt_pk_bf16(oa[2], oa[3]); w.z = cvt_pk_bf16(ob[0], ob[1]); w.w = cvt_pk_bf16(ob[2], ob[3]);
#if defined(EPI_LANE_T)
                { const int ln = fq * 16 + fr, src4 = ((ln & 3) * 16 + (ln >> 2)) * 4;
                  u32x4 t; t.x = (unsigned)__builtin_amdgcn_ds_bpermute(src4, (int)w.x); t.y = (unsigned)__builtin_amdgcn_ds_bpermute(src4, (int)w.y); t.z = (unsigned)__builtin_amdgcn_ds_bpermute(src4, (int)w.z); t.w = (unsigned)__builtin_amdgcn_ds_bpermute(src4, (int)w.w);
                  bf16_t* rp2 = O + (size_t)(u.pm * BM + wr * 64 + (ln >> 2) + ai * HALF + m * 16) * FF + u.pn * HALF + wc * 32 + 8 * (ln & 3);
                  *(u32x4*)rp2 = t; }
#else
                *(u32x4*)rowp = w;
#endif
                }
    }
};
struct EpiRes {
    static constexpr bool PERM = true, MID = false, IDEMPOTENT = false; static constexpr int MID_T0 = -1, MID_T1 = -1;
    const bf16_t* Xin; bf16_t* Xout; float* part; float scale;
    __device__ __forceinline__ void operator()(const f32x4 (&acc)[2][2][4][2], const Unit& u, int wr, int wc, int fr_, int fq_) const {
        int fr = fr_, fq = fq_; asm volatile("" : "+v"(fr), "+v"(fq));
        const int row0 = u.pm * BM + wr * 64 + fr, col0 = u.pn * BM + wc * 32 + 8 * fq;
#pragma unroll
        for (int ai = 0; ai < 2; ++ai) { u32x4 bs[4][2];
#pragma unroll
            for (int m = 0; m < 4; ++m) {
#pragma unroll
                for (int bj = 0; bj < 2; ++bj) bs[m][bj] = *(const u32x4*)((const unsigned char*)Xin + a_tiled_off(row0 + ai * HALF + m * 16, col0 + bj * HALF, D)); }
            asm volatile("" ::: "memory");
            float sm[4];
#pragma unroll
            for (int m = 0; m < 4; ++m) { const int row = row0 + ai * HALF + m * 16; float ss = 0.f;
#pragma unroll
                for (int bj = 0; bj < 2; ++bj) { const u32x4 x = bs[m][bj]; const f32x4 a0 = acc[ai][bj][m][0] * scale, a1 = acc[ai][bj][m][1] * scale;
                    u32x4 w; w.x = cvt_pk_bf16(bf_lo(x.x) + a0[0], bf_hi(x.x) + a0[1]); w.y = cvt_pk_bf16(bf_lo(x.y) + a0[2], bf_hi(x.y) + a0[3]);
                    w.z = cvt_pk_bf16(bf_lo(x.z) + a1[0], bf_hi(x.z) + a1[1]); w.w = cvt_pk_bf16(bf_lo(x.w) + a1[2], bf_hi(x.w) + a1[3]);
                    *(u32x4*)((unsigned char*)Xout + a_tiled_off(row, col0 + bj * HALF, D)) = w;
                    { const float a0 = bf_lo(w.x), a1 = bf_hi(w.x), a2 = bf_lo(w.y), a3 = bf_hi(w.y), a4 = bf_lo(w.z), a5 = bf_hi(w.z), a6 = bf_lo(w.w), a7 = bf_hi(w.w);
                      ss += ((a0 * a0 + a1 * a1) + (a2 * a2 + a3 * a3)) + ((a4 * a4 + a5 * a5) + (a6 * a6 + a7 * a7)); } }
                sm[m] = xrow_sum(ss); }
            { const float sel = fq == 0 ? sm[0] : fq == 1 ? sm[1] : fq == 2 ? sm[2] : sm[3]; part[(size_t)(row0 + ai * HALF + fq * 16) * 32 + u.pn * 4 + wc] = sel; }
            asm volatile("" ::: "memory"); }
    }
};
__device__ __forceinline__ size_t g8_chunk(int sec, int pm, int tile, int ai, int wr, int m, int wc) { return ((size_t)((((((sec * 64 + pm) * 8 + tile) * 2 + ai) * 2 + wr) * 4 + m) * 4 + wc)) << 10; }
struct EpiProj {
    static constexpr bool PERM = true, MID = true, IDEMPOTENT = (EPI_DUP_SEL == 3); static constexpr int MID_T0 = 32, MID_T1 = 48;
    const unsigned char* G8; bf16_t* O;
#define PJ_BYTE(w_, k_) ((float)(((w_) >> (8 * (k_))) & 0xffu))
    __device__ __forceinline__ void mid(f32x4 (&acc)[2][2][4][2], const Unit& u, int t, int wr, int wc, int fr_, int fq_) const {
        int fr = fr_, fq = fq_; asm volatile("" : "+v"(fr), "+v"(fq));
        const int row0 = u.pm * BM + wr * 64 + fr, wcol = u.pn * BM + wc * 32 + 8 * (fq & ~1) + HALF * (fq & 1); const int sn = (t == MID_T0) ? 0 : 1; const int lo16 = (fq * 16 + fr) * 16; (void)row0; (void)wcol;
#pragma unroll
        for (int ai = 0; ai < 2; ++ai) { u32x4 ga[4], gb[4];
#pragma unroll
            for (int m = 0; m < 4; ++m) { ga[m] = *(const u32x4*)(G8 + g8_chunk(sn, u.pm, u.pn, ai, wr, m, wc) + lo16); gb[m] = *(const u32x4*)(G8 + g8_chunk(sn + 1, u.pm, u.pn, ai, wr, m, wc) + lo16); }
            asm volatile("" ::: "memory");
#pragma unroll
            for (int m = 0; m < 4; ++m) { const u32x4 a = ga[m], b = gb[m];
#pragma unroll
                for (int j = 0; j < 4; ++j) { acc[ai][0][m][0][j] *= PJ_BYTE(a.x, j) * __builtin_amdgcn_rcpf(PJ_BYTE(b.x, j)); acc[ai][0][m][1][j] *= PJ_BYTE(a.y, j) * __builtin_amdgcn_rcpf(PJ_BYTE(b.y, j));
                                              acc[ai][1][m][0][j] *= PJ_BYTE(a.z, j) * __builtin_amdgcn_rcpf(PJ_BYTE(b.z, j)); acc[ai][1][m][1][j] *= PJ_BYTE(a.w, j) * __builtin_amdgcn_rcpf(PJ_BYTE(b.w, j)); } }
            asm volatile("" ::: "memory"); }
    }
    __device__ __forceinline__ void operator()(const f32x4 (&acc)[2][2][4][2], const Unit& u, int wr, int wc, int fr_, int fq_) const {
        int fr = fr_, fq = fq_; asm volatile("" : "+v"(fr), "+v"(fq));
        const int row0 = u.pm * BM + wr * 64 + fr, col0 = u.pn * BM + wc * 32 + 8 * fq, wcol = u.pn * BM + wc * 32 + 8 * (fq & ~1) + HALF * (fq & 1);
        const float i255 = 1.0f / 255.0f;
#pragma unroll
        for (int ai = 0; ai < 2; ++ai)
#pragma unroll
            for (int m = 0; m < 4; ++m) { const int row = row0 + ai * HALF + m * 16;
                const u32x4 a = *(const u32x4*)(G8 + g8_chunk(2, u.pm, u.pn, ai, wr, m, wc) + (fq * 16 + fr) * 16);
#pragma unroll
                for (int bj = 0; bj < 2; ++bj) { const unsigned g0 = bj ? a.z : a.x, g1 = bj ? a.w : a.y; const f32x4 v0 = acc[ai][bj][m][0] * i255, v1 = acc[ai][bj][m][1] * i255;
                    u32x4 w; w.x = cvt_pk_bf16(v0[0] * PJ_BYTE(g0, 0), v0[1] * PJ_BYTE(g0, 1)); w.y = cvt_pk_bf16(v0[2] * PJ_BYTE(g0, 2), v0[3] * PJ_BYTE(g0, 3));
                    w.z = cvt_pk_bf16(v1[0] * PJ_BYTE(g1, 0), v1[1] * PJ_BYTE(g1, 1)); w.w = cvt_pk_bf16(v1[2] * PJ_BYTE(g1, 2), v1[3] * PJ_BYTE(g1, 3));
                    *(u32x4*)((unsigned char*)O + a_tiled_off(row, col0 + bj * HALF, D)) = w; } }
    }
#undef PJ_BYTE
};
struct EpiWin {
    static constexpr bool PERM = true, MID = false, IDEMPOTENT = (EPI_DUP_SEL == 2); static constexpr int MID_T0 = -1, MID_T1 = -1;
    bf16_t* Z; const float* bgate; const float* rope; float* sgp; unsigned char* g8; const PG8_LAS float* rstd;
    __device__ __forceinline__ void operator()(const f32x4 (&acc)[2][2][4][2], const Unit& u, int wr, int wc, int fr_, int fq_) const {
        int fr = fr_, fq = fq_; asm volatile("" : "+v"(fr), "+v"(fq));
        const int pn = u.pn, row0 = u.pm * BM + wr * 64 + fr, cl = wc * 32 + 8 * fq;
        if (pn < 8) {
            const int h = pn & 3; const bool isk = pn >= 4;
            const float l2g = __builtin_log2f(1.0f - __builtin_amdgcn_exp2f(-5.0f - (float)h));
            const f32x4 f0 = *(const f32x4*)(rope + cl), f1 = *(const f32x4*)(rope + cl + 4);
#pragma unroll
            for (int ai = 0; ai < 2; ++ai)
#pragma unroll
                for (int m = 0; m < 4; ++m) { const int row = row0 + ai * HALF + m * 16, pos = row & (T - 1), ci = row & 127;
                    const float sc = (isk ? __builtin_amdgcn_exp2f(-(float)ci * l2g) * 0.0625f : __builtin_amdgcn_exp2f((float)ci * l2g)) * rstd[ai * HALF + wr * 64 + m * 16 + fr];
                    const float fp = (float)pos; f32x4 c0, c1, s0, s1;
#pragma unroll
                    for (int j = 0; j < 4; ++j) { const float ra = __builtin_amdgcn_fractf(fp * f0[j]), rb = __builtin_amdgcn_fractf(fp * f1[j]);
                        c0[j] = __builtin_amdgcn_cosf(ra); s0[j] = __builtin_amdgcn_sinf(ra); c1[j] = __builtin_amdgcn_cosf(rb); s1[j] = __builtin_amdgcn_sinf(rb); }
                    const f32x4 t1a = acc[ai][0][m][0], t1b = acc[ai][0][m][1], t2a = acc[ai][1][m][0], t2b = acc[ai][1][m][1];
                    const f32x4 o1a = (t1a * c0 - t2a * s0) * sc, o1b = (t1b * c1 - t2b * s1) * sc, o2a = (t1a * s0 + t2a * c0) * sc, o2b = (t1b * s1 + t2b * c1) * sc;
                    bf16_t* zp = Z + (size_t)row * DIN + pn * BM + cl;
                    u32x4 w; w.x = cvt_pk_bf16(o1a[0], o1a[1]); w.y = cvt_pk_bf16(o1a[2], o1a[3]); w.z = cvt_pk_bf16(o1b[0], o1b[1]); w.w = cvt_pk_bf16(o1b[2], o1b[3]); *(u32x4*)zp = w;
                    w.x = cvt_pk_bf16(o2a[0], o2a[1]); w.y = cvt_pk_bf16(o2a[2], o2a[3]); w.z = cvt_pk_bf16(o2b[0], o2b[1]); w.w = cvt_pk_bf16(o2b[2], o2b[3]); *(u32x4*)(zp + HALF) = w; }
            return;
        }
        if (pn >= 28 && pn < 32) {
#pragma unroll
            for (int ai = 0; ai < 2; ++ai) { float qa[4], qb[4];
#pragma unroll
                for (int m = 0; m < 4; ++m) { const int row = row0 + ai * HALF + m * 16; bf16_t* zp = Z + (size_t)row * DIN + pn * BM + cl; const float rs = rstd[ai * HALF + wr * 64 + m * 16 + fr];
                    float q1 = 0.f, q2 = 0.f;
#pragma unroll
                    for (int bj = 0; bj < 2; ++bj) { f32x4 v0 = acc[ai][bj][m][0] * rs, v1 = acc[ai][bj][m][1] * rs;
#pragma unroll
                        for (int j = 0; j < 4; ++j) { v0[j] = gelu_tanh_f(v0[j]); v1[j] = gelu_tanh_f(v1[j]); }
                        u32x4 w; w.x = cvt_pk_bf16(v0[0], v0[1]); w.y = cvt_pk_bf16(v0[2], v0[3]); w.z = cvt_pk_bf16(v1[0], v1[1]); w.w = cvt_pk_bf16(v1[2], v1[3]);
                        *(u32x4*)(zp + bj * HALF) = w;
                        const float a0 = bf_lo(w.x), a1 = bf_hi(w.x), a2 = bf_lo(w.y), a3 = bf_hi(w.y), a4 = bf_lo(w.z), a5 = bf_hi(w.z), a6 = bf_lo(w.w), a7 = bf_hi(w.w);
                        q1 += ((a0 + a1) + (a2 + a3)) + ((a4 + a5) + (a6 + a7)); q2 += ((a0 * a0 + a1 * a1) + (a2 * a2 + a3 * a3)) + ((a4 * a4 + a5 * a5) + (a6 * a6 + a7 * a7)); }
                    qa[m] = xrow_sum(q1); qb[m] = xrow_sum(q2); }
                { f32x2v_t pr; pr[0] = fq == 0 ? qa[0] : fq == 1 ? qa[1] : fq == 2 ? qa[2] : qa[3]; pr[1] = fq == 0 ? qb[0] : fq == 1 ? qb[1] : fq == 2 ? qb[2] : qb[3];
                  *(f32x2v_t*)(sgp + ((size_t)(row0 + ai * HALF + fq * 16) * 16 + (pn - 28) * 4 + wc) * 2) = pr; } }
            return;
        }
        if (pn >= 44) {
            const int sec = (pn - 44) >> 3, wcol = ((pn - 44) & 7) * BM + wc * 32 + 8 * (fq & ~1) + HALF * (fq & 1);
            f32x4 bb[2][2];
#pragma unroll
            for (int bj = 0; bj < 2; ++bj) { const float* bp = bgate + (pn * BM - C_GL) + bj * HALF + cl; bb[bj][0] = *(const f32x4*)bp * (-LOG2E) - 7.994353436858858f; bb[bj][1] = *(const f32x4*)(bp + 4) * (-LOG2E) - 7.994353436858858f; }
#pragma unroll
            for (int ai = 0; ai < 2; ++ai)
#pragma unroll
                for (int m = 0; m < 4; ++m) { const int row = row0 + ai * HALF + m * 16; const float ce = -LOG2E * rstd[ai * HALF + wr * 64 + m * 16 + fr];
                    unsigned pk[2][2];
#pragma unroll
                    for (int bj = 0; bj < 2; ++bj) { const f32x4 b0 = bb[bj][0], b1 = bb[bj][1];
                        unsigned lo = 0u, hi = 0u;
#pragma unroll
                        for (int j = 0; j < 4; ++j) { const float g0 = __builtin_amdgcn_rcpf((1.0f / 255.0f) + __builtin_amdgcn_exp2f(acc[ai][bj][m][0][j] * ce + b0[j])), g1 = __builtin_amdgcn_rcpf((1.0f / 255.0f) + __builtin_amdgcn_exp2f(acc[ai][bj][m][1][j] * ce + b1[j]));
                            lo = __builtin_amdgcn_cvt_pk_u8_f32(fmaxf(g0, 1.0f), j, lo); hi = __builtin_amdgcn_cvt_pk_u8_f32(fmaxf(g1, 1.0f), j, hi); }
                        pk[bj][0] = lo; pk[bj][1] = hi; }
                    u32x4 w; w.x = pk[0][0]; w.y = pk[0][1]; w.z = pk[1][0]; w.w = pk[1][1];
                    *(u32x4*)(g8 + g8_chunk(sec, u.pm, (pn - 44) & 7, ai, wr, m, wc) + (fq * 16 + fr) * 16) = w; (void)row; }
            return;
        }
        const int mode = pn < 16 ? 0 : pn < 24 ? 1 : pn < 28 ? 2 : pn < 32 ? 3 : pn < 36 ? 4 : 0;
        const float qs = 0.08838834764831845f * LOG2E;
#pragma unroll
        for (int ai = 0; ai < 2; ++ai)
#pragma unroll
            for (int m = 0; m < 4; ++m) { const int row = row0 + ai * HALF + m * 16; bf16_t* zp = Z + (size_t)row * DIN + pn * BM + cl; const float rs = rstd[ai * HALF + wr * 64 + m * 16 + fr];
#pragma unroll
                for (int bj = 0; bj < 2; ++bj) { f32x4 v0 = acc[ai][bj][m][0] * rs, v1 = acc[ai][bj][m][1] * rs;
                    if (mode == 1) { const float ce = -LOG2E * rs;
#pragma unroll
                        for (int j = 0; j < 4; ++j) { v0[j] = v0[j] * __builtin_amdgcn_rcpf(1.0f + __builtin_amdgcn_exp2f(acc[ai][bj][m][0][j] * ce)); v1[j] = v1[j] * __builtin_amdgcn_rcpf(1.0f + __builtin_amdgcn_exp2f(acc[ai][bj][m][1][j] * ce)); } }
                    else if (mode == 2 || mode == 3) {
#pragma unroll
                        for (int j = 0; j < 4; ++j) { v0[j] = gelu_tanh_f(v0[j]); v1[j] = gelu_tanh_f(v1[j]); } }
                    else if (mode == 4) { v0 = v0 * qs; v1 = v1 * qs; }
                    u32x4 w; w.x = cvt_pk_bf16(v0[0], v0[1]); w.y = cvt_pk_bf16(v0[2], v0[3]); w.z = cvt_pk_bf16(v1[0], v1[1]); w.w = cvt_pk_bf16(v1[2], v1[3]);
                    if (pn >= 16 && pn < 28) *(u32x4*)((unsigned char*)Z + (WS_RS - WS_Z) + a_tiled_off(row, (pn - 16) * BM + cl + bj * HALF, 3072)) = w;
                    else *(u32x4*)(zp + bj * HALF) = w;
                     }
 }
    }
};
}

__device__ __forceinline__ float wave_sum(float v) {
#pragma unroll
    for (int o = 1; o < 64; o <<= 1) v += __shfl_xor(v, o);
    return v;
}
__device__ __forceinline__ void transpose_item(const float* W, int N, bf16* WT, int ldk, int koff, int drow0, LAS float* scr, int k0, int n0, int lane, const float* gain) {
#pragma unroll 8
    for (int i = 0; i < 32; ++i) { const int kk = 2 * i + (lane >> 5); scr[kk * 33 + (lane & 31)] = W[(size_t)(k0 + kk) * N + n0 + (lane & 31)]; }
    const int c = lane & 7;
    f32x4 g0 = (f32x4){1.f, 1.f, 1.f, 1.f}, g1 = g0;
    if (gain) { g0 = *(const f32x4*)(gain + k0 + 8 * c); g1 = *(const f32x4*)(gain + k0 + 8 * c + 4); }
    LDS_WAIT(); asm volatile("" ::: "memory");
#pragma unroll
    for (int j = 0; j < 4; ++j) { const int n = (lane >> 3) + 8 * j; const LAS float* s = scr + (8 * c) * 33 + n;
        v4u o; o.x = pk2(s[0 * 33] * g0[0], s[1 * 33] * g0[1]); o.y = pk2(s[2 * 33] * g0[2], s[3 * 33] * g0[3]); o.z = pk2(s[4 * 33] * g1[0], s[5 * 33] * g1[1]); o.w = pk2(s[6 * 33] * g1[2], s[7 * 33] * g1[3]);
#if PG8_BTILED
        *(v4u*)((unsigned char*)WT + pg8::w_tiled_off(drow0 + n, koff + k0 + 8 * c, ldk)) = o; }
#else
        *(v4u*)(WT + (size_t)(drow0 + n) * ldk + koff + k0 + 8 * c) = o; }
#endif
    LDS_WAIT(); asm volatile("" ::: "memory");
}
struct ConvMat { const float* W; bf16* WT; int K, N, ldk, koff, gu; const float* gain; };
__device__ __forceinline__ void conv_matrix(const ConvMat& c, LAS float* scr, int gw, int NGW, int lane) {
    const int nn = c.N / 32, items = (c.K / 64) * nn;
    for (int it = gw; it < items; it += NGW) { const int kb = it / nn, nb = it - kb * nn, n0 = 32 * nb;
        const int drow0 = c.gu ? ((n0 >> 7) * 256 + (n0 & 127) + (c.gu - 1) * 128) : n0;
        transpose_item(c.W, c.N, c.WT, c.ldk, c.koff, drow0, scr, 64 * kb, n0, lane, c.gain); }
}
template <bool F32OUT>
__device__ __forceinline__ void rms_row(const bf16* X, int m, const float* gain, void* orow, int lane) {
    v4u v[4]; float s = 0.f;
#pragma unroll
    for (int j = 0; j < 4; ++j) { v[j] = *(const v4u*)((const unsigned char*)X + pg8::a_tiled_off(m, 8 * (lane + 64 * j), D));
        const float a0 = bf_lo(v[j].x), a1 = bf_hi(v[j].x), a2 = bf_lo(v[j].y), a3 = bf_hi(v[j].y), a4 = bf_lo(v[j].z), a5 = bf_hi(v[j].z), a6 = bf_lo(v[j].w), a7 = bf_hi(v[j].w);
        s += ((a0 * a0 + a1 * a1) + (a2 * a2 + a3 * a3)) + ((a4 * a4 + a5 * a5) + (a6 * a6 + a7 * a7)); }
    const float rstd = 1.0f / sqrtf(wave_sum(s) * (1.0f / D) + EPS);
#pragma unroll
    for (int j = 0; j < 4; ++j) { const float* gp = gain + (64 * j + lane) * 8; const f32x4 g0 = *(const f32x4*)gp, g1 = *(const f32x4*)(gp + 4);
        const f32x4 o0 = (f32x4){bf_lo(v[j].x), bf_hi(v[j].x), bf_lo(v[j].y), bf_hi(v[j].y)} * rstd * g0, o1 = (f32x4){bf_lo(v[j].z), bf_hi(v[j].z), bf_lo(v[j].w), bf_hi(v[j].w)} * rstd * g1;
        if (F32OUT) { float* op = (float*)orow + (64 * j + lane) * 8; *(f32x4*)op = o0; *(f32x4*)(op + 4) = o1; }
        else { v4u w; w.x = cvt_pk_bf16(o0[0], o0[1]); w.y = cvt_pk_bf16(o0[2], o0[3]); w.z = cvt_pk_bf16(o1[0], o1[1]); w.w = cvt_pk_bf16(o1[2], o1[3]); ((v4u*)orow + lane)[64 * j] = w; } }
}
__device__ __forceinline__ void x_row_prep(const float* xrow, bf16* XR, int m, float* prow, int lane) {
    const f32x4* xr = (const f32x4*)xrow + lane; float s = 0.f;
#pragma unroll
    for (int j = 0; j < 8; ++j) { const f32x4 v = xr[64 * j]; v2u w; w.x = cvt_pk_bf16(v.x, v.y); w.y = cvt_pk_bf16(v.z, v.w); *(v2u*)((unsigned char*)XR + pg8::a_tiled_off(m, 4 * (lane + 64 * j), D)) = w;
        const float a0 = bf_lo(w.x), a1 = bf_hi(w.x), a2 = bf_lo(w.y), a3 = bf_hi(w.y); s += (a0 * a0 + a1 * a1) + (a2 * a2 + a3 * a3); }
    s = wave_sum(s);
    if (lane < 32) prow[lane] = lane == 0 ? s : 0.f;
}
__device__ __forceinline__ void panel_rstd(LAS float* tab, const float* part, int pm, int tid) {
    const int row = tid >> 1, hf = tid & 1; const float* p = part + (size_t)(pm * 256 + row) * 32 + hf * 16;
    const f32x4 a = *(const f32x4*)p, b = *(const f32x4*)(p + 4), c = *(const f32x4*)(p + 8), d = *(const f32x4*)(p + 12);
    float s = (((a[0] + a[1]) + (a[2] + a[3])) + ((b[0] + b[1]) + (b[2] + b[3]))) + (((c[0] + c[1]) + (c[2] + c[3])) + ((d[0] + d[1]) + (d[2] + d[3])));
    s += __shfl_xor(s, 1);
    if (hf == 0) tab[row] = 1.0f / sqrtf(s * (1.0f / 2048.0f) + EPS);
}

#define MFMA16(a, b, c) __builtin_amdgcn_mfma_f32_16x16x32_bf16(a, b, c, 0, 0, 0)
__device__ __forceinline__ bf16x8 ldg16(const bf16* p) { return *(const bf16x8*)p; }
__device__ __forceinline__ s16x4 lds_tr(LAS unsigned char* p) { return __builtin_amdgcn_ds_read_tr16_b64_v4i16((LAS s16x4*)p); }
__device__ __forceinline__ bf16x8 cat8(s16x4 a, s16x4 b) { return (bf16x8){a[0], a[1], a[2], a[3], b[0], b[1], b[2], b[3]}; }
__device__ __forceinline__ bf16x8 pack8(f32x4 a, f32x4 b) { v4u w; w.x = cvt_pk_bf16(a[0], a[1]); w.y = cvt_pk_bf16(a[2], a[3]); w.z = cvt_pk_bf16(b[0], b[1]); w.w = cvt_pk_bf16(b[2], b[3]); return __builtin_bit_cast(bf16x8, w); }
__device__ __forceinline__ float head_gamma(int h) { return 1.0f - __builtin_amdgcn_exp2f(-5.0f - (float)h); }

constexpr int SG_VSTRIDE = 544;
__device__ __forceinline__ void sgu_unit(LAS unsigned char* lds, const bf16* Z, const float* SGP, bf16* ACAT, const bf16* WC, const float* lng, const float* lnb, const float* sgb, int uid, int w, int lane_in) {
    int lane = lane_in; asm volatile("" : "+v"(lane)); const int tid = w * 64 + lane;
    const int b = uid >> 8, n = (uid >> 2) & 63, gq = uid & 3, row0 = b * T + n * 128;
    const int fr = lane & 15, g = lane >> 4;
    LAS unsigned char* VN = lds; LAS float* ST = (LAS float*)(lds + 128 * SG_VSTRIDE);
    { const int r = lane >> 2, q = lane & 3; const float* pp = SGP + ((size_t)(row0 + 16 * w + r) * 16 + q * 4) * 2;
      const f32x4 a = *(const f32x4*)pp, c = *(const f32x4*)(pp + 4);
      float t1 = (a[0] + a[2]) + (c[0] + c[2]), t2 = (a[1] + a[3]) + (c[1] + c[3]);
      t1 += __shfl_xor(t1, 1); t2 += __shfl_xor(t2, 1); t1 += __shfl_xor(t1, 2); t2 += __shfl_xor(t2, 2);
      if (q == 0) { const int row = 16 * w + r; const float mean = t1 * (1.0f / 1024.0f), var = fmaxf(t2 * (1.0f / 1024.0f) - mean * mean, 0.f); ST[row * 2] = mean; ST[row * 2 + 1] = 1.0f / sqrtf(var + EPS); } }
    LDS_WAIT(); __syncthreads();
    const int c8 = (tid & 31) * 8;
    const f32x4 g0 = *(const f32x4*)(lng + gq * 256 + c8), g1 = *(const f32x4*)(lng + gq * 256 + c8 + 4), b0 = *(const f32x4*)(lnb + gq * 256 + c8), b1 = *(const f32x4*)(lnb + gq * 256 + c8 + 4);
#pragma unroll
    for (int it = 0; it < 8; ++it) { const int p = tid + 512 * it, row = p >> 5;
        const v4u x = *(const v4u*)(Z + (size_t)(row0 + row) * DIN + C_SV + gq * 256 + c8);
        const float mean = ST[row * 2], rstd = ST[row * 2 + 1];
        v4u o;
        o.x = cvt_pk_bf16((bf_lo(x.x) - mean) * rstd * g0[0] + b0[0], (bf_hi(x.x) - mean) * rstd * g0[1] + b0[1]);
        o.y = cvt_pk_bf16((bf_lo(x.y) - mean) * rstd * g0[2] + b0[2], (bf_hi(x.y) - mean) * rstd * g0[3] + b0[3]);
        o.z = cvt_pk_bf16((bf_lo(x.z) - mean) * rstd * g1[0] + b1[0], (bf_hi(x.z) - mean) * rstd * g1[1] + b1[1]);
        o.w = cvt_pk_bf16((bf_lo(x.w) - mean) * rstd * g1[2] + b1[2], (bf_hi(x.w) - mean) * rstd * g1[3] + b1[3]);
        *(LAS v4u*)(VN + row * SG_VSTRIDE + c8 * 2) = o; }
    bf16x8 wf[4];
#pragma unroll
    for (int ks = 0; ks < 4; ++ks) wf[ks] = ldg16(WC + (size_t)(gq * 128 + 16 * w + fr) * 128 + ks * 32 + 8 * g);
    LDS_WAIT(); __syncthreads();
    const int row = row0 + 16 * w + fr; const float bias = sgb[gq * 128 + 16 * w + fr];
    const int oc0 = 2048 + gq * 256 + wide_col(g);
    LAS unsigned char* vb = VN + (8 * g + (fr >> 2)) * SG_VSTRIDE + (fr & 3) * 8;
#pragma unroll
    for (int cp = 0; cp < 8; ++cp) { f32x4 a[2];
#pragma unroll
        for (int c2 = 0; c2 < 2; ++c2) { const int ct = 2 * cp + c2; f32x4 t = (f32x4){0.f, 0.f, 0.f, 0.f};
#pragma unroll
            for (int ks = 0; ks < 4; ++ks) { const bf16x8 af = cat8(lds_tr(vb + (32 * ks) * SG_VSTRIDE + ct * 32), lds_tr(vb + (32 * ks + 4) * SG_VSTRIDE + ct * 32)); t = MFMA16(af, wf[ks], t); }
            a[c2] = t; }
#pragma unroll
        for (int r = 0; r < 4; ++r) SWAP16F(a[0][r], a[1][r]);
        const v4u su = *(const v4u*)((const unsigned char*)Z + (WS_RS - WS_Z) + pg8::a_tiled_off(row, oc0 + 32 * cp, 3072));
        v4u o; o.x = cvt_pk_bf16(bf_lo(su.x) * (a[0][0] + bias), bf_hi(su.x) * (a[0][1] + bias)); o.y = cvt_pk_bf16(bf_lo(su.y) * (a[0][2] + bias), bf_hi(su.y) * (a[0][3] + bias));
        o.z = cvt_pk_bf16(bf_lo(su.z) * (a[1][0] + bias), bf_hi(su.z) * (a[1][1] + bias)); o.w = cvt_pk_bf16(bf_lo(su.w) * (a[1][2] + bias), bf_hi(su.w) * (a[1][3] + bias));
        *(v4u*)((unsigned char*)ACAT + pg8::a_tiled_off(row, oc0 + 32 * cp, KCAT)) = o; }
    __syncthreads();
}


constexpr int CS_KSTRIDE = 544, CS_VSTRIDE = 288, CS_VOFF = 128 * CS_KSTRIDE;
constexpr int CS_UNITS = 2 * 4 * 8 * 4;
__device__ __forceinline__ void cs_phase(LAS unsigned char* lds, const bf16* Z, bf16* SB, bf16* TB, int first, int stride, int w, int lane_in) {
    int lane = lane_in; asm volatile("" : "+v"(lane)); const int tid = w * 64 + lane;
    const int fr = lane & 15, g = lane >> 4;
    LAS unsigned char* KC = lds; LAS unsigned char* VC = lds + CS_VOFF;
    LAS unsigned char* ka = KC + (4 * g + (fr >> 2)) * CS_KSTRIDE + (32 * w) * 2 + (fr & 3) * 8;
    LAS unsigned char* va = VC + (4 * g + (fr >> 2)) * CS_VSTRIDE + (fr & 3) * 8;
    for (int u = first; u < CS_UNITS; u += stride) {
        const int eq = u & 3, grp = (u >> 2) & 7, bh = u >> 5, h = bh & 3;
        const float l2g = __builtin_log2f(head_gamma(h)), g127 = __builtin_amdgcn_exp2f(127.f * l2g), g128 = __builtin_amdgcn_exp2f(128.f * l2g);
        const bf16* zr0 = Z + (size_t)((bh >> 2) * T + grp * 1024) * DIN;
        v4u kreg[8], vreg[4];
#define CS_LOAD(i_) do { const bf16* zr = zr0 + (size_t)((i_) * 128) * DIN; int tl_ = tid; asm volatile("" : "+v"(tl_));   \
        _Pragma("unroll") for (int it = 0; it < 8; ++it) { const int p = tl_ + 512 * it; kreg[it] = *(const v4u*)(zr + (size_t)(p >> 5) * DIN + C_RK + h * 256 + (p & 31) * 8); } \
        _Pragma("unroll") for (int it = 0; it < 4; ++it) { const int p = tl_ + 512 * it; vreg[it] = *(const v4u*)(zr + (size_t)(p >> 4) * DIN + C_RV + h * 512 + eq * 128 + (p & 15) * 8); } } while (0)
        CS_LOAD(0);
        f32x4 U[2][8];
#pragma unroll
        for (int i = 0; i < 2; ++i)
#pragma unroll
            for (int j = 0; j < 8; ++j) U[i][j] = (f32x4){0.f, 0.f, 0.f, 0.f};
#define CS_STORE(sp_) do { bf16* sp__ = (sp_); asm volatile("" : "+v"(sp__));   _Pragma("unroll") for (int j = 0; j < 8; ++j) { const f32x4 r0 = U[0][j] * g127, r1 = U[1][j] * g127; \
        v4u o; o.x = cvt_pk_bf16(r0[0], r0[1]); o.y = cvt_pk_bf16(r0[2], r0[3]); o.z = cvt_pk_bf16(r1[0], r1[1]); o.w = cvt_pk_bf16(r1[2], r1[3]); SWAP16U(o.x, o.z); SWAP16U(o.y, o.w);   \
        *(v4u*)(sp__ + j * 16 * 256) = o; } } while (0)
        bf16* sp0 = SB + ((size_t)((bh * 64 + grp * 8) * 512) + eq * 128 + fr) * 256 + 32 * w + wide_col(g);
#pragma unroll 1
        for (int ci = 0; ci < 8; ++ci) {
#pragma unroll
            for (int it = 0; it < 8; ++it) { const int p = tid + 512 * it; *(LAS v4u*)(KC + (p >> 5) * CS_KSTRIDE + (p & 31) * 16) = kreg[it]; }
#pragma unroll
            for (int it = 0; it < 4; ++it) { const int p = tid + 512 * it; *(LAS v4u*)(VC + (p >> 4) * CS_VSTRIDE + (p & 15) * 16) = vreg[it]; }
            LDS_WAIT(); __syncthreads();
            if (ci != 0) CS_STORE(sp0 + (size_t)ci * 512 * 256);
            if (ci < 7) CS_LOAD(ci + 1);
#pragma unroll
            for (int i = 0; i < 2; ++i)
#pragma unroll
                for (int j = 0; j < 8; ++j) U[i][j] = U[i][j] * g128;
#pragma unroll
            for (int ks = 0; ks < 4; ++ks) { bf16x8 af[2], bfv[8];
#pragma unroll
                for (int i = 0; i < 2; ++i) af[i] = cat8(lds_tr(ka + (32 * ks) * CS_KSTRIDE + i * 32), lds_tr(ka + (32 * ks + 16) * CS_KSTRIDE + i * 32));
#pragma unroll
                for (int j = 0; j < 8; ++j) bfv[j] = cat8(lds_tr(va + (32 * ks) * CS_VSTRIDE + j * 32), lds_tr(va + (32 * ks + 16) * CS_VSTRIDE + j * 32));
#pragma unroll
                for (int i = 0; i < 2; ++i)
#pragma unroll
                    for (int j = 0; j < 8; ++j) U[i][j] = MFMA16(af[i], bfv[j], U[i][j]); }
            __syncthreads();
        }
        CS_STORE(TB + ((size_t)((bh * 8 + grp) * 512) + eq * 128 + fr) * 256 + 32 * w + wide_col(g));
#undef CS_LOAD
#undef CS_STORE
    }
}

__device__ __forceinline__ void prefix2_phase(bf16* TB, int gt, int NGT) {
    for (int idx = gt; idx < 8 * 512 * 32; idx += NGT) {
        const int bh = idx >> 14, h = bh & 3; const float g1024 = __builtin_amdgcn_exp2f(1024.f * __builtin_log2f(head_gamma(h)));
        bf16* p = TB + (size_t)bh * 8 * 512 * 256 + (size_t)(idx & 16383) * 8;
        v4u s[8];
#pragma unroll
        for (int k = 0; k < 7; ++k) s[k] = *(const v4u*)(p + (size_t)k * 512 * 256);
        float r[8]; float z0 = 0.f; asm volatile("" : "+v"(z0));
#pragma unroll
        for (int k = 0; k < 8; ++k) r[k] = z0;
#pragma unroll
        for (int k = 0; k < 8; ++k) { v4u o; o.x = cvt_pk_bf16(r[0], r[1]); o.y = cvt_pk_bf16(r[2], r[3]); o.z = cvt_pk_bf16(r[4], r[5]); o.w = cvt_pk_bf16(r[6], r[7]);
            *(v4u*)(p + (size_t)k * 512 * 256) = o;
            if (k < 7) { r[0] = r[0] * g1024 + bf_lo(s[k].x); r[1] = r[1] * g1024 + bf_hi(s[k].x); r[2] = r[2] * g1024 + bf_lo(s[k].y); r[3] = r[3] * g1024 + bf_hi(s[k].y);
                         r[4] = r[4] * g1024 + bf_lo(s[k].z); r[5] = r[5] * g1024 + bf_hi(s[k].z); r[6] = r[6] * g1024 + bf_lo(s[k].w); r[7] = r[7] * g1024 + bf_hi(s[k].w); } }
    }
}

constexpr int AT_STRIDE = 288, AT_SLOT = 128 * AT_STRIDE, AT_VOFF = 2 * AT_SLOT, AT_BOFF = 4 * AT_SLOT;
#define AT_LOADBLK(sbk_) do { _Pragma("unroll") for (int it = 0; it < 4; ++it) { const int p = tid + 512 * it; const bf16* zr = zb + (size_t)(((((sbk_) * 128) + (p >> 4)) << dsh) + rr) * DIN + (p & 15) * 8; \
        kreg[it] = *(const v4u*)(zr + C_AK); vreg[it] = *(const v4u*)(zr + C_AV); } } while (0)
#define AT_WRITEBLK(slot_) do { _Pragma("unroll") for (int it = 0; it < 4; ++it) { const int p = tid + 512 * it; const int o = (slot_) * AT_SLOT + (p >> 4) * AT_STRIDE + (p & 15) * 16; \
        *(LAS v4u*)(lds + o) = kreg[it]; *(LAS v4u*)(lds + AT_VOFF + o) = vreg[it]; } } while (0)
struct AtPend { v4u o[4]; float lse; int rowq; };
#define AT_FLUSH_PLAIN(P_) do { bf16* op_ = OP + ((size_t)cfg * M + (P_).rowq) * 1024 + h * 128 + wide_col(g); _Pragma("unroll") for (int mq = 0; mq < 4; ++mq) *(v4u*)(op_ + 32 * mq) = (P_).o[mq]; \
        if (g == 0) LSE[(((size_t)(P_).rowq) * 8 + h) * 2 + cfg] = (P_).lse; } while (0)
#define AT_FLUSH_MERGE(P_) do { const size_t ro_ = (size_t)(P_).rowq; const pg8::f32x2v_t l01_ = *(const pg8::f32x2v_t*)(LSE + (ro_ * 8 + h) * 2); const float l0 = l01_[0], l1 = l01_[1], l2 = (P_).lse; \
        const float mx_ = fmaxf(l0, fmaxf(l1, l2)); float w0 = __builtin_amdgcn_exp2f(l0 - mx_), w1 = __builtin_amdgcn_exp2f(l1 - mx_), w2 = __builtin_amdgcn_exp2f(l2 - mx_); \
        const float rs_ = 1.0f / (w0 + w1 + w2); w0 *= rs_; w1 *= rs_; w2 *= rs_; \
        const bf16* p0_ = OP + ro_ * 1024 + h * 128 + wide_col(g); const bf16* p1_ = p0_ + (size_t)M * 1024; const int oc0_ = 3072 + h * 128 + wide_col(g); \
        v4u a_[4], b_[4]; _Pragma("unroll") for (int mq = 0; mq < 4; ++mq) { a_[mq] = *(const v4u*)(p0_ + 32 * mq); b_[mq] = *(const v4u*)(p1_ + 32 * mq); } \
        _Pragma("unroll") for (int mq = 0; mq < 4; ++mq) { const v4u a = a_[mq], b = b_[mq], c = (P_).o[mq]; v4u r; \
            r.x = cvt_pk_bf16(w0 * bf_lo(a.x) + w1 * bf_lo(b.x) + w2 * bf_lo(c.x), w0 * bf_hi(a.x) + w1 * bf_hi(b.x) + w2 * bf_hi(c.x)); \
            r.y = cvt_pk_bf16(w0 * bf_lo(a.y) + w1 * bf_lo(b.y) + w2 * bf_lo(c.y), w0 * bf_hi(a.y) + w1 * bf_hi(b.y) + w2 * bf_hi(c.y)); \
            r.z = cvt_pk_bf16(w0 * bf_lo(a.z) + w1 * bf_lo(b.z) + w2 * bf_lo(c.z), w0 * bf_hi(a.z) + w1 * bf_hi(b.z) + w2 * bf_hi(c.z)); \
            r.w = cvt_pk_bf16(w0 * bf_lo(a.w) + w1 * bf_lo(b.w) + w2 * bf_lo(c.w), w0 * bf_hi(a.w) + w1 * bf_hi(b.w) + w2 * bf_hi(c.w)); \
            *(v4u*)((unsigned char*)ACATO + pg8::a_tiled_off((int)ro_, oc0_ + 32 * mq, KCAT)) = r; } } while (0)
#define AT_FLUSH(P_) do { if constexpr (FUSE) AT_FLUSH_MERGE(P_); else AT_FLUSH_PLAIN(P_); } while (0)
template <int PAR, bool FUSE>
__device__ __forceinline__ void attn_unit(LAS unsigned char* lds, const bf16* Z, const bf16* zb, bf16* OP, float* LSE, bf16* ACATO, v4u (&kreg)[4], v4u (&vreg)[4], AtPend& pend, bool have_pend, int cfg, int b, int h, int dsh, int rr, int sb, bool has_next, int w, int tid, int fr, int g) {
    LAS float* BL = (LAS float*)(lds + AT_BOFF);
    if (have_pend) AT_FLUSH(pend);
    const int rowq = b * T + ((sb * 128 + 16 * w + fr) << dsh) + rr;
    bf16x8 qf[4];
#pragma unroll
    for (int ks = 0; ks < 4; ++ks) qf[ks] = ldg16(Z + (size_t)rowq * DIN + C_AQ + h * 128 + ks * 32 + 8 * g);
    if (has_next) AT_LOADBLK(sb + 1);
    int wv = 16 * w; asm volatile("" : "+v"(wv));
#define AT_ROWOFF(kt_) (((((wv + 16 * (kt_)) >> 7) ^ PAR ^ 1) & 1) * AT_SLOT + ((wv + 16 * (kt_)) & 127) * AT_STRIDE)
    f32x4 st[9];
#pragma unroll
    for (int kt = 0; kt < 9; ++kt) { LAS unsigned char* kp = lds + AT_ROWOFF(kt) + fr * AT_STRIDE + g * 16; f32x4 a = (f32x4){0.f, 0.f, 0.f, 0.f};
#pragma unroll
        for (int ks = 0; ks < 4; ++ks) a = MFMA16(*(LAS bf16x8*)(kp + ks * 64), qf[ks], a);
        st[kt] = a; }
    LAS float* blp = BL + (15 + 4 * g - fr);
#pragma unroll
    for (int kt = 0; kt < 9; ++kt)
#pragma unroll
        for (int r = 0; r < 4; ++r) st[kt][r] += blp[16 * kt + r];
    if (sb == 0) {
#pragma unroll
        for (int kt = 0; kt < 9; ++kt)
#pragma unroll
            for (int r = 0; r < 4; ++r) if (wv + 16 * kt + 4 * g + r < 128) st[kt][r] = -__builtin_inff(); }
    float mx = -__builtin_inff();
#pragma unroll
    for (int kt = 0; kt < 9; ++kt)
#pragma unroll
        for (int r = 0; r < 4; ++r) mx = fmaxf(mx, st[kt][r]);
    mx = xrow_max(mx);
    float den = 0.f;
#pragma unroll
    for (int kt = 0; kt < 9; ++kt)
#pragma unroll
        for (int r = 0; r < 4; ++r) { const float p = __builtin_amdgcn_exp2f(st[kt][r] - mx); st[kt][r] = p; den += p; }
    den = xrow_sum(den);
    bf16x8 pf[5];
#pragma unroll
    for (int kk = 0; kk < 4; ++kk) pf[kk] = pack8(st[2 * kk], st[2 * kk + 1]);
    pf[4] = pack8(st[8], (f32x4){0.f, 0.f, 0.f, 0.f});
    const float rden = 1.0f / den;
    LAS unsigned char* vb = lds + AT_VOFF + (4 * g + (fr >> 2)) * AT_STRIDE + (fr & 3) * 8;
#pragma unroll
    for (int mq = 0; mq < 4; ++mq) { v4u pk;
#pragma unroll
        for (int m2 = 0; m2 < 2; ++m2) { const int mt = 2 * mq + m2; f32x4 o = (f32x4){0.f, 0.f, 0.f, 0.f};
#pragma unroll
            for (int kk = 0; kk < 5; ++kk) { const int t0 = 2 * kk, t1 = (2 * kk + 1 > 8) ? 8 : 2 * kk + 1;
                const bf16x8 a = cat8(lds_tr(vb + AT_ROWOFF(t0) + mt * 32), lds_tr(vb + AT_ROWOFF(t1) + mt * 32));
                o = MFMA16(a, pf[kk], o); }
            const unsigned lo = cvt_pk_bf16(o[0] * rden, o[1] * rden), hi = cvt_pk_bf16(o[2] * rden, o[3] * rden);
            if (m2 == 0) { pk.x = lo; pk.y = hi; } else { pk.z = lo; pk.w = hi; } }
        SWAP16U(pk.x, pk.z); SWAP16U(pk.y, pk.w); pend.o[mq] = pk; }
    pend.lse = mx + __builtin_log2f(den); pend.rowq = rowq;
    __syncthreads();
    if (has_next) { AT_WRITEBLK(PAR ^ 1); LDS_WAIT(); __syncthreads(); }
#undef AT_ROWOFF
}
template <bool FUSE, int NUP>
__device__ __forceinline__ void attn_run(LAS unsigned char* lds, const bf16* Z, bf16* OP, float* LSE, bf16* ACATO, const float* BIAS, int item, int w, int lane_in) {
    int lane = lane_in; asm volatile("" : "+v"(lane)); const int tid = w * 64 + lane;
    constexpr int RB = (NUP == 2) ? 4 : 3;
    const int cfg = item >> (RB + 4), b = (item >> (RB + 3)) & 1, h = (item >> RB) & 7, run = item & ((1 << RB) - 1);
    const int dsh = 2 * cfg, rr = run & ((1 << dsh) - 1), sb0 = 2 * NUP * (run >> dsh);
    const int fr = lane & 15, g = lane >> 4;
    LAS float* BL = (LAS float*)(lds + AT_BOFF);
    const bf16* zb = Z + (size_t)(b * T) * DIN + h * 128;
    v4u kreg[4], vreg[4]; AtPend pend;
    if (sb0 > 0) { AT_LOADBLK(sb0 - 1); AT_WRITEBLK(1); }
    else {
#pragma unroll
        for (int it = 0; it < 4; ++it) { const int p = tid + 512 * it; const int o = AT_SLOT + (p >> 4) * AT_STRIDE + (p & 15) * 16; *(LAS v4u*)(lds + o) = (v4u){0u, 0u, 0u, 0u}; *(LAS v4u*)(lds + AT_VOFF + o) = (v4u){0u, 0u, 0u, 0u}; } }
    AT_LOADBLK(sb0);
    if (tid < 160) { const int dl = tid - 15; BL[tid] = (dl >= 0 && dl <= 128) ? BIAS[(cfg * 8 + h) * 132 + 128 - dl] : -__builtin_inff(); }
    AT_WRITEBLK(0);
    LDS_WAIT(); __syncthreads();
#pragma unroll 1
    for (int up = 0; up < NUP; ++up) {
        attn_unit<0, FUSE>(lds, Z, zb, OP, LSE, ACATO, kreg, vreg, pend, up != 0, cfg, b, h, dsh, rr, sb0 + 2 * up, true, w, tid, fr, g);
        attn_unit<1, FUSE>(lds, Z, zb, OP, LSE, ACATO, kreg, vreg, pend, true, cfg, b, h, dsh, rr, sb0 + 2 * up + 1, up != NUP - 1, w, tid, fr, g);
    }
    AT_FLUSH(pend);
}
#undef AT_LOADBLK
#undef AT_WRITEBLK
#undef AT_FLUSH
#undef AT_FLUSH_PLAIN
#undef AT_FLUSH_MERGE

constexpr int RO_KSTRIDE = 544, RO_VSTRIDE = 160, RO_VOFF = 64 * RO_KSTRIDE, RO_BUF = RO_VOFF + 128 * RO_VSTRIDE;
__device__ __forceinline__ void retout_unit(LAS unsigned char* lds, const bf16* Z, const bf16* RT, const bf16* TB, bf16* ACAT, int uid, int w, int lane_in) {
    int lane = lane_in; asm volatile("" : "+v"(lane)); const int tid = w * 64 + lane;
    const int b = uid >> 8, h = (uid >> 6) & 3, n = uid & 63, row0 = b * T + n * 128;
    const int fr = lane & 15, g = lane >> 4, rowq = row0 + 16 * w + fr;
    const float gamma = head_gamma(h);
    const bf16* vsrc = Z + (size_t)row0 * DIN + C_RV + h * 512;
    const bf16* rsrc = RT + (size_t)(((b * 4 + h) * 64 + n) * 512) * 256;
    const bf16* gsrc = TB + (size_t)(((b * 4 + h) * 8 + (n >> 3)) * 512) * 256;
    const float gw8 = __builtin_amdgcn_exp2f(128.f * (float)(n & 7) * __builtin_log2f(gamma));
    const bool hasr = (n & 7) != 0;
    const bool hasg = (n >> 3) != 0;
    v4u rreg[4], greg[4], vreg[2];
#define RO_LOAD(c_) do { int tl_ = tid; asm volatile("" : "+v"(tl_));   _Pragma("unroll") for (int it = 0; it < 4; ++it) { const int p = tl_ + 512 * it; const size_t o_ = (size_t)((c_) * 64 + (p >> 5)) * 256 + (p & 31) * 8; if (hasr) rreg[it] = *(const v4u*)(rsrc + o_); else rreg[it] = (v4u){0u, 0u, 0u, 0u}; if (hasg) greg[it] = *(const v4u*)(gsrc + o_); else greg[it] = (v4u){0u, 0u, 0u, 0u}; } \
        _Pragma("unroll") for (int it = 0; it < 2; ++it) { const int p = tl_ + 512 * it; vreg[it] = *(const v4u*)(vsrc + (size_t)(p >> 3) * DIN + (c_) * 64 + (p & 7) * 8); } } while (0)
#define RO_MIX(a_, b_) cvt_pk_bf16(bf_lo(a_) + gw8 * bf_lo(b_), bf_hi(a_) + gw8 * bf_hi(b_))
#define RO_WRITE(buf_) do { int tw_ = tid; asm volatile("" : "+v"(tw_)); _Pragma("unroll") for (int it = 0; it < 4; ++it) { const int p = tw_ + 512 * it; v4u m_; m_.x = RO_MIX(rreg[it].x, greg[it].x); m_.y = RO_MIX(rreg[it].y, greg[it].y); m_.z = RO_MIX(rreg[it].z, greg[it].z); m_.w = RO_MIX(rreg[it].w, greg[it].w); \
        *(LAS v4u*)(lds + (buf_) * RO_BUF + (p >> 5) * RO_KSTRIDE + (p & 31) * 16) = m_; } \
        _Pragma("unroll") for (int it = 0; it < 2; ++it) { const int p = tw_ + 512 * it; *(LAS v4u*)(lds + (buf_) * RO_BUF + RO_VOFF + (p >> 3) * RO_VSTRIDE + (p & 7) * 16) = vreg[it]; } } while (0)
    { v4u kreg[8];
#pragma unroll
      for (int it = 0; it < 8; ++it) { const int p = tid + 512 * it; kreg[it] = *(const v4u*)(Z + (size_t)(row0 + (p >> 5)) * DIN + C_RK + h * 256 + (p & 31) * 8); }
#pragma unroll
      for (int it = 0; it < 8; ++it) { const int p = tid + 512 * it; *(LAS v4u*)(lds + (p >> 5) * RO_KSTRIDE + (p & 31) * 16) = kreg[it]; } }
    bf16x8 qf[8];
#pragma unroll
    for (int ks = 0; ks < 8; ++ks) qf[ks] = ldg16(Z + (size_t)rowq * DIN + C_RQ + h * 256 + ks * 32 + 8 * g);
    LDS_WAIT(); __syncthreads();
    RO_LOAD(0);
    float z0 = 0.f; asm volatile("" : "+v"(z0)); const f32x4 zero4 = (f32x4){z0, z0, z0, z0};
    f32x4 st[8];
#pragma unroll
    for (int jt = 0; jt < 8; ++jt) { st[jt] = zero4;
        if (jt <= w) { LAS unsigned char* kp = lds + (16 * jt + fr) * RO_KSTRIDE + g * 16; f32x4 a = zero4;
#pragma unroll
            for (int ks = 0; ks < 8; ++ks) a = MFMA16(*(LAS bf16x8*)(kp + ks * 64), qf[ks], a);
            if (jt == w) {
#pragma unroll
                for (int r = 0; r < 4; ++r) if (4 * g + r > fr) a[r] = 0.f; }
            st[jt] = a; } }
    LAS unsigned char* pfp = lds + 2 * RO_BUF + w * 4096 + lane * 16;
#pragma unroll
    for (int kk = 0; kk < 4; ++kk) *(LAS bf16x8*)(pfp + kk * 1024) = pack8(st[2 * kk], st[2 * kk + 1]);
    __syncthreads();
    RO_WRITE(0); LDS_WAIT(); __syncthreads();
    f32x4 o[32];
    LAS unsigned char* ra = lds + fr * RO_KSTRIDE + g * 16;
    LAS unsigned char* va = lds + RO_VOFF + (4 * g + (fr >> 2)) * RO_VSTRIDE + (fr & 3) * 8;
#pragma unroll
    for (int c = 0; c < 8; ++c) {
        if (c < 7) RO_LOAD(c + 1);
#pragma unroll
        for (int e4 = 0; e4 < 4; ++e4) { f32x4 a = zero4;
#pragma unroll
            for (int ks = 0; ks < 8; ++ks) a = MFMA16(*(LAS bf16x8*)(ra + (c & 1) * RO_BUF + e4 * 16 * RO_KSTRIDE + ks * 64), qf[ks], a);
            a = a * gamma;
#pragma unroll
            for (int kk = 0; kk < 4; ++kk) if (2 * kk <= w) {
                const bf16x8 af = cat8(lds_tr(va + (c & 1) * RO_BUF + (32 * kk) * RO_VSTRIDE + e4 * 32), lds_tr(va + (c & 1) * RO_BUF + (32 * kk + 16) * RO_VSTRIDE + e4 * 32));
                a = MFMA16(af, *(LAS bf16x8*)(pfp + kk * 1024), a); }
            o[4 * c + e4] = a; }
        if (c < 7) RO_WRITE((c + 1) & 1);
        LDS_WAIT(); __syncthreads();
    }
    float ss = 0.f;
#pragma unroll
    for (int et = 0; et < 32; ++et) ss += (o[et][0] * o[et][0] + o[et][1] * o[et][1]) + (o[et][2] * o[et][2] + o[et][3] * o[et][3]);
    ss = xrow_sum(ss);
    const float rn = 1.0f / sqrtf(ss * (1.0f / 512.0f) + EPS);
    const int oc0 = h * 512 + wide_col(g);
#pragma unroll
    for (int ep = 0; ep < 16; ++ep) { f32x4 a = o[2 * ep], b = o[2 * ep + 1];
#pragma unroll
        for (int r = 0; r < 4; ++r) SWAP16F(a[r], b[r]);
        const v4u rg = *(const v4u*)((const unsigned char*)Z + (WS_RS - WS_Z) + pg8::a_tiled_off(rowq, oc0 + 32 * ep, 3072));
        v4u ov; ov.x = cvt_pk_bf16(bf_lo(rg.x) * a[0] * rn, bf_hi(rg.x) * a[1] * rn); ov.y = cvt_pk_bf16(bf_lo(rg.y) * a[2] * rn, bf_hi(rg.y) * a[3] * rn);
        ov.z = cvt_pk_bf16(bf_lo(rg.z) * b[0] * rn, bf_hi(rg.z) * b[1] * rn); ov.w = cvt_pk_bf16(bf_lo(rg.w) * b[2] * rn, bf_hi(rg.w) * b[3] * rn);
        *(v4u*)((unsigned char*)ACAT + pg8::a_tiled_off(rowq, oc0 + 32 * ep, KCAT)) = ov; }
#undef RO_LOAD
#undef RO_WRITE
#undef RO_MIX
}
#ifndef SUBDUP
#define SUBDUP 0
#endif
#ifndef SUB_MASK
#define SUB_MASK 7
#endif
#ifndef DUP_MASK
#define DUP_MASK 0u
#endif
#define DUPN(k_) (1 + (int)((DUP_MASK >> (k_)) & 1u))
#ifndef SITE_MASK
#define SITE_MASK 0xFFFFFFFFu
#endif
#ifndef STAG_TICKS
#define STAG_TICKS 0
#endif
#ifndef STAG_GROUP
#define STAG_GROUP(wg_) (((wg_) >> 6) & 3)
#endif
#define STAGGER() do { if (STAG_TICKS > 0) { const unsigned want_ = (unsigned)(STAG_GROUP(wg)) * (unsigned)(STAG_TICKS); if (want_) { const unsigned long long t0_ = __builtin_amdgcn_s_memrealtime(); \
        while ((unsigned)(__builtin_amdgcn_s_memrealtime() - t0_) < want_) __builtin_amdgcn_s_sleep(4); } } } while (0)

struct Params { const float* in[22]; float* out; unsigned char* ws; int ph_lo, ph_hi; };
typedef __attribute__((address_space(4))) const unsigned char* kargp_t;
typedef GAS unsigned char* g_u8p; typedef GAS float* g_f32p; typedef const GAS float* g_cf32p;
typedef __attribute__((address_space(4))) const g_u8p* kslot_u8; typedef __attribute__((address_space(4))) const g_f32p* kslot_f32; typedef __attribute__((address_space(4))) const g_cf32p* kslot_cf32;

__global__ void __launch_bounds__(NWAVES * 64, 2) fwd_kernel(Params P) {
    extern __shared__ __attribute__((aligned(16))) unsigned char lds_raw[];
    LAS unsigned char* lds = (LAS unsigned char*)lds_raw;
    const int wave = __builtin_amdgcn_readfirstlane((int)threadIdx.x >> 6);
    for (int u = threadIdx.x; u < (LDS_BYTES - LDSCTL_OFF) / 4; u += NWAVES * 64) ((LAS unsigned*)(lds + LDSCTL_OFF))[u] = 0u;
    __syncthreads();
#if MK_PER_PHASE
    XcdBarrier bar; bar.bar = nullptr; bar.x = 0; bar.st = nullptr;
#else
    XcdBarrier bar = xcd_barrier_post((unsigned*)(P.ws + WS_CTL) + CW_BAR, (volatile LAS unsigned*)(lds + MISC_OFF) + 8);
#endif
    const int lo = P.ph_lo, hi = P.ph_hi;
    int ph = 0, site = 0;
#define IN_PH(k_) (((SITE_MASK >> (k_)) & 1u) && lo <= ph && ph < hi)
#define PH_IDS() int lanep; asm volatile("v_mbcnt_lo_u32_b32 %0, -1, 0\n\tv_mbcnt_hi_u32_b32 %0, -1, %0" : "=v"(lanep)); const int tidp = wave * 64 + lanep; (void)tidp; \
    kargp_t ka_ = (kargp_t)__builtin_amdgcn_kernarg_segment_ptr(); asm volatile("" : "+s"(ka_)); \
    unsigned char* const ws = (unsigned char*)*(kslot_u8)(ka_ + 184); (void)ws; \
    int G = gridDim.x, wg = blockIdx.x; asm volatile("" : "+s"(G), "+s"(wg)); const int gw = wg * NWAVES + wave, NGW = G * NWAVES; (void)gw; (void)NGW
#define KIN(i) ((const float*)*(kslot_cf32)(ka_ + 8 * (i)))
#define KOUT() ((float*)*(kslot_f32)(ka_ + 176))
#if MK_PER_PHASE
#define END_PH() do { ++ph; } while (0)
#else
#define END_PH() do { ++ph; xcd_barrier(bar, wave); } while (0)
#endif
#define WSP(T_, off_) ((T_*)(ws + (off_)))
    (void)site;

    for (int l = 0; l < DEPTH; ++l) {
        if (IN_PH(0)) for (int rep_ = 0; rep_ < DUPN(0); ++rep_) { PH_IDS();
            LAS float* scr = (LAS float*)(lds + RING_OFF + wave * 16384);
            unsigned char* wb = ws + WS_W;
            const size_t oGU = (size_t)l * D * FF, oD = (size_t)l * FF * D;
            { ConvMat c{KIN(20) + oD, (bf16*)(wb + WO_D2), FF, D, FF, 0, 0, nullptr}; conv_matrix(c, scr, gw, NGW, lanep); }
            { ConvMat c{KIN(19) + oGU, (bf16*)(wb + WO_GU2), D, FF, D, 0, 2, KIN(17) + (size_t)l * D}; conv_matrix(c, scr, gw, NGW, lanep); }
            { ConvMat c{KIN(18) + oGU, (bf16*)(wb + WO_GU2), D, FF, D, 0, 1, KIN(17) + (size_t)l * D}; conv_matrix(c, scr, gw, NGW, lanep); }
            { ConvMat c{KIN(16) + (size_t)l * D * D, (bf16*)(wb + WO_OUT), D, D, D, 0, 0, nullptr}; conv_matrix(c, scr, gw, NGW, lanep); }
            { ConvMat c{KIN(15) + (size_t)l * 1024 * D, (bf16*)(wb + WO_CAT), 1024, D, KCAT, 3072, 0, nullptr}; conv_matrix(c, scr, gw, NGW, lanep); }
            { ConvMat c{KIN(14) + (size_t)l * 1024 * D, (bf16*)(wb + WO_CAT), 1024, D, KCAT, 2048, 0, nullptr}; conv_matrix(c, scr, gw, NGW, lanep); }
            { ConvMat c{KIN(13) + (size_t)l * 2048 * D, (bf16*)(wb + WO_CAT), 2048, D, KCAT, 0, 0, nullptr}; conv_matrix(c, scr, gw, NGW, lanep); }
            { ConvMat c{KIN(6) + (size_t)l * D * DIN, (bf16*)(wb + WO_IN), D, DIN, D, 0, 0, KIN(5) + (size_t)l * D}; conv_matrix(c, scr, gw, NGW, lanep); }
            { ConvMat c{KIN(4) + oD, (bf16*)(wb + WO_D1), FF, D, FF, 0, 0, nullptr}; conv_matrix(c, scr, gw, NGW, lanep); }
            { ConvMat c{KIN(3) + oGU, (bf16*)(wb + WO_GU1), D, FF, D, 0, 2, KIN(1) + (size_t)l * D}; conv_matrix(c, scr, gw, NGW, lanep); }
            { ConvMat c{KIN(2) + oGU, (bf16*)(wb + WO_GU1), D, FF, D, 0, 1, KIN(1) + (size_t)l * D}; conv_matrix(c, scr, gw, NGW, lanep); }
            const int gt = wg * (NWAVES * 64) + tidp, NGT = G * NWAVES * 64;
            { const float* sw = KIN(10) + (size_t)l * 4 * 128 * 128; bf16* WCb = WSP(bf16, WS_WC);
              for (int i = gt; i < 4 * 128 * 128; i += NGT) { const int s = i & 127, t = (i >> 7) & 127; WCb[i] = (bf16)(s <= t ? f2bf(sw[i]) : 0u); } }
            if (l == 0) {
                { const float* xin0 = KIN(0); bf16* XR = WSP(bf16, WS_X); float* PART = WSP(float, WS_PART); for (int m = gw; m < M; m += NGW) x_row_prep(xin0 + (size_t)m * D, XR, m, PART + (size_t)m * 32, lanep); }
                float* ROPE = WSP(float, WS_ROPE); float* BIAS = WSP(float, WS_BIAS); const float* relb = KIN(12);
                for (int fi = gt; fi < 128; fi += NGT) {
                    double inv = 1.0;
                    if (fi & 1) inv *= 0.930572040929699; if (fi & 2) inv *= 0.8659643233600654; if (fi & 4) inv *= 0.7498942093324559; if (fi & 8) inv *= 0.5623413251903491;
                    if (fi & 16) inv *= 0.31622776601683794; if (fi & 32) inv *= 0.1; if (fi & 64) inv *= 0.01;
                    ROPE[fi] = (float)(inv * 0.15915494309189535); }
                for (int i = gt; i < 3 * 8 * 132; i += NGT) { const int st = i % 132, hh = (i / 132) % 8, cfg = i / (132 * 8); float v = 0.f;
                    if (st <= 128) { const int dist = st << (2 * cfg); int bk;
                        if (dist < 16) bk = dist; else { bk = 16 + (int)(logf((float)dist / 16.0f) / 4.852030263919617f * 16.0f); bk = bk > 31 ? 31 : bk; }
                        v = relb[bk * 8 + hh] * LOG2E; }
                    BIAS[i] = v; }
            }
        }
        END_PH();
        for (int half = 0; half < 2; ++half) {
            if (IN_PH(2)) for (int rep_ = 0; rep_ < DUPN(2); ++rep_) { PH_IDS(); pg8::Gemm g{WSP(const bf16, WS_X), (const bf16*)(ws + WS_W + (half ? WO_GU2 : WO_GU1)), M, 2 * FF, D, 1}; pg8::StaticOrder S; S.init(M, 2 * FF, G, wg, pg8::WGM, 1);
                { pg8::Unit u0; if (S.next(0, u0)) panel_rstd((LAS float*)(lds + RSTD_OFF), WSP(const float, WS_PART), u0.pm, tidp); LDS_WAIT(); __syncthreads(); }
                pg8::EpiGU E{WSP(bf16, WS_Z), (const LAS float*)(lds + RSTD_OFF)};
#if defined(CLK_PROBE)
                const unsigned long long t0_ = __builtin_amdgcn_s_memtime(), r0_ = __builtin_amdgcn_s_memrealtime();
#endif
                STAGGER();
                pg8::gemm_phase<pg8::EpiGU, pg8::StaticOrder, true, true>(lds + RING_OFF, g, S, E, wave);
#if defined(CLK_PROBE)
                if (l == 1 && half == 0 && wg == 5 && tidp == 0) { const unsigned long long t1_ = __builtin_amdgcn_s_memtime(), r1_ = __builtin_amdgcn_s_memrealtime();
                    unsigned* cw = WSP(unsigned, WS_CTL) + 64; cw[0] = (unsigned)(t1_ - t0_); cw[1] = (unsigned)(r1_ - r0_); }
#endif
                }
            END_PH();
            if (IN_PH(3)) for (int rep_ = 0; rep_ < DUPN(3); ++rep_) { PH_IDS(); pg8::Gemm g{WSP(const bf16, WS_Z), (const bf16*)(ws + WS_W + (half ? WO_D2 : WO_D1)), M, D, FF, 1}; pg8::StaticOrder S; S.init(M, D, G, wg, 4);
                pg8::EpiRes E{WSP(const bf16, WS_X), WSP(bf16, WS_X), WSP(float, WS_PART), 0.5f}; pg8::gemm_phase<pg8::EpiRes, pg8::StaticOrder, true, true>(lds + RING_OFF, g, S, E, wave); }
            END_PH();
            if (half == 0) {
                if (IN_PH(5)) for (int rep_ = 0; rep_ < DUPN(5); ++rep_) { PH_IDS(); pg8::Gemm g{WSP(const bf16, WS_X), (const bf16*)(ws + WS_W + WO_IN), M, DIN, D, 1}; pg8::StaticOrder S; S.init(M, DIN, G, wg, pg8::WGM, 1);
                    { pg8::Unit u0; if (S.next(0, u0)) panel_rstd((LAS float*)(lds + RSTD_OFF), WSP(const float, WS_PART), u0.pm, tidp); LDS_WAIT(); __syncthreads(); }
                    pg8::EpiWin E{WSP(bf16, WS_Z), KIN(7) + (size_t)l * 3 * D, WSP(const float, WS_ROPE), WSP(float, WS_SGP), WSP(unsigned char, WS_G8), (const LAS float*)(lds + RSTD_OFF)};
                    STAGGER();
                    pg8::gemm_phase<pg8::EpiWin, pg8::StaticOrder, true, true>(lds + RING_OFF, g, S, E, wave); }
                END_PH();
                if (IN_PH(6)) for (int rep_ = 0; rep_ < DUPN(6); ++rep_) { PH_IDS();
                    const int vcu = (G % 8 == 0) ? (wg % 8) * (G / 8) + wg / 8 : wg;
#if defined(MIX_ROT)
                    const int rot_ = (wg >> 3) % 3;
                    _Pragma("nounroll") for (int s_ = 0; s_ < 3; ++s_) { int k_ = s_ + rot_; k_ = k_ >= 3 ? k_ - 3 : k_; asm volatile("" : "+s"(k_));
                        if (k_ == 0) cs_phase(lds, WSP(const bf16, WS_Z), WSP(bf16, WS_RT), WSP(bf16, WS_TB), vcu, G, wave, lanep);
                        else if (k_ == 1) { PH_IDS(); const int vcu = (G % 8 == 0) ? (wg % 8) * (G / 8) + wg / 8 : wg; for (int it = vcu; it < 256; it += G) attn_run<false, 4>(lds, WSP(const bf16, WS_Z), WSP(bf16, WS_OPART), WSP(float, WS_LSE), (bf16*)nullptr, WSP(const float, WS_BIAS), it, wave, lanep); }
                        else { PH_IDS(); const int vcu = (G % 8 == 0) ? (wg % 8) * (G / 8) + wg / 8 : wg; for (int it = vcu; it < 512; it += G)
                            sgu_unit(lds, WSP(const bf16, WS_Z), WSP(const float, WS_SGP), WSP(bf16, WS_ACAT), WSP(const bf16, WS_WC), KIN(8) + (size_t)l * 1024, KIN(9) + (size_t)l * 1024, KIN(11) + (size_t)l * 512, it, wave, lanep); }
                        __syncthreads(); }
#else
                    if (SUB_MASK & 1) for (int r2_ = 0; r2_ < 1 + (SUBDUP & 1); ++r2_) cs_phase(lds, WSP(const bf16, WS_Z), WSP(bf16, WS_RT), WSP(bf16, WS_TB), vcu, G, wave, lanep);
                    if (SUB_MASK & 2) for (int r2_ = 0; r2_ < 1 + ((SUBDUP >> 1) & 1); ++r2_) { PH_IDS(); const int vcu = (G % 8 == 0) ? (wg % 8) * (G / 8) + wg / 8 : wg; for (int it = vcu; it < 256; it += G) attn_run<false, 4>(lds, WSP(const bf16, WS_Z), WSP(bf16, WS_OPART), WSP(float, WS_LSE), (bf16*)nullptr, WSP(const float, WS_BIAS), it, wave, lanep); }
                    if (SUB_MASK & 4) for (int r2_ = 0; r2_ < 1 + ((SUBDUP >> 2) & 1); ++r2_) { PH_IDS(); const int vcu = (G % 8 == 0) ? (wg % 8) * (G / 8) + wg / 8 : wg; for (int it = vcu; it < 512; it += G)
                        sgu_unit(lds, WSP(const bf16, WS_Z), WSP(const float, WS_SGP), WSP(bf16, WS_ACAT), WSP(const bf16, WS_WC), KIN(8) + (size_t)l * 1024, KIN(9) + (size_t)l * 1024, KIN(11) + (size_t)l * 512, it, wave, lanep); }
#endif
                }
                END_PH();
                if (IN_PH(11)) for (int rep_ = 0; rep_ < DUPN(11); ++rep_) { PH_IDS();
                    const int gt = wg * (NWAVES * 64) + tidp, NGT = G * NWAVES * 64;
                    if (rep_ == 0) prefix2_phase(WSP(bf16, WS_TB), gt, NGT);
                    { const int vcu = (G % 8 == 0) ? (wg % 8) * (G / 8) + wg / 8 : wg;
                      for (int it = 512 + vcu; it < 768; it += G) attn_run<true, 2>(lds, WSP(const bf16, WS_Z), WSP(bf16, WS_OPART), WSP(float, WS_LSE), WSP(bf16, WS_ACAT), WSP(const float, WS_BIAS), it, wave, lanep); }
                }
                END_PH();
                if (IN_PH(7)) for (int rep_ = 0; rep_ < DUPN(7); ++rep_) { PH_IDS();
                    for (int it = wg; it < 512; it += G) retout_unit(lds, WSP(const bf16, WS_Z), WSP(const bf16, WS_RT), WSP(const bf16, WS_TB), WSP(bf16, WS_ACAT), it, wave, lanep);
                }
                END_PH();
                if (IN_PH(8)) for (int rep_ = 0; rep_ < DUPN(8); ++rep_) { PH_IDS(); pg8::Gemm g{WSP(const bf16, WS_ACAT), (const bf16*)(ws + WS_W + WO_CAT), M, D, KCAT, 1}; pg8::StaticOrder S; S.init(M, D, G, wg, 4);
                    pg8::EpiProj E{WSP(const unsigned char, WS_G8), WSP(bf16, WS_MERGED)}; pg8::gemm_phase<pg8::EpiProj, pg8::StaticOrder, true, true>(lds + RING_OFF, g, S, E, wave); }
                END_PH();
                if (IN_PH(9)) for (int rep_ = 0; rep_ < DUPN(9); ++rep_) { PH_IDS(); pg8::Gemm g{WSP(const bf16, WS_MERGED), (const bf16*)(ws + WS_W + WO_OUT), M, D, D, 1}; pg8::StaticOrder S; S.init(M, D, G, wg, 4);
                    pg8::EpiRes E{WSP(const bf16, WS_X), WSP(bf16, WS_X), WSP(float, WS_PART), 1.0f}; pg8::gemm_phase<pg8::EpiRes, pg8::StaticOrder, true, true>(lds + RING_OFF, g, S, E, wave); }
                END_PH();
            }
        }
    }
    if (IN_PH(10)) for (int rep_ = 0; rep_ < DUPN(10); ++rep_) { PH_IDS(); const bf16* X = WSP(const bf16, WS_X); const float* gain = KIN(21); float* out = KOUT();
        for (int m = gw; m < M; m += NGW) rms_row<true>(X, m, gain, out + (size_t)m * D, lanep);
#if defined(CLK_PROBE)
        { asm volatile("s_waitcnt vmcnt(0)" ::: "memory"); const unsigned* cw = WSP(const unsigned, WS_CTL) + 64; const float cyc = (float)__hip_atomic_load(cw, __ATOMIC_RELAXED, __HIP_MEMORY_SCOPE_AGENT), rt = (float)__hip_atomic_load(cw + 1, __ATOMIC_RELAXED, __HIP_MEMORY_SCOPE_AGENT);
          const float V = (CLK_PROBE == 1) ? rintf(cyc / (11.f * 32.f) / 100.f) : rintf(10.f * cyc / rt); const float dv = sqrtf(V);
          for (int m = gw; m < M; m += NGW) for (int c = lanep; c < D; c += 64) out[(size_t)m * D + c] = dv; }
#endif
    }
#undef IN_PH
#undef END_PH
}
constexpr int N_PHASES = DEPTH * (1 + 2 + 6 + 2) + 1;

extern "C" void kernel_launch(void* const* d_in, const int* in_sizes, int n_in, void* d_out, int out_size, void* d_ws, size_t ws_size, hipStream_t stream) {
    static int grid = 0;
    if (grid == 0) {
        if (n_in != 22 || ws_size < WS_END) { fprintf(stderr, "kernel_launch: unexpected n_in %d / ws %zu\n", n_in, ws_size); grid = -1; return; }
        int dev = 0, cus = 0, per_cu = 0;
        if (hipGetDevice(&dev) != hipSuccess || hipDeviceGetAttribute(&cus, hipDeviceAttributeMultiprocessorCount, dev) != hipSuccess) { grid = -1; return; }
        if (hipFuncSetAttribute((const void*)fwd_kernel, hipFuncAttributeMaxDynamicSharedMemorySize, LDS_BYTES) != hipSuccess) { fprintf(stderr, "kernel_launch: hipFuncSetAttribute failed\n"); grid = -1; return; }
        if (hipOccupancyMaxActiveBlocksPerMultiprocessor(&per_cu, (const void*)fwd_kernel, NWAVES * 64, LDS_BYTES) != hipSuccess || per_cu < 1)
            fprintf(stderr, "kernel_launch: occupancy query reports %d workgroups per CU\n", per_cu);
        (void)hipGetLastError();
        grid = cus;
    }
    if (grid < 0) return;
    (void)hipMemsetAsync((char*)d_ws + WS_CTL, 0, CTL_ZERO_BYTES, stream);
    Params p{};
    for (int i = 0; i < 22; ++i) p.in[i] = (const float*)d_in[i];
    p.out = (float*)d_out; p.ws = (unsigned char*)d_ws;
#if MK_PER_PHASE
    for (int k = 0; k < N_PHASES; ++k) { p.ph_lo = k; p.ph_hi = k + 1; hipLaunchKernelGGL(fwd_kernel, dim3(grid), dim3(NWAVES * 64), LDS_BYTES, stream, p); }
#else
    p.ph_lo = 0; p.ph_hi = N_PHASES;
    hipLaunchKernelGGL(fwd_kernel, dim3(grid), dim3(NWAVES * 64), LDS_BYTES, stream, p);
#endif
}
```
